# Optimizing an MI355X kernel written in HIP

```python
import math
import jax, jax.numpy as jnp
from jax import lax
import numpy as np

D_MODEL = 2048
BATCH = 2
SEQ = 4096
DEPTH = 1

PLE_DIM = 256
D_FF = 5632
EPS = 1e-6
MLA_HEADS = 8
QK_NOPE = 128
QK_ROPE = 64
QK_HEAD = QK_NOPE + QK_ROPE
V_HEAD = 128
Q_LORA = 512
KV_LORA = 256
ROPE_BASE = 10000.0
Q_BLOCK = 128
MLA_OUT = MLA_HEADS * V_HEAD
MLA_IN = Q_LORA + KV_LORA + QK_ROPE
RWKV_HEAD = 64
RWKV_HEADS = 16
RWKV_DIM = RWKV_HEADS * RWKV_HEAD
DECAY_LORA = 64
AAA_LORA = 64
GATE_LORA = 128
GN_EPS = 64e-5
RWKV_IN = 3 * RWKV_DIM + DECAY_LORA + AAA_LORA + GATE_LORA
D_MIX = MLA_OUT + RWKV_DIM
D_IN = MLA_IN + RWKV_IN

kernel_name = "hymba_mla_rwkv7_macaron_ple"


def rmsnorm(x, g, eps=EPS):
    xf = x.astype(jnp.float32)
    y = xf * lax.rsqrt(jnp.mean(xf * xf, axis=-1, keepdims=True) + eps)
    return (y * g.astype(jnp.float32)).astype(x.dtype)


def swiglu(h, w_gate, w_up, w_down):
    return (jax.nn.silu(h @ w_gate) * (h @ w_up)) @ w_down


def rope_tables(seq_len, dtype):
    inv_freq = 1.0 / (ROPE_BASE ** (jnp.arange(0, QK_ROPE, 2, dtype=jnp.float32) / QK_ROPE))
    ang = jnp.arange(seq_len, dtype=jnp.float32)[:, None] * inv_freq[None, :]
    return jnp.cos(ang)[:, None, :].astype(dtype), jnp.sin(ang)[:, None, :].astype(dtype)


def apply_rope(x, cos, sin):
    x1, x2 = jnp.split(x, 2, axis=-1)
    return jnp.concatenate([x1 * cos - x2 * sin, x2 * cos + x1 * sin], axis=-1)


def mla_group(z_mla, q_a_norm, w_q_b, kv_a_norm, w_kv_b, q_norm, k_norm):
    B, S, _ = z_mla.shape
    q_lat = z_mla[..., :Q_LORA]
    kv_lat = z_mla[..., Q_LORA:Q_LORA + KV_LORA]
    k_pe = z_mla[..., Q_LORA + KV_LORA:]
    q = (rmsnorm(q_lat, q_a_norm) @ w_q_b).reshape(B, S, MLA_HEADS, QK_HEAD)
    kv = (rmsnorm(kv_lat, kv_a_norm) @ w_kv_b).reshape(B, S, MLA_HEADS, QK_NOPE + V_HEAD)
    k_nope, v = kv[..., :QK_NOPE], kv[..., QK_NOPE:]
    k_pe = jnp.broadcast_to(k_pe[:, :, None, :], (B, S, MLA_HEADS, QK_ROPE))
    k = jnp.concatenate([k_nope, k_pe], axis=-1)
    q = rmsnorm(q, q_norm)
    k = rmsnorm(k, k_norm)
    cos, sin = rope_tables(S, q.dtype)
    q = jnp.concatenate([q[..., :QK_NOPE], apply_rope(q[..., QK_NOPE:], cos, sin)], axis=-1)
    k = jnp.concatenate([k[..., :QK_NOPE], apply_rope(k[..., QK_NOPE:], cos, sin)], axis=-1)
    q = q * (1.0 / math.sqrt(QK_HEAD))

    n_blk = S // Q_BLOCK
    qb = q.reshape(B, n_blk, Q_BLOCK, MLA_HEADS, QK_HEAD).transpose(1, 0, 2, 3, 4)
    k_pos = jnp.arange(S)

    def attend(args):
        q_i, blk = args
        s = jnp.einsum('bqhd,bkhd->bhqk', q_i, k).astype(jnp.float32)
        q_pos = blk * Q_BLOCK + jnp.arange(Q_BLOCK)
        causal = k_pos[None, :] <= q_pos[:, None]
        s = jnp.where(causal[None, None], s, -1e30)
        pr = jax.nn.softmax(s, axis=-1).astype(v.dtype)
        return jnp.einsum('bhqk,bkhd->bqhd', pr, v)

    o = lax.map(attend, (qb, jnp.arange(n_blk)))
    return o.transpose(1, 0, 2, 3, 4).reshape(B, S, MLA_OUT)


def rwkv7_group(z_rwkv, mu_shift, w0, w_w2, a0, w_a2, w_g2, k_k, k_a, r_k, ln_x_w, ln_x_b):
    B, S, _ = z_rwkv.shape
    H, N = RWKV_HEADS, RWKV_HEAD
    prev = jnp.pad(z_rwkv, ((0, 0), (1, 0), (0, 0)))[:, :-1]
    zs = z_rwkv + (prev - z_rwkv) * mu_shift
    o1, o2, o3 = RWKV_DIM, 2 * RWKV_DIM, 3 * RWKV_DIM
    o4, o5 = o3 + DECAY_LORA, o3 + DECAY_LORA + AAA_LORA
    r, k, v = zs[..., :o1], zs[..., o1:o2], zs[..., o2:o3]
    w_lo, a_lo, g_lo = zs[..., o3:o4], zs[..., o4:o5], zs[..., o5:]
    w = -jax.nn.softplus(-(w0 + jnp.tanh(w_lo) @ w_w2)) - 0.5
    decay = jnp.exp(-jnp.exp(w.astype(jnp.float32)))
    a = jax.nn.sigmoid(a0 + a_lo @ w_a2)
    g = jax.nn.sigmoid(g_lo) @ w_g2
    kk = (k * k_k).reshape(B, S, H, N).astype(jnp.float32)
    kk = kk / jnp.maximum(jnp.sqrt(jnp.sum(kk * kk, axis=-1, keepdims=True)), 1e-12)
    k = k * (1.0 + (a - 1.0) * k_a)

    def heads(t):
        return t.reshape(B, S, H, N).astype(jnp.float32)

    r_h, k_h, v_h, a_h, w_h = heads(r), heads(k), heads(v), heads(a), heads(decay)

    def step(state, inp):
        r_t, w_t, k_t, v_t, kk_t, a_t = inp
        sa = jnp.einsum('bhvk,bhk->bhv', state, -kk_t)
        state = (state * w_t[:, :, None, :]
                 + sa[..., None] * (kk_t * a_t)[:, :, None, :]
                 + v_t[..., None] * k_t[:, :, None, :])
        return state, jnp.einsum('bhvk,bhk->bhv', state, r_t)

    seq_first = lambda t: jnp.swapaxes(t, 0, 1)
    init = jnp.zeros((B, H, N, N), jnp.float32)
    _, o = lax.scan(step, init, tuple(seq_first(t) for t in (r_h, w_h, k_h, v_h, kk, a_h)))
    o = seq_first(o)
    mu = jnp.mean(o, axis=-1, keepdims=True)
    var = jnp.mean(jnp.square(o - mu), axis=-1, keepdims=True)
    o = (o - mu) * lax.rsqrt(var + GN_EPS)
    o = o * ln_x_w.reshape(H, N).astype(jnp.float32) + ln_x_b.reshape(H, N).astype(jnp.float32)
    bonus = jnp.sum(r_h * k_h * r_k.astype(jnp.float32), axis=-1, keepdims=True) * v_h
    o = (o + bonus).reshape(B, S, RWKV_DIM).astype(z_rwkv.dtype)
    return o * g


def setup_inputs(seed: int = 0) -> dict:
    key = jax.random.key(seed)
    ks = jax.random.split(key, 40)
    f32 = jnp.float32

    def dense(k, shape, fan_in, scale=1.0):
        return jax.random.normal(k, shape, f32) * (scale * fan_in ** -0.5)

    def gain(k, n):
        return 1.0 + 0.02 * jax.random.normal(k, (DEPTH, n), f32)

    L = DEPTH
    return {
        "x": jax.random.normal(ks[0], (BATCH, SEQ, D_MODEL), f32),
        "p": jax.random.normal(ks[1], (DEPTH, BATCH, SEQ, PLE_DIM), f32),
        "norm_ffn1": gain(ks[2], D_MODEL),
        "w1_gate": dense(ks[3], (L, D_MODEL, D_FF), D_MODEL),
        "w1_up": dense(ks[4], (L, D_MODEL, D_FF), D_MODEL),
        "w1_down": dense(ks[5], (L, D_FF, D_MODEL), D_FF),
        "norm_mix": gain(ks[6], D_MODEL),
        "w_in": dense(ks[7], (L, D_MODEL, D_IN), D_MODEL),
        "q_a_norm": gain(ks[8], Q_LORA),
        "w_q_b": dense(ks[9], (L, Q_LORA, MLA_HEADS * QK_HEAD), Q_LORA),
        "kv_a_norm": gain(ks[10], KV_LORA),
        "w_kv_b": dense(ks[11], (L, KV_LORA, MLA_HEADS * (QK_NOPE + V_HEAD)), KV_LORA),
        "q_norm": gain(ks[12], QK_HEAD),
        "k_norm": gain(ks[13], QK_HEAD),
        "mu_shift": jax.random.uniform(ks[14], (L, RWKV_IN), f32),
        "w0": jax.random.normal(ks[15], (L, RWKV_DIM), f32),
        "w_w2": dense(ks[16], (L, DECAY_LORA, RWKV_DIM), DECAY_LORA, 0.5),
        "a0": 0.1 * jax.random.normal(ks[17], (L, RWKV_DIM), f32),
        "w_a2": dense(ks[18], (L, AAA_LORA, RWKV_DIM), AAA_LORA),
        "w_g2": dense(ks[19], (L, GATE_LORA, RWKV_DIM), GATE_LORA),
        "k_k": 0.85 + 0.05 * jax.random.normal(ks[20], (L, RWKV_DIM), f32),
        "k_a": 1.0 + 0.05 * jax.random.normal(ks[21], (L, RWKV_DIM), f32),
        "r_k": 0.1 * jax.random.normal(ks[22], (L, RWKV_HEADS, RWKV_HEAD), f32),
        "ln_x_w": gain(ks[23], RWKV_DIM),
        "ln_x_b": 0.02 * jax.random.normal(ks[24], (L, RWKV_DIM), f32),
        "w_out": dense(ks[25], (L, D_MIX, D_MODEL), D_MIX),
        "norm_ffn2": gain(ks[26], D_MODEL),
        "w2_gate": dense(ks[27], (L, D_MODEL, D_FF), D_MODEL),
        "w2_up": dense(ks[28], (L, D_MODEL, D_FF), D_MODEL),
        "w2_down": dense(ks[29], (L, D_FF, D_MODEL), D_FF),
        "norm_ple": gain(ks[30], D_MODEL),
        "w_ple_gate": dense(ks[31], (L, D_MODEL, D_MODEL), D_MODEL),
        "w_ple_proj": dense(ks[32], (L, PLE_DIM, D_MODEL), PLE_DIM),
    }


def reference(x, p, norm_ffn1, w1_gate, w1_up, w1_down, norm_mix, w_in, q_a_norm, w_q_b,
              kv_a_norm, w_kv_b, q_norm, k_norm, mu_shift, w0, w_w2, a0, w_a2, w_g2, k_k, k_a,
              r_k, ln_x_w, ln_x_b, w_out, norm_ffn2, w2_gate, w2_up, w2_down, norm_ple,
              w_ple_gate, w_ple_proj):
    for i in range(DEPTH):
        x = x + 0.5 * swiglu(rmsnorm(x, norm_ffn1[i]), w1_gate[i], w1_up[i], w1_down[i])
        h = rmsnorm(x, norm_mix[i])
        z = h @ w_in[i]
        o_mla = mla_group(z[..., :MLA_IN], q_a_norm[i], w_q_b[i], kv_a_norm[i], w_kv_b[i],
                          q_norm[i], k_norm[i])
        o_rwkv = rwkv7_group(z[..., MLA_IN:], mu_shift[i], w0[i], w_w2[i], a0[i], w_a2[i],
                             w_g2[i], k_k[i], k_a[i], r_k[i], ln_x_w[i], ln_x_b[i])
        x = x + jnp.concatenate([o_mla, o_rwkv], axis=-1) @ w_out[i]
        x = x + 0.5 * swiglu(rmsnorm(x, norm_ffn2[i]), w2_gate[i], w2_up[i], w2_down[i])
        gate = jax.nn.sigmoid(rmsnorm(x, norm_ple[i]) @ w_ple_gate[i])
        x = x + gate * (p[i] @ w_ple_proj[i])
    return x
```

```cpp
#include <hip/hip_runtime.h>
#include <cstdio>
#include <cstdint>
namespace pg8 {
#define PG8_LAS __attribute__((address_space(3)))
typedef unsigned short bf16_t;
typedef short bf16x8 __attribute__((ext_vector_type(8)));
typedef float f32x4 __attribute__((ext_vector_type(4)));
typedef unsigned u32x4 __attribute__((ext_vector_type(4)));
typedef unsigned u32x2 __attribute__((ext_vector_type(2)));
constexpr int BM = 256, BK = 64, HALF = 128, HTB = HALF * BK * 2  , STAGE_BYTES = 8 * HTB, NXCD = 8, WGM = 8;

__host__ __device__ __forceinline__ int lds_byte(int r, int c) { const int st = (r >> 4) * 2 + (c >> 5), rr = r & 15, cc = c & 31, ob = rr * 64 + cc * 2; return st * 1024 + (ob ^ (((ob >> 9) & 1) << 5)); }
__host__ __device__ __forceinline__ void stage_rc(int b, int& R, int& C) { const int st = b / 1024, sb = b % 1024, swz = sb ^ (((sb >> 9) & 1) << 5); R = (st >> 1) * 16 + swz / 64; C = (st & 1) * 32 + (swz % 64) / 2; }
__host__ __device__ __forceinline__ int perm32(int rho) { const int n = rho >> 4, i = rho & 15; return 8 * (i >> 2) + 4 * n + (i & 3); }

struct Unit { int pm, pn; };
struct Gemm { const bf16_t* A; const bf16_t* Bt; int M, N, K; int ld; size_t kofs; };

struct StaticOrder {
    int nM, nN, nwg, G, c;
    __host__ __device__ void init(int M, int N, int G_, int c_) { nM = M / BM; nN = N / BM; nwg = nM * nN; G = G_; c = c_; }
    __host__ __device__ bool next(int i, Unit& u) const {
        const long L = (long)i * G + c; if (L >= nwg) return false;
        int wgid = (int)L; { const int q = nwg / NXCD, r = nwg % NXCD, xcd = wgid % NXCD, off = wgid / NXCD; wgid = (xcd < r ? xcd * (q + 1) : r * (q + 1) + (xcd - r) * q) + off; }
        const int nig = WGM * nN, gid = wgid / nig, fm = gid * WGM, gsz = (nM - fm) < WGM ? (nM - fm) : WGM;
        u.pm = fm + ((wgid % nig) % gsz); u.pn = (wgid % nig) / gsz; return true;
    }
    __device__ __forceinline__ void a_ready(const Unit&) const {}
    __device__ __forceinline__ void done(const Unit&) const {}
};


__device__ __forceinline__ unsigned cvt_pk_bf16(float lo, float hi) { unsigned r; asm volatile("v_cvt_pk_bf16_f32 %0, %1, %2" : "=v"(r) : "v"(lo), "v"(hi)); return r; }
__device__ __forceinline__ float fast_sigmoid(float x) { return __builtin_amdgcn_rcpf(1.0f + __builtin_amdgcn_exp2f(-1.4426950408889634f * x)); }

__device__ __forceinline__ float row_rstd(const float* ss, int row) { return ss ? __builtin_amdgcn_rsqf(ss[row] * (1.0f / 2048.0f) + 1e-6f) : 1.0f; }
__device__ __forceinline__ void pf_rows_lds(PG8_LAS unsigned char* slot, const float* ss, int rowbase, int lane) {
    if (ss) { const float* src = ss + rowbase + lane;
        __builtin_amdgcn_global_load_lds((const unsigned*)src, (PG8_LAS unsigned*)slot, 4, 0, 0);
        __builtin_amdgcn_global_load_lds((const unsigned*)(src + HALF), (PG8_LAS unsigned*)(slot + 256), 4, 0, 0); }
}
__device__ __forceinline__ void rstd8_lds(float (&rs8)[2][4], const PG8_LAS unsigned char* slot, const float* ss, int fr) {
    if (ss) {
#pragma unroll
        for (int ai = 0; ai < 2; ++ai)
#pragma unroll
            for (int m = 0; m < 4; ++m) rs8[ai][m] = *(const PG8_LAS float*)(slot + ai * 256 + (m * 16 + fr) * 4);
#pragma unroll
        for (int ai = 0; ai < 2; ++ai)
#pragma unroll
            for (int m = 0; m < 4; ++m) rs8[ai][m] = __builtin_amdgcn_rsqf(rs8[ai][m] * (1.0f / 2048.0f) + 1e-6f);
    } else {
#pragma unroll
        for (int ai = 0; ai < 2; ++ai)
#pragma unroll
            for (int m = 0; m < 4; ++m) rs8[ai][m] = 1.0f;
    }
}
__device__ __forceinline__ void load_rstd8(float (&rs8)[2][4], const float* ss, int row0) {
    if (ss) {
#pragma unroll
        for (int ai = 0; ai < 2; ++ai)
#pragma unroll
            for (int m = 0; m < 4; ++m) rs8[ai][m] = ss[row0 + ai * HALF + m * 16];
#pragma unroll
        for (int ai = 0; ai < 2; ++ai)
#pragma unroll
            for (int m = 0; m < 4; ++m) rs8[ai][m] = __builtin_amdgcn_rsqf(rs8[ai][m] * (1.0f / 2048.0f) + 1e-6f);
    } else {
#pragma unroll
        for (int ai = 0; ai < 2; ++ai)
#pragma unroll
            for (int m = 0; m < 4; ++m) rs8[ai][m] = 1.0f;
    }
}
struct EpiBf16 {
    static constexpr bool PERM = true, AFTER_DRAIN = false, PF = true;
    bf16_t* O; int ldc; const float* ss;
    __device__ __forceinline__ void prefetch(PG8_LAS unsigned char* slot, const Unit& u, int wr, int lane) const { pf_rows_lds(slot, ss, u.pm * BM + wr * 64, lane); }
    __device__ __forceinline__ void operator()(const f32x4 (&acc)[2][2][4][2], const Unit& u, int wr, int wc, int fr, int fq, const PG8_LAS unsigned char* slot) const {
        const int row0 = u.pm * BM + wr * 64 + fr, col0 = u.pn * BM + wc * 32 + 8 * fq;
        float rs8[2][4];
        rstd8_lds(rs8, slot, ss, fr);
#pragma unroll
        for (int ai = 0; ai < 2; ++ai)
#pragma unroll
            for (int m = 0; m < 4; ++m) { const int row = row0 + ai * HALF + m * 16; const float rs = rs8[ai][m]; bf16_t* rowp = O + (size_t)row * ldc + col0;
#pragma unroll
                for (int bj = 0; bj < 2; ++bj) { const f32x4 v0 = acc[ai][bj][m][0] * rs, v1 = acc[ai][bj][m][1] * rs;
                    u32x4 w; w.x = cvt_pk_bf16(v0[0], v0[1]); w.y = cvt_pk_bf16(v0[2], v0[3]); w.z = cvt_pk_bf16(v1[0], v1[1]); w.w = cvt_pk_bf16(v1[2], v1[3]);
                    *(u32x4*)(rowp + bj * HALF) = w; } }
    }
};
struct EpiSwiGLU {
    static constexpr bool PERM = true, AFTER_DRAIN = false, PF = true;
    bf16_t* O; int ldc; const float* ss;
    __device__ __forceinline__ void prefetch(PG8_LAS unsigned char* slot, const Unit& u, int wr, int lane) const { pf_rows_lds(slot, ss, u.pm * BM + wr * 64, lane); }
    __device__ __forceinline__ void operator()(const f32x4 (&acc)[2][2][4][2], const Unit& u, int wr, int wc, int fr, int fq, const PG8_LAS unsigned char* slot) const {
        const int row0 = u.pm * BM + wr * 64 + fr, hid0 = u.pn * 128 + wc * 16 + 4 * fq;
        float rs8[2][4];
        rstd8_lds(rs8, slot, ss, fr);
#pragma unroll
        for (int ai = 0; ai < 2; ++ai)
#pragma unroll
            for (int m = 0; m < 4; ++m) { const int row = row0 + ai * HALF + m * 16; const float rs = rs8[ai][m]; bf16_t* rowp = O + (size_t)row * ldc + hid0;
#pragma unroll
                for (int bj = 0; bj < 2; ++bj) { const f32x4 g = acc[ai][bj][m][0] * rs, up = acc[ai][bj][m][1] * rs; float o[4];
#pragma unroll
                    for (int e = 0; e < 4; ++e) o[e] = g[e] * up[e] * fast_sigmoid(g[e]);
                    u32x2 w; w.x = cvt_pk_bf16(o[0], o[1]); w.y = cvt_pk_bf16(o[2], o[3]);
                    *(u32x2*)(rowp + bj * 64) = w; } }
    }
};
__device__ __forceinline__ f32x4 bf4_to_f32(const u32x2 w) { f32x4 r; r[0] = __builtin_bit_cast(float, w.x << 16); r[1] = __builtin_bit_cast(float, w.x & 0xffff0000u); r[2] = __builtin_bit_cast(float, w.y << 16); r[3] = __builtin_bit_cast(float, w.y & 0xffff0000u); return r; }
template <bool RB>
struct EpiRes {
    static constexpr bool PERM = false, AFTER_DRAIN = false, PF = false;
    const float* resid; int ldc; float scale; bf16_t* xb; float* ss_out;
    __device__ __forceinline__ void operator()(const f32x4 (&acc)[2][2][4][2], const Unit& u, int wr, int wc, int fr, int fq) const {
        const int row0 = u.pm * BM + wr * 64 + fr, col0 = u.pn * BM + wc * 32 + 4 * fq;
        const float* const resid_ = resid; bf16_t* const xb_ = xb; float* const ss_ = ss_out; const float scale_ = scale; const int ldc_ = ldc;
        f32x4 rs[2][2][2]; u32x2 rb[2][2][2];
#pragma unroll
        for (int bj = 0; bj < 2; ++bj)
#pragma unroll
            for (int n = 0; n < 2; ++n) { const size_t o0 = (size_t)row0 * ldc_ + col0 + bj * HALF + n * 16;
                if constexpr (RB) rb[0][bj][n] = *(const u32x2*)(xb_ + o0); else rs[0][bj][n] = *(const f32x4*)(resid_ + o0); }
#pragma unroll
        for (int gi = 0; gi < 8; ++gi) { const int ai = gi >> 2, m = gi & 3; const int row = row0 + ai * HALF + m * 16; const size_t off = (size_t)row * ldc_ + col0;
            if (gi < 7) { const size_t offn = (size_t)(row0 + ((gi + 1) >> 2) * HALF + ((gi + 1) & 3) * 16) * ldc_ + col0;
#pragma unroll
                for (int bj = 0; bj < 2; ++bj)
#pragma unroll
                    for (int n = 0; n < 2; ++n) { if constexpr (RB) rb[(gi + 1) & 1][bj][n] = *(const u32x2*)(xb_ + offn + bj * HALF + n * 16); else rs[(gi + 1) & 1][bj][n] = *(const f32x4*)(resid_ + offn + bj * HALF + n * 16); } }
            float q = 0.f;
#pragma unroll
            for (int bj = 0; bj < 2; ++bj)
#pragma unroll
                for (int n = 0; n < 2; ++n) { f32x4 r; if constexpr (RB) r = bf4_to_f32(rb[gi & 1][bj][n]); else r = rs[gi & 1][bj][n];
                    const f32x4 o = r + acc[ai][bj][m][n] * scale_;
                    u32x2 w; w.x = cvt_pk_bf16(o[0], o[1]); w.y = cvt_pk_bf16(o[2], o[3]);
                    *(u32x2*)(xb_ + off + bj * HALF + n * 16) = w;
                    q += (o[0] * o[0] + o[1] * o[1]) + (o[2] * o[2] + o[3] * o[3]); }
            q += __shfl_xor(q, 16); q += __shfl_xor(q, 32);
            if (fq == 0) __hip_atomic_fetch_add((__attribute__((address_space(1))) float*)(ss_ + row), q, __ATOMIC_RELAXED, __HIP_MEMORY_SCOPE_AGENT);
            asm volatile("" ::: "memory"); }
    }
};
struct EpiKpe {
    static constexpr bool PERM = true, AFTER_DRAIN = false, PF = false;
    float* P; int Mrows; const float* ss;
    __device__ __forceinline__ void operator()(const f32x4 (&acc)[2][2][4][2], const Unit& u, int wr, int wc, int fr, int fq) const {
        if (wc >= 2) return;
        const int row0 = u.pm * BM + wr * 64 + fr, col0 = wc * 32 + 8 * fq;
#pragma unroll
        for (int ai = 0; ai < 2; ++ai)
#pragma unroll
            for (int m = 0; m < 4; ++m) { const int row = row0 + ai * HALF + m * 16; const float rs = row_rstd(ss, row); float* dst = P + ((size_t)u.pn * Mrows + row) * 64 + col0;
                *(f32x4*)dst = acc[ai][0][m][0] * rs; *(f32x4*)(dst + 4) = acc[ai][0][m][1] * rs; }
    }
};
struct EpiF32 {
    static constexpr bool PERM = false, AFTER_DRAIN = false, PF = false;
    float* C; int ldc;
    __device__ __forceinline__ void operator()(const f32x4 (&acc)[2][2][4][2], const Unit& u, int wr, int wc, int fr, int fq) const {
        const int row0 = u.pm * BM + wr * 64 + fr, col0 = u.pn * BM + wc * 32 + 4 * fq;
#pragma unroll
        for (int ai = 0; ai < 2; ++ai)
#pragma unroll
            for (int m = 0; m < 4; ++m) { float* rowp = C + (size_t)(row0 + ai * HALF + m * 16) * ldc + col0;
#pragma unroll
                for (int bj = 0; bj < 2; ++bj)
#pragma unroll
                    for (int n = 0; n < 2; ++n) *(f32x4*)(rowp + bj * HALF + n * 16) = acc[ai][bj][m][n]; }
    }
};
struct EpiBf16NP {
    static constexpr bool PERM = false, AFTER_DRAIN = false, PF = false;
    bf16_t* C; int ldc;
    __device__ __forceinline__ void operator()(const f32x4 (&acc)[2][2][4][2], const Unit& u, int wr, int wc, int fr, int fq) const {
        const int row0 = u.pm * BM + wr * 64 + fr, col0 = u.pn * BM + wc * 32 + 4 * fq;
#pragma unroll
        for (int ai = 0; ai < 2; ++ai)
#pragma unroll
            for (int m = 0; m < 4; ++m) { bf16_t* rowp = C + (size_t)(row0 + ai * HALF + m * 16) * ldc + col0;
#pragma unroll
                for (int bj = 0; bj < 2; ++bj)
#pragma unroll
                    for (int n = 0; n < 2; ++n) { const f32x4 v = acc[ai][bj][m][n]; u32x2 w; w.x = cvt_pk_bf16(v[0], v[1]); w.y = cvt_pk_bf16(v[2], v[3]); *(u32x2*)(rowp + bj * HALF + n * 16) = w; } }
    }
};
struct EpiPle {
    static constexpr bool PERM = false, AFTER_DRAIN = false, PF = false;
    const bf16_t* x; const bf16_t* P; float* out; int ldc; const float* ss;
    __device__ __forceinline__ void operator()(const f32x4 (&acc)[2][2][4][2], const Unit& u, int wr, int wc, int fr, int fq) const {
        const int row0 = u.pm * BM + wr * 64 + fr, col0 = u.pn * BM + wc * 32 + 4 * fq;
        const bf16_t* const x_ = x; const bf16_t* const P_ = P; float* const out_ = out; const int ldc_ = ldc;
        float rs8[2][4];
        load_rstd8(rs8, ss, row0);
        u32x2 xs[2][2], ps[2][2];
#pragma unroll
        for (int n = 0; n < 2; ++n) { xs[0][n] = *(const u32x2*)(x_ + (size_t)row0 * ldc_ + col0 + n * 16); ps[0][n] = *(const u32x2*)(P_ + (size_t)row0 * ldc_ + col0 + n * 16); }
#pragma unroll
        for (int st = 0; st < 16; ++st) { const int ai = st >> 3, m = (st >> 1) & 3, bj = st & 1; const size_t off = (size_t)(row0 + ai * HALF + m * 16) * ldc_ + col0 + bj * HALF; const float rsd = rs8[ai][m];
            if (st < 15) { const int s2 = st + 1; const size_t offn = (size_t)(row0 + (s2 >> 3) * HALF + ((s2 >> 1) & 3) * 16) * ldc_ + col0 + (s2 & 1) * HALF;
#pragma unroll
                for (int n = 0; n < 2; ++n) { xs[s2 & 1][n] = *(const u32x2*)(x_ + offn + n * 16); ps[s2 & 1][n] = *(const u32x2*)(P_ + offn + n * 16); } }
#pragma unroll
            for (int n = 0; n < 2; ++n) { const f32x4 xv = bf4_to_f32(xs[st & 1][n]), pv = bf4_to_f32(ps[st & 1][n]); f32x4 o;
#pragma unroll
                for (int e = 0; e < 4; ++e) o[e] = xv[e] + fast_sigmoid(acc[ai][bj][m][n][e] * rsd) * pv[e];
                *(f32x4*)(out_ + off + n * 16) = o; }
            asm volatile("" ::: "memory"); }
    }
};

template <class Epi, class Sched, bool ALIGN_EPI = false, bool SP2 = false>
__device__ __forceinline__ void gemm_phase(PG8_LAS unsigned char* lds, const Gemm g, const Sched S, const Epi E) {
    const int tid = threadIdx.x, wid = __builtin_amdgcn_readfirstlane(tid >> 6), lane = tid & 63, wr = wid >> 2, wc = wid & 3, fr = lane & 15, fq = lane >> 4;
    const int K = g.K, nt = K / BK, LD = g.ld ? g.ld : K;
    unsigned voffA[2], voffB[2];
#pragma unroll
    for (int i = 0; i < 2; ++i) { int R, C; stage_rc(tid * 16 + i * 8192, R, C); const int Rb = Epi::PERM ? ((R & ~31) + perm32(R & 31)) : R;
        voffA[i] = (unsigned)(R * LD + C) * 2u; voffB[i] = (unsigned)(Rb * LD + C) * 2u; }
    const size_t kstep = (size_t)(BK * 2);
    const size_t hstep = (size_t)HALF * LD * 2;
    const size_t tstep = 2 * hstep;
    const unsigned ldsw = (unsigned)wid * 1024u;
    const int aoff = lds_byte(wr * 64 + fr, fq * 8), boff = lds_byte(wc * 32 + fr, fq * 8);
#define PG8_SA(b, h) (((b) * 2 + (h)) * HTB)
#define PG8_SB(b, h) ((4 + (b) * 2 + (h)) * HTB)
#define PG8_STAGE(bufoff, gbase, voff) do { _Pragma("unroll") for (int _i = 0; _i < 2; ++_i) \
        __builtin_amdgcn_global_load_lds((const unsigned*)((const char*)(gbase) + (voff)[_i]), (PG8_LAS unsigned*)(lds + (bufoff) + ldsw + _i * 8192), 16, 0, 0); } while (0)
#define PG8_LDA(dst, b, h) do { _Pragma("unroll") for (int m = 0; m < 4; ++m) _Pragma("unroll") for (int k = 0; k < 2; ++k) dst[m][k] = *(const PG8_LAS bf16x8*)(lds + PG8_SA(b, h) + aoff + m * 2048 + k * 1024); } while (0)
#define PG8_LDB(dst, b, h) do { _Pragma("unroll") for (int n = 0; n < 2; ++n) _Pragma("unroll") for (int k = 0; k < 2; ++k) dst[n][k] = *(const PG8_LAS bf16x8*)(lds + PG8_SB(b, h) + boff + n * 2048 + k * 1024); } while (0)
#define PG8_MMA(ai, bj, At, Bt) do { __builtin_amdgcn_s_setprio(1); _Pragma("unroll") for (int m = 0; m < 4; ++m) _Pragma("unroll") for (int n = 0; n < 2; ++n) _Pragma("unroll") for (int k = 0; k < 2; ++k) \
        acc[ai][bj][m][n] = __builtin_amdgcn_mfma_f32_16x16x32_bf16(Bt[n][k], At[m][k], acc[ai][bj][m][n], 0, 0, 0); __builtin_amdgcn_s_setprio(0); } while (0)
#define PG8_WAIT_V(n) asm volatile("s_waitcnt vmcnt(" #n ")" ::: "memory")
#define PG8_WAIT_L(n) asm volatile("s_waitcnt lgkmcnt(" #n ")" ::: "memory")
#define PG8_BAR __builtin_amdgcn_s_barrier()
#define PG8_SCHED __builtin_amdgcn_sched_barrier(0)
    Unit cur, nxt; int ui = 0;
    if (!S.next(0, cur)) return;
    f32x4 acc[2][2][4][2];
#pragma unroll
    for (int a = 0; a < 2; ++a)
#pragma unroll
        for (int b = 0; b < 2; ++b)
#pragma unroll
            for (int m = 0; m < 4; ++m)
#pragma unroll
                for (int n = 0; n < 2; ++n) acc[a][b][m][n] = (f32x4){0.f, 0.f, 0.f, 0.f};
    bf16x8 At[4][2], B0[2][2], B1[2][2];
    const size_t bstep = g.kofs ? g.kofs : tstep;
    const char* cA = (const char*)g.A + (size_t)cur.pm * tstep + (size_t)cur.pn * g.kofs; const char* cB = (const char*)g.Bt + (size_t)cur.pn * bstep;
    S.a_ready(cur);
    if constexpr (SP2) {
        PG8_STAGE(PG8_SB(0, 0), cB, voffB); PG8_STAGE(PG8_SB(0, 1), cB + hstep, voffB); PG8_STAGE(PG8_SA(0, 0), cA, voffA); PG8_STAGE(PG8_SA(0, 1), cA + hstep, voffA);
        if (wr == 1) PG8_BAR;
        PG8_WAIT_V(2); PG8_BAR;
        PG8_STAGE(PG8_SB(1, 0), cB + kstep, voffB); PG8_STAGE(PG8_SA(1, 0), cA + kstep, voffA); PG8_STAGE(PG8_SB(1, 1), cB + hstep + kstep, voffB);
        PG8_WAIT_V(6); PG8_BAR;
    } else {
        PG8_STAGE(PG8_SB(0, 0), cB, voffB); PG8_STAGE(PG8_SA(0, 0), cA, voffA); PG8_STAGE(PG8_SB(0, 1), cB + hstep, voffB); PG8_STAGE(PG8_SA(0, 1), cA + hstep, voffA);
        if (wr == 1) PG8_BAR;
        PG8_WAIT_V(4); PG8_BAR;
        PG8_STAGE(PG8_SB(1, 0), cB + kstep, voffB); PG8_STAGE(PG8_SA(1, 0), cA + kstep, voffA); PG8_STAGE(PG8_SB(1, 1), cB + hstep + kstep, voffB);
        PG8_WAIT_V(6); PG8_BAR;
    }
    for (;;) {
        const bool has_next = S.next(ui + 1, nxt);
        const char* nA = has_next ? (const char*)g.A + (size_t)nxt.pm * tstep + (size_t)nxt.pn * g.kofs : cA; const char* nB = has_next ? (const char*)g.Bt + (size_t)nxt.pn * bstep : cB;
        for (int t = 0; t < nt; t += 2) {
            const bool last = (t == nt - 2);
            const char* a1 = cA + (size_t)(t + 1) * kstep;
            const char* a2 = last ? nA : cA + (size_t)(t + 2) * kstep; const char* b2 = last ? nB : cB + (size_t)(t + 2) * kstep;
            const char* a3 = a2 + kstep; const char* b3 = b2 + kstep;
            if (last && has_next) S.a_ready(nxt);
            if constexpr (Epi::PF) { if (last) E.prefetch(lds + STAGE_BYTES + wid * 512, cur, wr, lane); }
            if constexpr (SP2) {
            PG8_LDB(B0, 0, 0); PG8_LDB(B1, 0, 1); PG8_SCHED; PG8_LDA(At, 0, 0); PG8_STAGE(PG8_SA(1, 1), a1 + hstep, voffA);
            PG8_WAIT_V(8); PG8_WAIT_L(0); PG8_BAR; PG8_MMA(0, 0, At, B0); PG8_MMA(0, 1, At, B1); PG8_BAR; PG8_SCHED;
            PG8_LDA(At, 0, 1); PG8_STAGE(PG8_SB(0, 0), b2, voffB); PG8_STAGE(PG8_SB(0, 1), b2 + hstep, voffB); PG8_STAGE(PG8_SA(0, 0), a2, voffA);
            PG8_WAIT_V(8); PG8_WAIT_L(0); PG8_BAR; PG8_MMA(1, 0, At, B0); PG8_MMA(1, 1, At, B1); PG8_BAR; PG8_SCHED;
            PG8_LDB(B0, 1, 0); PG8_LDB(B1, 1, 1); PG8_SCHED; PG8_LDA(At, 1, 0); PG8_STAGE(PG8_SA(0, 1), a2 + hstep, voffA);
            PG8_WAIT_V(8); PG8_WAIT_L(0); PG8_BAR; PG8_MMA(0, 0, At, B0); PG8_MMA(0, 1, At, B1); PG8_BAR; PG8_SCHED;
            PG8_LDA(At, 1, 1); PG8_STAGE(PG8_SB(1, 0), b3, voffB); PG8_STAGE(PG8_SB(1, 1), b3 + hstep, voffB); PG8_STAGE(PG8_SA(1, 0), a3, voffA);
            PG8_WAIT_V(8); PG8_WAIT_L(0); PG8_BAR; PG8_MMA(1, 0, At, B0); PG8_MMA(1, 1, At, B1); PG8_BAR; PG8_SCHED;
            } else {
            PG8_LDB(B0, 0, 0); PG8_SCHED; PG8_LDA(At, 0, 0); PG8_STAGE(PG8_SA(1, 1), a1 + hstep, voffA);
            PG8_WAIT_L(8); PG8_BAR; PG8_WAIT_L(0); PG8_MMA(0, 0, At, B0); PG8_BAR; PG8_SCHED;
            PG8_LDB(B1, 0, 1); PG8_STAGE(PG8_SB(0, 0), b2, voffB);
            PG8_BAR; PG8_WAIT_L(0); PG8_MMA(0, 1, At, B1); PG8_BAR;
            PG8_LDA(At, 0, 1); PG8_STAGE(PG8_SA(0, 0), a2, voffA);
            PG8_BAR; PG8_WAIT_L(0); PG8_MMA(1, 0, At, B0); PG8_BAR; PG8_SCHED;
            PG8_STAGE(PG8_SB(0, 1), b2 + hstep, voffB);
            PG8_WAIT_V(6); PG8_BAR; PG8_MMA(1, 1, At, B1); PG8_BAR;
            PG8_LDB(B0, 1, 0); PG8_SCHED; PG8_LDA(At, 1, 0); PG8_STAGE(PG8_SA(0, 1), a2 + hstep, voffA);
            PG8_WAIT_L(8); PG8_BAR; PG8_WAIT_L(0); PG8_MMA(0, 0, At, B0); PG8_BAR; PG8_SCHED;
            PG8_LDB(B1, 1, 1); PG8_STAGE(PG8_SB(1, 0), b3, voffB);
            PG8_BAR; PG8_WAIT_L(0); PG8_MMA(0, 1, At, B1); PG8_BAR;
            PG8_LDA(At, 1, 1); PG8_STAGE(PG8_SA(1, 0), a3, voffA);
            PG8_BAR; PG8_WAIT_L(0); PG8_MMA(1, 0, At, B0); PG8_BAR; PG8_SCHED;
            PG8_STAGE(PG8_SB(1, 1), b3 + hstep, voffB);
            PG8_WAIT_V(6); PG8_BAR; PG8_MMA(1, 1, At, B1); PG8_BAR;
            }
        }
        if constexpr (ALIGN_EPI) { if (wr == 0) PG8_BAR; }
        if constexpr (!Epi::AFTER_DRAIN) { if constexpr (Epi::PF) E(acc, cur, wr, wc, fr, fq, lds + STAGE_BYTES + wid * 512); else E(acc, cur, wr, wc, fr, fq); S.done(cur); }
        if (!has_next) break;
#pragma unroll
        for (int a = 0; a < 2; ++a)
#pragma unroll
            for (int b = 0; b < 2; ++b)
#pragma unroll
                for (int m = 0; m < 4; ++m)
#pragma unroll
                    for (int n = 0; n < 2; ++n) acc[a][b][m][n] = (f32x4){0.f, 0.f, 0.f, 0.f};
        cur = nxt; cA = nA; cB = nB; ++ui;
        if constexpr (ALIGN_EPI) { if (wr == 1) PG8_BAR; }
    }
    PG8_WAIT_V(0);
    if constexpr (!ALIGN_EPI) { if (wr == 0) PG8_BAR; }
    PG8_BAR;
    if constexpr (Epi::AFTER_DRAIN) { E.fused(acc, cur, wr, wc, fr, fq, lds, wid, lane); S.done(cur); }
#undef PG8_SA
#undef PG8_SB
#undef PG8_STAGE
#undef PG8_LDA
#undef PG8_LDB
#undef PG8_MMA
#undef PG8_WAIT_V
#undef PG8_WAIT_L
#undef PG8_BAR
#undef PG8_SCHED
}
}

#ifndef MK_N_LAUNCHES
#define MK_N_LAUNCHES 1
#endif
#ifndef PROBE_PHASE
#define PROBE_PHASE -1
#endif
#define REP(k) (((k) == PROBE_PHASE) ? 2 : 1)
constexpr int NPH = 16;
constexpr int N_LAUNCHES = MK_N_LAUNCHES;
constexpr int NWAVES = 8, NTHR = 512;
constexpr int BATCH = 2, SEQ = 4096, T = BATCH * SEQ, DM = 2048, FF = 5632, PLE = 256;
constexpr int MLA_H = 8, QKH = 192, VH = 128, QL = 512, KVL = 256;
constexpr int RH = 16, RD = 1024;
constexpr int ZW = 4096;
constexpr int Z_R = 768, Z_K = 1792, Z_V = 2816, Z_LORA = 3840;
constexpr int LW = 3072;
constexpr float EPS = 1e-6f, GN_EPS = 64e-5f;
constexpr float QSCALE = 1.4426950408889634f * 0.07216878364870322f;

constexpr size_t MiB = 1u << 20;
constexpr size_t WS_CTL = 0, CTL_ZERO_BYTES = 1 * MiB;
constexpr size_t WS_ROPE = 1 * MiB;
constexpr size_t WS_BONUS = 2 * MiB;
constexpr size_t WS_WIN = 3 * MiB;
constexpr size_t WS_WQB = 20 * MiB;
constexpr size_t WS_WKVB = WS_WQB + 1536 * 512 * 2;
constexpr size_t WS_WLORA = WS_WKVB + 2048 * 256 * 2;
constexpr size_t WS_WOUT = 25 * MiB;
constexpr size_t WS_WPG = 33 * MiB;
constexpr size_t WS_WPP = 41 * MiB;
constexpr size_t WS_WGU = 42 * MiB;
constexpr size_t WS_WD = 86 * MiB;
constexpr size_t WS_WD2 = 3 * MiB;
static_assert(WS_WD2 + (size_t)2048 * 5632 * 2 <= WS_WOUT && WS_WPP + 2048 * 256 * 2 <= WS_WGU, "ws map 2");
constexpr size_t WS_H = 108 * MiB;
constexpr size_t WS_U = 140 * MiB;
constexpr size_t WS_X = 228 * MiB;
constexpr size_t WS_END = 408 * MiB;
constexpr size_t WS_Z = WS_U, WS_AQ = WS_U + 64 * MiB, WS_AKV = WS_AQ + 8 * MiB, WS_AL = WS_AKV + 4 * MiB, WS_KPEP = WS_AL + 4 * MiB;
constexpr size_t WS_WKPE = WS_WIN + 16 * MiB;
constexpr size_t WS_QRAW = WS_X, WS_KVRAW = WS_X + 24 * MiB, WS_LORA = WS_X + 56 * MiB;
constexpr size_t WS_QH = WS_X + 104 * MiB, WS_KH = WS_X + 128 * MiB, WS_VT = WS_X + 152 * MiB;
constexpr size_t WS_OMIX = WS_X;
constexpr size_t WS_TRT = WS_WGU;
constexpr size_t WS_SLOT = WS_TRT + 32 * MiB;
constexpr size_t WS_RRT = WS_SLOT + 32 * MiB;
constexpr size_t WS_G2T = WS_RRT + 16 * MiB;
constexpr size_t WS_VCG = WS_AQ;
static_assert(WS_G2T + 8 * MiB <= WS_U && WS_VCG + 16 * MiB <= WS_X, "chunk matrices");
constexpr size_t WS_OTMP = WS_X + 32 * MiB;
constexpr size_t WS_AST = WS_X + 172 * MiB;
constexpr size_t WS_PB = WS_X + 168 * MiB, WS_PPLE = WS_X + 8 * MiB;
static_assert(WS_WLORA + 3072 * 256 * 2 <= WS_WOUT && WS_VT + 16 * MiB <= WS_END && WS_AL + 4 * MiB <= WS_X, "ws map");
constexpr int CW_BAR = 4096, CW_QUEUE = 64, CW_SS = 32768;

constexpr int RING_OFF = 0, RING_BYTES = 131072;
constexpr int LDSCTL_OFF = 157696, MISC_OFF = LDSCTL_OFF + 320;
constexpr int LDS_BYTES = 159744;

#define GAS __attribute__((address_space(1)))
#define LAS __attribute__((address_space(3)))
typedef unsigned short bf16;
typedef unsigned v4u __attribute__((ext_vector_type(4)));
typedef unsigned v2u __attribute__((ext_vector_type(2)));
typedef float f32x4 __attribute__((ext_vector_type(4)));
typedef float f32x2 __attribute__((ext_vector_type(2)));
typedef float f32x16 __attribute__((ext_vector_type(16)));
typedef short bf16x8 __attribute__((ext_vector_type(8)));
typedef GAS unsigned gu32;
#define RLX_AGENT __ATOMIC_RELAXED, __HIP_MEMORY_SCOPE_AGENT
#define LDS_WAIT() asm volatile("s_waitcnt lgkmcnt(0)" ::: "memory")
#define VM_WAIT() asm volatile("s_waitcnt vmcnt(0)" ::: "memory")
__device__ __forceinline__ unsigned f2bf(float f) { unsigned u = __builtin_bit_cast(unsigned, f); return (u + 0x7fffu + ((u >> 16) & 1u)) >> 16; }
__device__ __forceinline__ unsigned pk2(float lo, float hi) { return f2bf(lo) | (f2bf(hi) << 16); }
__device__ __forceinline__ float bf2f(unsigned short h) { return __builtin_bit_cast(float, (unsigned)h << 16); }
__device__ __forceinline__ float bflo(unsigned w) { return __builtin_bit_cast(float, w << 16); }
__device__ __forceinline__ float bfhi(unsigned w) { return __builtin_bit_cast(float, w & 0xffff0000u); }
__device__ __forceinline__ float sigmoidf_(float x) { return __builtin_amdgcn_rcpf(1.0f + __builtin_amdgcn_exp2f(-1.4426950408889634f * x)); }
__device__ __forceinline__ float wave_sum(float v) {
#pragma unroll
    for (int o = 1; o < 64; o <<= 1) v += __shfl_xor(v, o);
    return v;
}

#define XB_TMO      128
#define XB_XCNT(j)  (256  + 64 * (j))
#define XB_XSUB(j)  (1280 + 64 * (j))
#define XB_XGEN(j)  (2304 + 64 * (j))
#define XB_TOP      3328
#define XB_TOPGEN   3392
#define XCD_BAR_WORDS 3456
#define XB_SPIN_CAP (1u << 18)

__device__ __forceinline__ unsigned xb_ld(unsigned* p)              { return __hip_atomic_load(p, __ATOMIC_RELAXED, __HIP_MEMORY_SCOPE_AGENT); }
__device__ __forceinline__ unsigned xb_add(unsigned* p, unsigned v) { return __hip_atomic_fetch_add(p, v, __ATOMIC_RELAXED, __HIP_MEMORY_SCOPE_AGENT); }
__device__ __forceinline__ unsigned xb_xcc_id() { return (unsigned)__builtin_amdgcn_s_getreg((3 << 11) | 20) & 0xFu; }
#define XB_SPIN(cond, bar) do { unsigned _sp = 0; while (cond) { __builtin_amdgcn_s_sleep(1); \
    if ((++_sp & 255u) == 0u) { if (xb_ld(&(bar)[XB_TMO])) break; if (_sp > XB_SPIN_CAP) { atomicAdd(&(bar)[XB_TMO], 1u); break; } } } } while (0)

struct XcdBarrier {
    unsigned* bar; unsigned x;
    volatile LAS unsigned* st;
};

__device__ __forceinline__ XcdBarrier xcd_barrier_post(unsigned* bar, volatile LAS unsigned* st) {
    XcdBarrier b; b.bar = bar; b.x = xb_xcc_id(); b.st = st;
    if (threadIdx.x == 0) (void)xb_add(&bar[XB_XCNT(b.x)], 1u);
    return b;
}
__device__ __forceinline__ void xcd_barrier_complete(unsigned* bar, unsigned x, unsigned& nloc, unsigned& nx) {
    const unsigned G = gridDim.x * gridDim.y * gridDim.z;
    unsigned sum, cnt, mine, sp = 0u;
    for (;;) {
        sum = 0u; cnt = 0u; mine = 0u;
#pragma unroll
        for (unsigned j = 0; j < 16; ++j) { const unsigned c = xb_ld(&bar[XB_XCNT(j)]); sum += c; cnt += (c > 0u) ? 1u : 0u; mine = (j == x) ? c : mine; }
        if (sum == G) break;
        __builtin_amdgcn_s_sleep(1);
        if ((++sp & 255u) == 0u) { if (xb_ld(&bar[XB_TMO])) break; if (sp > XB_SPIN_CAP) { atomicAdd(&bar[XB_TMO], 1u); break; } }
    }
    nloc = mine > 0u ? mine : 1u; nx = cnt > 0u ? cnt : 1u;
}

__device__ __forceinline__ void xcd_barrier(const XcdBarrier& b) {
    asm volatile("s_waitcnt vmcnt(0)" ::: "memory");
    __syncthreads();
    if (threadIdx.x == 0) {
        unsigned* bar = b.bar;
        __builtin_amdgcn_s_waitcnt(0);
        unsigned nloc = b.st[0], nx = b.st[1];
        if (nloc == 0u) { xcd_barrier_complete(bar, b.x, nloc, nx); b.st[0] = nloc; b.st[1] = nx; }
        const unsigned old = xb_add(&bar[XB_XSUB(b.x)], 1u);
        const unsigned gen = old / nloc;
        if (old + 1u == (gen + 1u) * nloc) {
            __builtin_amdgcn_fence(__ATOMIC_RELEASE, "agent");
            asm volatile("s_waitcnt vmcnt(0)" ::: "memory");
            const unsigned og = xb_add(&bar[XB_TOP], 1u);
            const unsigned tg = og / nx;
            if (og + 1u == (tg + 1u) * nx) xb_add(&bar[XB_TOPGEN], 1u);
            else XB_SPIN(xb_ld(&bar[XB_TOPGEN]) == tg, bar);
            __builtin_amdgcn_fence(__ATOMIC_ACQUIRE, "agent");
            xb_add(&bar[XB_XGEN(b.x)], 1u);
            asm volatile("s_waitcnt vmcnt(0)" ::: "memory");
        } else {
            XB_SPIN(xb_ld(&bar[XB_XGEN(b.x)]) == gen, bar);
            __builtin_amdgcn_fence(__ATOMIC_ACQUIRE, "agent");
            asm volatile("s_waitcnt vmcnt(0)" ::: "memory");
        }
    }
    __syncthreads();
}


struct Args { const float* in[33]; float* out; unsigned char* ws; int ph_lo, ph_hi; };

struct WJob { const float* W0; const float* W1; const float* gain; bf16* dst; int K, N, NP, KD, koff, mode, LDN, coff, skip_at, skip_by, nlo; };
__device__ __forceinline__ int job_items(const WJob& j) { return (j.KD / 64) * (j.NP / 32); }
__device__ __forceinline__ bf16* tr_load(const WJob& j, int item, int lane, f32x4 (&v)[8]) {
    const int nblk = j.NP / 32, kb = item / nblk, nb = item % nblk, k0 = 64 * kb, n0 = j.nlo + 32 * nb;
    const int g = lane & 7, kc = lane >> 3, np = n0 + 4 * g, kk = k0 + 8 * kc;
    const float* W = j.W0; int col = np + j.coff + (np >= j.skip_at ? j.skip_by : 0); bool nvalid = np < j.N;
    if (j.mode == 1) { const int i = np & 7, jj = np >> 3; const ptrdiff_t dW = j.W1 - j.W0; W = j.W0 + ((i < 4) ? (ptrdiff_t)0 : dW); col = 4 * jj; nvalid = true; }
#pragma unroll
    for (int i = 0; i < 8; ++i) {
        const int k = kk + i - j.koff;
        const bool ok = nvalid && k >= 0 && k < j.K;
        v[i] = (f32x4){0.f, 0.f, 0.f, 0.f};
        if (ok) { v[i] = __builtin_nontemporal_load((const GAS f32x4*)(W + (size_t)k * j.LDN + col)); if (j.gain) v[i] = v[i] * j.gain[k]; }
    }
    return j.dst + (size_t)np * j.KD + kk;
}
__device__ __forceinline__ void tr_store(const WJob& j, const f32x4 (&v)[8], bf16* d) {
#pragma unroll
    for (int q = 0; q < 4; ++q) { v4u o; o.x = pk2(v[0][q], v[1][q]); o.y = pk2(v[2][q], v[3][q]); o.z = pk2(v[4][q], v[5][q]); o.w = pk2(v[6][q], v[7][q]);
        __builtin_nontemporal_store(o, (GAS v4u*)(d + (size_t)q * j.KD)); }
}
__device__ __forceinline__ WJob mk_job(const float* W0, const float* W1, const float* gain, bf16* dst, int K, int N, int NP, int KD, int koff, int mode, int LDN = 0, int coff = 0, int skip_at = 1 << 30, int skip_by = 0, int nlo = 0) {
    WJob j; j.W0 = W0; j.W1 = W1; j.gain = gain; j.dst = dst; j.K = K; j.N = N; j.NP = NP; j.KD = KD; j.koff = koff; j.mode = mode; j.LDN = LDN ? LDN : N; j.coff = coff; j.skip_at = skip_at; j.skip_by = skip_by; j.nlo = nlo; return j;
}
__device__ __forceinline__ void run_job(const WJob& j, int gw, int NGW, int& base, LAS float* scr, int lane) {
    const int n = job_items(j);
    int first = (gw - base) % NGW; if (first < 0) first += NGW;
    (void)scr;
    for (int it = first; it < n; it += 2 * NGW) {
        f32x4 va[8], vb[8]; bf16* db = nullptr; const bool hb = it + NGW < n;
        bf16* da = tr_load(j, it, lane, va);
        if (hb) db = tr_load(j, it + NGW, lane, vb);
        tr_store(j, va, da);
        if (hb) tr_store(j, vb, db);
    }
    base = (base + n) % NGW;
}

__device__ __forceinline__ void rms_row_bf16(const float* xrow, bf16* orow, int lane) {
    const GAS f32x4* xr = (const GAS f32x4*)xrow + lane;
    f32x4 v[8]; float s = 0.f;
#pragma unroll
    for (int j = 0; j < 8; ++j) { v[j] = xr[64 * j]; s += (v[j].x * v[j].x + v[j].y * v[j].y) + (v[j].z * v[j].z + v[j].w * v[j].w); }
    const float rstd = 1.0f / sqrtf(wave_sum(s) * (1.f / DM) + EPS);
    GAS unsigned long long* o8 = (GAS unsigned long long*)orow + lane;
#pragma unroll
    for (int j = 0; j < 8; ++j) o8[64 * j] = (unsigned long long)pk2(v[j].x * rstd, v[j].y * rstd) | ((unsigned long long)pk2(v[j].z * rstd, v[j].w * rstd) << 32);
}
__device__ __forceinline__ void rms_pass(const float* X, bf16* H, int gw, int NGW, int lane) {
    for (int m = gw; m < T; m += NGW) rms_row_bf16(X + (size_t)m * DM, H + (size_t)m * DM, lane);
}
__device__ __forceinline__ void xb_pass(const float* X, bf16* XB, float* ss, int gw, int NGW, int lane) {
    for (int m = gw; m < T; m += 2 * NGW) {
        const int m2 = m + NGW; const bool hb = m2 < T;
        const GAS f32x4* xa = (const GAS f32x4*)(X + (size_t)m * DM) + lane; const GAS f32x4* xb = (const GAS f32x4*)(X + (size_t)(hb ? m2 : m) * DM) + lane;
        f32x4 va[8], vb[8]; float sa = 0.f, sb = 0.f;
#pragma unroll
        for (int j = 0; j < 8; ++j) va[j] = __builtin_nontemporal_load(xa + 64 * j);
#pragma unroll
        for (int j = 0; j < 8; ++j) vb[j] = __builtin_nontemporal_load(xb + 64 * j);
#pragma unroll
        for (int j = 0; j < 8; ++j) { sa += (va[j].x * va[j].x + va[j].y * va[j].y) + (va[j].z * va[j].z + va[j].w * va[j].w); sb += (vb[j].x * vb[j].x + vb[j].y * vb[j].y) + (vb[j].z * vb[j].z + vb[j].w * vb[j].w); }
        sa = wave_sum(sa); sb = wave_sum(sb);
        GAS unsigned long long* oa = (GAS unsigned long long*)(XB + (size_t)m * DM) + lane;
#pragma unroll
        for (int j = 0; j < 8; ++j) oa[64 * j] = (unsigned long long)pk2(va[j].x, va[j].y) | ((unsigned long long)pk2(va[j].z, va[j].w) << 32);
        if (lane == 0) ss[m] = sa;
        if (hb) { GAS unsigned long long* ob = (GAS unsigned long long*)(XB + (size_t)m2 * DM) + lane;
#pragma unroll
            for (int j = 0; j < 8; ++j) ob[64 * j] = (unsigned long long)pk2(vb[j].x, vb[j].y) | ((unsigned long long)pk2(vb[j].z, vb[j].w) << 32);
            if (lane == 0) ss[m2] = sb; }
    }
}

__device__ __forceinline__ void prep_a_row(int t, const bf16* Z, const float* mu, bf16* AQ, bf16* AKV, bf16* AL, int lane) {
    const bf16* zr = Z + (size_t)t * ZW;
    {
        const v4u w = *(const GAS v4u*)(zr + lane * 8);
        float x[8] = {bflo(w.x), bfhi(w.x), bflo(w.y), bfhi(w.y), bflo(w.z), bfhi(w.z), bflo(w.w), bfhi(w.w)};
        float s = 0.f;
#pragma unroll
        for (int e = 0; e < 8; ++e) s += x[e] * x[e];
        const float rstd = 1.0f / sqrtf(wave_sum(s) * (1.f / QL) + EPS);
        v4u o; o.x = pk2(x[0] * rstd, x[1] * rstd); o.y = pk2(x[2] * rstd, x[3] * rstd); o.z = pk2(x[4] * rstd, x[5] * rstd); o.w = pk2(x[6] * rstd, x[7] * rstd);
        *(GAS v4u*)(AQ + (size_t)t * QL + lane * 8) = o;
    }
    {
        const v2u w = *(const GAS v2u*)(zr + QL + lane * 4);
        float x[4] = {bflo(w.x), bfhi(w.x), bflo(w.y), bfhi(w.y)};
        const float s = (x[0] * x[0] + x[1] * x[1]) + (x[2] * x[2] + x[3] * x[3]);
        const float rstd = 1.0f / sqrtf(wave_sum(s) * (1.f / KVL) + EPS);
        v2u o; o.x = pk2(x[0] * rstd, x[1] * rstd); o.y = pk2(x[2] * rstd, x[3] * rstd);
        *(GAS v2u*)(AKV + (size_t)t * KVL + lane * 4) = o;
    }
    {
        const v2u w = *(const GAS v2u*)(zr + Z_LORA + lane * 4);
        v2u wp; wp.x = 0u; wp.y = 0u;
        if ((t % SEQ) != 0) wp = *(const GAS v2u*)(zr - ZW + Z_LORA + lane * 4);
        const f32x4 m4 = *(const GAS f32x4*)(mu + (Z_LORA - Z_R) + lane * 4);
        float c[4] = {bflo(w.x), bfhi(w.x), bflo(w.y), bfhi(w.y)}, p[4] = {bflo(wp.x), bfhi(wp.x), bflo(wp.y), bfhi(wp.y)}, o[4];
#pragma unroll
        for (int e = 0; e < 4; ++e) { const float zs = c[e] + (p[e] - c[e]) * m4[e];
            float r;
            if (lane < 16) r = 1.0f - 2.0f * __builtin_amdgcn_rcpf(__builtin_amdgcn_exp2f(2.8853900817779268f * zs) + 1.0f);
            else if (lane < 32) r = zs;
            else r = sigmoidf_(zs);
            o[e] = r; }
        v2u ow; ow.x = pk2(o[0], o[1]); ow.y = pk2(o[2], o[3]);
        *(GAS v2u*)(AL + (size_t)t * 256 + lane * 4) = ow;
    }
}

template <int CTRL> __device__ __forceinline__ float dpp_add(float x) { return x + __builtin_bit_cast(float, __builtin_amdgcn_update_dpp(0, __builtin_bit_cast(int, x), CTRL, 0xF, 0xF, true)); }
__device__ __forceinline__ float allreduce16(float x) { x = dpp_add<0xB1>(x); x = dpp_add<0x4E>(x); x = dpp_add<0x141>(x); x = dpp_add<0x140>(x); return x; }
__device__ __forceinline__ float wave_sum_dpp(float x) { x = allreduce16(x); x += __shfl_xor(x, 16); x += __shfl_xor(x, 32); return x; }
__device__ __forceinline__ float allreduce64(float x) { x = allreduce16(x); float a_ = x, b_ = x;
    asm volatile("s_nop 1\n\tv_permlane16_swap_b32 %0, %1" : "+v"(a_), "+v"(b_));
    x = a_ + b_; a_ = x; b_ = x;
    asm volatile("s_nop 1\n\tv_permlane32_swap_b32 %0, %1" : "+v"(a_), "+v"(b_));
    return a_ + b_; }
__device__ __forceinline__ void kpe_task(int task, const bf16* XB, const bf16* WK, const float* ss, float* KPE, LAS unsigned char* lds, int tid) {
    const int lane = tid & 63, wv = __builtin_amdgcn_readfirstlane(tid >> 6), r32 = lane & 31, hi = lane >> 5, r0 = task * 32;
    f32x16 acc0, acc1;
#pragma unroll
    for (int r = 0; r < 16; ++r) { acc0[r] = 0.f; acc1[r] = 0.f; }
    const bf16* ap = XB + (size_t)(r0 + r32) * DM + 256 * wv + 8 * hi;
    const bf16* bp0 = WK + (size_t)r32 * DM + 256 * wv + 8 * hi; const bf16* bp1 = bp0 + (size_t)32 * DM;
#pragma unroll
    for (int half = 0; half < 2; ++half) {
        bf16x8 a[8], b0[8], b1[8];
#pragma unroll
        for (int ks = 0; ks < 8; ++ks) { const int ko = (half * 8 + ks) * 16; a[ks] = *(const GAS bf16x8*)(ap + ko); b0[ks] = *(const GAS bf16x8*)(bp0 + ko); b1[ks] = *(const GAS bf16x8*)(bp1 + ko); }
#pragma unroll
        for (int ks = 0; ks < 8; ++ks) { acc0 = __builtin_amdgcn_mfma_f32_32x32x16_bf16(a[ks], b0[ks], acc0, 0, 0, 0); acc1 = __builtin_amdgcn_mfma_f32_32x32x16_bf16(a[ks], b1[ks], acc1, 0, 0, 0); }
    }
    LAS float* red = (LAS float*)lds;
#pragma unroll
    for (int r = 0; r < 16; ++r) { red[(wv * 32 + r) * 64 + lane] = acc0[r]; red[(wv * 32 + 16 + r) * 64 + lane] = acc1[r]; }
    __syncthreads();
#pragma unroll
    for (int q = 0; q < 4; ++q) { const int reg = 4 * wv + q; float s = 0.f;
#pragma unroll
        for (int w = 0; w < 8; ++w) s += red[(w * 32 + reg) * 64 + lane];
        const int tile = reg >> 4, rr = reg & 15, row = r0 + (rr & 3) + 8 * (rr >> 2) + 4 * hi, col = 32 * tile + r32;
        KPE[(size_t)row * 64 + col] = s * __builtin_amdgcn_rsqf(ss[row] * (1.0f / 2048.0f) + 1e-6f); }
    __syncthreads();
}
__device__ __forceinline__ int vpos(int kl) { const int ko = kl & 15; return (kl & 48) + 8 * ((ko >> 2) & 1) + 4 * (ko >> 3) + (ko & 3); }
__device__ __forceinline__ void mla_prep_task(int task, const bf16* QRAW, const bf16* KVRAW, const float* qn, const float* kn, const f32x2* rope,
                                              bf16* Qh, bf16* Kh, bf16* Vt, int lane, const float* KPEP) {
    const int ws = task & 7, tile = (task >> 3) & 63, bh = task >> 9, b = bh >> 3, h = bh & 7;
    const float qg0 = qn[lane], qg1 = qn[64 + lane], qg2 = qn[128 + lane], kg0 = kn[lane], kg1 = kn[64 + lane], kg2 = kn[128 + lane];
    unsigned short qx[8][3], kx[8][2], vx[8][2]; float kpe[8];
#pragma unroll
    for (int i = 0; i < 8; ++i) { const int t = b * SEQ + tile * 64 + ws * 8 + i;
        const bf16* qr = QRAW + (size_t)t * 1536 + h * QKH; const bf16* kr = KVRAW + (size_t)t * 2048 + h * 256;
        qx[i][0] = qr[lane]; qx[i][1] = qr[64 + lane]; qx[i][2] = qr[128 + lane];
        kx[i][0] = kr[lane]; kx[i][1] = kr[64 + lane];
        kpe[i] = KPEP[(size_t)t * 64 + lane];
        vx[i][0] = kr[128 + lane]; vx[i][1] = kr[192 + lane]; }
#pragma unroll
    for (int i = 0; i < 8; ++i) {
        const int kl = ws * 8 + i, s = tile * 64 + kl;
        const f32x2 cs = rope[s * 32 + (lane & 31)];
        const float sgn = (lane < 32) ? -1.0f : 1.0f;
        {   float x0 = bf2f(qx[i][0]), x1 = bf2f(qx[i][1]), x2 = bf2f(qx[i][2]);
            const float rstd = __builtin_amdgcn_rsqf(wave_sum_dpp(x0 * x0 + x1 * x1 + x2 * x2) * (1.f / QKH) + EPS);
            x0 *= rstd * qg0; x1 *= rstd * qg1; x2 *= rstd * qg2;
            const float pr = __shfl_xor(x2, 32);
            x2 = x2 * cs.x + sgn * pr * cs.y;
            bf16* qo = Qh + ((size_t)bh * SEQ + s) * QKH;
            qo[lane] = (bf16)f2bf(x0 * QSCALE); qo[64 + lane] = (bf16)f2bf(x1 * QSCALE); qo[128 + lane] = (bf16)f2bf(x2 * QSCALE); }
        {   float x0 = bf2f(kx[i][0]), x1 = bf2f(kx[i][1]), x2 = kpe[i];
            const float rstd = __builtin_amdgcn_rsqf(wave_sum_dpp(x0 * x0 + x1 * x1 + x2 * x2) * (1.f / QKH) + EPS);
            x0 *= rstd * kg0; x1 *= rstd * kg1; x2 *= rstd * kg2;
            const float pr = __shfl_xor(x2, 32);
            x2 = x2 * cs.x + sgn * pr * cs.y;
            bf16* ko = Kh + ((size_t)bh * SEQ + s) * QKH;
            ko[lane] = (bf16)f2bf(x0); ko[64 + lane] = (bf16)f2bf(x1); ko[128 + lane] = (bf16)f2bf(x2); }
    }
    {   bf16* vt = Vt + ((size_t)bh * 64 + tile) * 8192 + 16 * (ws >> 1) + 4 * (ws & 1);
        v2u a0, a1, c0, c1;
        a0.x = (unsigned)vx[0][0] | ((unsigned)vx[1][0] << 16); a0.y = (unsigned)vx[2][0] | ((unsigned)vx[3][0] << 16);
        a1.x = (unsigned)vx[4][0] | ((unsigned)vx[5][0] << 16); a1.y = (unsigned)vx[6][0] | ((unsigned)vx[7][0] << 16);
        c0.x = (unsigned)vx[0][1] | ((unsigned)vx[1][1] << 16); c0.y = (unsigned)vx[2][1] | ((unsigned)vx[3][1] << 16);
        c1.x = (unsigned)vx[4][1] | ((unsigned)vx[5][1] << 16); c1.y = (unsigned)vx[6][1] | ((unsigned)vx[7][1] << 16);
        *(GAS v2u*)(vt + lane * 64) = a0; *(GAS v2u*)(vt + lane * 64 + 8) = a1;
        *(GAS v2u*)(vt + (64 + lane) * 64) = c0; *(GAS v2u*)(vt + (64 + lane) * 64 + 8) = c1; }
}

namespace att {
constexpr int KROW = 400, VROW = 144, KT = 64 * KROW, VTB = 128 * VROW, BUFB = KT + VTB, WSF_OFF = 2 * BUFB;
static_assert(WSF_OFF + 8 * 32 * 4 <= RING_BYTES, "attention LDS");
static_assert(RING_OFF + pg8::STAGE_BYTES + 8 * 512 <= LDSCTL_OFF, "GEMM epilogue prefetch slots");
__device__ __forceinline__ int crow(int r, int hi) { return (r & 3) + 8 * (r >> 2) + 4 * hi; }
__device__ __forceinline__ bf16x8 pack8(const f32x16& p, int b0) {
    v4u w; w.x = pg8::cvt_pk_bf16(p[b0], p[b0 + 1]); w.y = pg8::cvt_pk_bf16(p[b0 + 2], p[b0 + 3]); w.z = pg8::cvt_pk_bf16(p[b0 + 4], p[b0 + 5]); w.w = pg8::cvt_pk_bf16(p[b0 + 6], p[b0 + 7]);
    return __builtin_bit_cast(bf16x8, w);
}
__device__ __forceinline__ void attn_unit(int bh, int qb, int part, const bf16* Qh, const bf16* Kh, const bf16* Vt, bf16* Odst, int opitch, f32x2* ST, LAS unsigned char* lds) {
    const int tid = threadIdx.x, lane = tid & 63, wid = __builtin_amdgcn_readfirstlane(tid >> 6), r32 = lane & 31, hi = lane >> 5;
    const int b = bh >> 3, h = bh & 7, NTP = 2 * (qb + 1);
    const char* Kg = (const char*)(Kh + (size_t)bh * SEQ * QKH);
    const char* Vg = (const char*)(Vt + (size_t)bh * 64 * 8192);
    const int q0 = qb * 256 + wid * 32;
    bf16x8 qf[12];
    {   const bf16* qp = Qh + ((size_t)bh * SEQ + q0 + r32) * QKH + hi * 8;
#pragma unroll
        for (int ks = 0; ks < 12; ++ks) qf[ks] = *(const GAS bf16x8*)(qp + ks * 16); }
    v4u kst[3], vst[2];
    int kdst[3], vdst[2];
#pragma unroll
    for (int i = 0; i < 3; ++i) { const int c = tid + 512 * i; kdst[i] = (c / 24) * KROW + (c % 24) * 16; }
#pragma unroll
    for (int i = 0; i < 2; ++i) { const int c = tid + 512 * i; vdst[i] = KT + (c >> 3) * VROW + (c & 7) * 16; }
#define ATT_LOAD(j) do { const char* kg = Kg + (size_t)(j) * (64 * QKH * 2); const char* vg = Vg + (size_t)(j) * 16384; \
        _Pragma("unroll") for (int i_ = 0; i_ < 3; ++i_) kst[i_] = *(const GAS v4u*)(kg + (tid + 512 * i_) * 16); \
        _Pragma("unroll") for (int i_ = 0; i_ < 2; ++i_) vst[i_] = *(const GAS v4u*)(vg + (tid + 512 * i_) * 16); } while (0)
#define ATT_STORE(buf) do { LAS unsigned char* bs = lds + (buf) * BUFB; \
        _Pragma("unroll") for (int i_ = 0; i_ < 3; ++i_) *(LAS v4u*)(bs + kdst[i_]) = kst[i_]; \
        _Pragma("unroll") for (int i_ = 0; i_ < 2; ++i_) *(LAS v4u*)(bs + vdst[i_]) = vst[i_]; } while (0)
    ATT_LOAD(part); ATT_STORE(0);
#pragma unroll
    for (int ks = 0; ks < 12; ++ks) asm volatile("" : "+v"(qf[ks]));
    __syncthreads();
    float m = -1e30f, l = 0.f;
    f32x16 o[4];
#pragma unroll
    for (int d = 0; d < 4; ++d)
#pragma unroll
        for (int r = 0; r < 16; ++r) o[d][r] = 0.f;
    LAS float* wsf = (LAS float*)(lds + WSF_OFF) + wid * 32;
    for (int it = 0; it < NTP; ++it) {
        const int j = 2 * it + part;
        if (it + 1 < NTP) ATT_LOAD(j + 2);
        const int k0 = j * 64;
        if (k0 <= q0) {
            const LAS unsigned char* kb = lds + (it & 1) * BUFB; const LAS unsigned char* vb = kb + KT;
            f32x16 p0, p1;
#pragma unroll
            for (int r = 0; r < 16; ++r) { p0[r] = 0.f; p1[r] = 0.f; }
            __builtin_amdgcn_s_setprio(1);
#pragma unroll
            for (int ks = 0; ks < 12; ++ks) {
                const bf16x8 a0 = *(const LAS bf16x8*)(kb + r32 * KROW + ks * 32 + hi * 16);
                const bf16x8 a1 = *(const LAS bf16x8*)(kb + (32 + r32) * KROW + ks * 32 + hi * 16);
                p0 = __builtin_amdgcn_mfma_f32_32x32x16_bf16(a0, qf[ks], p0, 0, 0, 0);
                p1 = __builtin_amdgcn_mfma_f32_32x32x16_bf16(a1, qf[ks], p1, 0, 0, 0);
            }
            __builtin_amdgcn_s_setprio(0);
            if (k0 + 63 > q0) {
                const int q = q0 + r32;
#pragma unroll
                for (int r = 0; r < 16; ++r) { const int key = k0 + crow(r, hi); if (key > q) p0[r] = -1e30f; if (key + 32 > q) p1[r] = -1e30f; }
            }
            float mx = fmaxf(p0[0], p1[0]);
#pragma unroll
            for (int r = 1; r < 16; ++r) mx = fmaxf(mx, fmaxf(p0[r], p1[r]));
            mx = fmaxf(mx, __shfl_xor(mx, 32));
            const float mn = fmaxf(m, mx);
            if (__any(mn > m)) {
                const float al = __builtin_amdgcn_exp2f(m - mn); l *= al; m = mn;
                if (hi == 0) wsf[r32] = al;
                LDS_WAIT();
#pragma unroll
                for (int g = 0; g < 4; ++g) { const f32x4 a4 = *(const LAS f32x4*)(wsf + 8 * g + 4 * hi);
#pragma unroll
                    for (int d = 0; d < 4; ++d)
#pragma unroll
                        for (int e = 0; e < 4; ++e) o[d][4 * g + e] *= a4[e]; }
            }
            float ps = 0.f;
#pragma unroll
            for (int r = 0; r < 16; ++r) { p0[r] = __builtin_amdgcn_exp2f(p0[r] - m); p1[r] = __builtin_amdgcn_exp2f(p1[r] - m); ps += p0[r] + p1[r]; }
            l += ps;
            bf16x8 pa[4]; pa[0] = pack8(p0, 0); pa[1] = pack8(p0, 8); pa[2] = pack8(p1, 0); pa[3] = pack8(p1, 8);
            __builtin_amdgcn_s_setprio(1);
#pragma unroll
            for (int d = 0; d < 4; ++d)
#pragma unroll
                for (int ks = 0; ks < 4; ++ks) {
                    const bf16x8 bv = *(const LAS bf16x8*)(vb + (32 * d + r32) * VROW + ks * 32 + hi * 16);
                    o[d] = __builtin_amdgcn_mfma_f32_32x32x16_bf16(pa[ks], bv, o[d], 0, 0, 0);
                }
            __builtin_amdgcn_s_setprio(0);
        }
        if (it + 1 < NTP) ATT_STORE((it + 1) & 1);
        __syncthreads();
    }
#undef ATT_LOAD
#undef ATT_STORE
    l += __shfl_xor(l, 32);
    const float inv = (l > 0.f) ? 1.0f / l : 0.f;
    if (hi == 0) { wsf[r32] = inv; ST[((size_t)(b * SEQ) + q0 + r32) * MLA_H + h] = (f32x2){m, l}; }
    LDS_WAIT();
    bf16* ob = Odst + ((size_t)(b * SEQ) + q0) * opitch + h * VH + r32;
#pragma unroll
    for (int g = 0; g < 4; ++g) { const f32x4 a4 = *(const LAS f32x4*)(wsf + 8 * g + 4 * hi);
#pragma unroll
        for (int e = 0; e < 4; ++e) { const int row = crow(4 * g + e, hi);
#pragma unroll
            for (int d = 0; d < 4; ++d) ob[(size_t)row * opitch + 32 * d] = (bf16)f2bf(o[d][4 * g + e] * a4[e]); } }
    LDS_WAIT();
}
__device__ __forceinline__ void attn_merge_item(int item, bf16* Omix, const bf16* OTMP, const f32x2* ST, int lane) {
    const int t = item >> 1, h = (item & 1) * 4 + (lane >> 4), dd = (lane & 15) * 8;
    const f32x2 s0 = ST[(size_t)t * MLA_H + h], s1 = ST[(size_t)(T + t) * MLA_H + h];
    const float M = fmaxf(s0.x, s1.x);
    float w0 = s0.y * __builtin_amdgcn_exp2f(s0.x - M), w1 = s1.y * __builtin_amdgcn_exp2f(s1.x - M);
    const float inv = __builtin_amdgcn_rcpf(w0 + w1); w0 *= inv; w1 *= inv;
    bf16* op = Omix + (size_t)t * 2048 + h * VH + dd;
    const v4u a = *(const GAS v4u*)op, bq = *(const GAS v4u*)(OTMP + (size_t)t * 1024 + h * VH + dd);
    v4u o; o.x = pk2(w0 * bflo(a.x) + w1 * bflo(bq.x), w0 * bfhi(a.x) + w1 * bfhi(bq.x)); o.y = pk2(w0 * bflo(a.y) + w1 * bflo(bq.y), w0 * bfhi(a.y) + w1 * bfhi(bq.y));
    o.z = pk2(w0 * bflo(a.z) + w1 * bflo(bq.z), w0 * bfhi(a.z) + w1 * bfhi(bq.z)); o.w = pk2(w0 * bflo(a.w) + w1 * bflo(bq.w), w0 * bfhi(a.w) + w1 * bfhi(bq.w));
    *(GAS v4u*)op = o;
}
}

namespace ck {
constexpr int CH = 32, NCH = SEQ / CH;
constexpr int PCK = 72, PKC = 32, PCC = 32;
constexpr int O_AT = 0, O_BT = 4608, O_KT = 9216, O_RT = 13824;
constexpr int O_P0 = 0, O_PT0 = 2048, O_P1 = 4096, O_PT1 = 6144, O_TT0 = 8192, O_TT1 = 10240, O_MAK = 12288, O_MBRT = 14336, O_G1 = 16384;
constexpr int O_AT2 = 0, O_VKT = 4096;
constexpr int O_ATT = 18432, O_RTT = 22528, O_BBT = 26624, O_KBT = 30720, O_VC = 34816, O_GC = 38912;
constexpr int UNIT_LDS = 39424, UNITS_PER_WG = 4;
static_assert(O_GC + 256 <= UNIT_LDS && UNITS_PER_WG * UNIT_LDS <= LDSCTL_OFF, "chunk_pre LDS");
typedef float ck_f32x2 __attribute__((ext_vector_type(2))); typedef __bf16 ck_bf16x2 __attribute__((ext_vector_type(2)));
__device__ __forceinline__ unsigned cvt2(float lo, float hi) { ck_f32x2 v = {lo, hi}; ck_bf16x2 b = __builtin_convertvector(v, ck_bf16x2); return __builtin_bit_cast(unsigned, b); }
__device__ __forceinline__ int crow(int r, int hi) { return (r & 3) + 8 * (r >> 2) + 4 * hi; }
__device__ __forceinline__ void zero16(f32x16& a) {
#pragma unroll
    for (int r = 0; r < 16; ++r) a[r] = 0.f; }
template <int KD> __device__ __forceinline__ void mm(f32x16& acc, const LAS unsigned char* X, int px, int xr0, const LAS unsigned char* YT, int py, int yr0, int r32, int hi) {
#pragma unroll
    for (int ks = 0; ks < KD / 16; ++ks) {
        const bf16x8 a = *(const LAS bf16x8*)(X + ((xr0 + r32) * px + ks * 16 + 8 * hi) * 2);
        const bf16x8 b = *(const LAS bf16x8*)(YT + ((yr0 + r32) * py + ks * 16 + 8 * hi) * 2);
        acc = __builtin_amdgcn_mfma_f32_32x32x16_bf16(a, b, acc, 0, 0, 0);
    }
}
__device__ __forceinline__ void storeT(const f32x16& acc, LAS unsigned char* dst, int pd, int r0, int c0, int r32, int hi) {
#pragma unroll
    for (int g = 0; g < 4; ++g) { v2u w; w.x = cvt2(acc[4 * g], acc[4 * g + 1]); w.y = cvt2(acc[4 * g + 2], acc[4 * g + 3]);
        *(LAS v2u*)(dst + ((r0 + r32) * pd + c0 + 8 * g + 4 * hi) * 2) = w; }
}
__device__ __forceinline__ void storeTg(const f32x16& acc, bf16* dst, int pd, int r0, int c0, int r32, int hi) {
#pragma unroll
    for (int g = 0; g < 4; ++g) { v2u w; w.x = cvt2(acc[4 * g], acc[4 * g + 1]); w.y = cvt2(acc[4 * g + 2], acc[4 * g + 3]);
        *(GAS v2u*)(dst + (size_t)(r0 + r32) * pd + c0 + 8 * g + 4 * hi) = w; }
}
__device__ __forceinline__ bf16x8 idfrag(int ks, int r32, int hi) {
    bf16x8 f;
#pragma unroll
    for (int j = 0; j < 8; ++j) f[j] = (ks * 16 + 8 * hi + j == r32) ? (short)0x3F80 : (short)0;
    return f;
}

struct Bat { unsigned short zr[8], zk[8], zv[8], lw[8], la[8]; };
#define CKA_LOAD(B, zp_, lp_, tb) do { _Pragma("unroll") for (int i = 0; i < 8; ++i) { const bf16* z1 = (zp_) + (size_t)((tb) + i) * ZW; B.zr[i] = z1[Z_R]; B.zk[i] = z1[Z_K]; B.zv[i] = z1[Z_V]; \
            B.lw[i] = (lp_)[(size_t)((tb) + i) * LW]; B.la[i] = (lp_)[(size_t)((tb) + i) * LW + 1024]; } } while (0)
__device__ __forceinline__ void preload(int unit, const bf16* Z, const bf16* L, Bat& B0, Bat& B1, unsigned short& qr, unsigned short& qk, unsigned short& qv, int lane) {
    const int chain = unit >> 7, c = unit & 127, b = chain >> 4, h = chain & 15, ch = h * 64 + lane, t0 = b * SEQ + c * CH;
    const bf16* zp = Z + (size_t)t0 * ZW + ch; const bf16* lp = L + (size_t)t0 * LW + ch;
    qr = 0; qk = 0; qv = 0;
    if (c > 0) { qr = zp[Z_R - ZW]; qk = zp[Z_K - ZW]; qv = zp[Z_V - ZW]; }
    CKA_LOAD(B0, zp, lp, 0); CKA_LOAD(B1, zp, lp, 8);
}
__device__ __forceinline__ void chunk_pre(int unit, const bf16* Z, const bf16* L, const float* mu, const float* w0, const float* a0, const float* k_k, const float* k_a, const float* r_k,
                                          float* BONUS, bf16* TRT, unsigned* SLOT, bf16* RRT, bf16* G2T, bf16* VCG, LAS unsigned char* lds, int lane,
                                          Bat& B0, Bat& B1, unsigned short& qr, unsigned short& qk, unsigned short& qv, int nxt) {
    const int chain = unit >> 7, c = unit & 127, b = chain >> 4, h = chain & 15, ch = h * 64 + lane, r32 = lane & 31, hi = lane >> 5;
    const int t0 = b * SEQ + c * CH;
    LAS bf16* At = (LAS bf16*)(lds + O_AT); LAS bf16* Bt = (LAS bf16*)(lds + O_BT); LAS bf16* Kt = (LAS bf16*)(lds + O_KT); LAS bf16* Rt = (LAS bf16*)(lds + O_RT);
    LAS bf16* AtT = (LAS bf16*)(lds + O_ATT); LAS bf16* RtT = (LAS bf16*)(lds + O_RTT); LAS bf16* BbT = (LAS bf16*)(lds + O_BBT); LAS bf16* KbT = (LAS bf16*)(lds + O_KBT);
    LAS bf16* Vc = (LAS bf16*)(lds + O_VC);
    {
        const float mu_r = mu[ch], mu_k = mu[1024 + ch], mu_v = mu[2048 + ch], w0c = w0[ch], a0c = a0[ch], kkc = k_k[ch], kac = k_a[ch], rkc = r_k[ch];
        const bf16* zp = Z + (size_t)t0 * ZW + ch; const bf16* lp = L + (size_t)t0 * LW + ch;
        float pr = bf2f(qr), pk = bf2f(qk), pv = bf2f(qv);
        float gam = 1.0f, mybon = 0.f;
        unsigned aRow = (unsigned)(size_t)(At + lane), aCol = (unsigned)(size_t)(AtT + lane * PKC);
        asm volatile("" : "+v"(aRow), "+v"(aCol));
#define CK_W16(base, off, v) (*(LAS bf16*)(size_t)((base) + (unsigned)(off)) = (v))
#define CKA_PROC(B, tb) do { unsigned short at8[8], rt8[8], vv8[8]; \
        _Pragma("unroll") for (int hf = 0; hf < 2; ++hf) { float r4[4], dec4[4], a4[4], kk4[4], kp4[4], n24[4], bo4[4]; \
        _Pragma("unroll") for (int j = 0; j < 4; ++j) { const int i = 4 * hf + j; \
            const float rc = bf2f(B.zr[i]), kc = bf2f(B.zk[i]), vc = bf2f(B.zv[i]); \
            r4[j] = rc + (pr - rc) * mu_r; const float k_ = kc + (pk - kc) * mu_k; vv8[i] = (unsigned short)(cvt2(vc + (pv - vc) * mu_v, 0.f) & 0xffffu); \
            pr = rc; pk = kc; pv = vc; \
            dec4[j] = __builtin_amdgcn_exp2f(-0.8750612633917001f * sigmoidf_(w0c + bf2f(B.lw[i]))); \
            a4[j] = sigmoidf_(a0c + bf2f(B.la[i])); \
            kk4[j] = k_ * kkc; n24[j] = kk4[j] * kk4[j]; \
            kp4[j] = k_ * (1.0f + (a4[j] - 1.0f) * kac); bo4[j] = r4[j] * kp4[j] * rkc; } \
        _Pragma("unroll") for (int j = 0; j < 4; ++j) { n24[j] = wave_sum_dpp(n24[j]); bo4[j] = wave_sum_dpp(bo4[j]); }     \
        _Pragma("unroll") for (int j = 0; j < 4; ++j) { const int i = 4 * hf + j, t = (tb) + i; \
            const float kk = kk4[j] * __builtin_amdgcn_rsqf(fmaxf(n24[j], 1e-24f)); \
            mybon = (lane == t) ? bo4[j] : mybon; \
            const float gprev = gam; gam *= dec4[j]; const float ig = __builtin_amdgcn_rcpf(gam); \
            const unsigned ar = cvt2(-gprev * kk, gam * r4[j]), bk = cvt2(kk * a4[j] * ig, kp4[j] * ig); \
            at8[i] = (unsigned short)(ar & 0xffffu); rt8[i] = (unsigned short)(ar >> 16); \
            CK_W16(aRow, t * PCK * 2, at8[i]); \
            CK_W16(aRow, (O_BT - O_AT) + t * PCK * 2, (bf16)(bk & 0xffffu)); CK_W16(aRow, (O_KT - O_AT) + t * PCK * 2, (bf16)(bk >> 16)); \
            CK_W16(aRow, (O_RT - O_AT) + t * PCK * 2, rt8[i]); } } \
          \
        { v4u q_; q_.x = at8[0] | ((unsigned)at8[1] << 16); q_.y = at8[2] | ((unsigned)at8[3] << 16); q_.z = at8[4] | ((unsigned)at8[5] << 16); q_.w = at8[6] | ((unsigned)at8[7] << 16); \
          *(LAS v4u*)(size_t)(aCol + (unsigned)((tb) * 2)) = q_; \
          q_.x = rt8[0] | ((unsigned)rt8[1] << 16); q_.y = rt8[2] | ((unsigned)rt8[3] << 16); q_.z = rt8[4] | ((unsigned)rt8[5] << 16); q_.w = rt8[6] | ((unsigned)rt8[7] << 16); \
          *(LAS v4u*)(size_t)(aCol + (unsigned)((O_RTT - O_ATT) + (tb) * 2)) = q_; \
          q_.x = vv8[0] | ((unsigned)vv8[1] << 16); q_.y = vv8[2] | ((unsigned)vv8[3] << 16); q_.z = vv8[4] | ((unsigned)vv8[5] << 16); q_.w = vv8[6] | ((unsigned)vv8[7] << 16); \
          *(LAS v4u*)(size_t)(aCol + (unsigned)((O_VC - O_ATT) + (tb) * 2)) = q_; } } while (0)
        CKA_PROC(B0, 0); asm volatile("" ::: "memory"); CKA_LOAD(B0, zp, lp, 16); asm volatile("" ::: "memory");
        CKA_PROC(B1, 8); asm volatile("" ::: "memory"); CKA_LOAD(B1, zp, lp, 24); asm volatile("" ::: "memory");
        CKA_PROC(B0, 16); asm volatile("" ::: "memory"); CKA_PROC(B1, 24); asm volatile("" ::: "memory");
#undef CKA_PROC
#undef CK_W16
        if (lane < CH) BONUS[(size_t)(t0 + lane) * RH + h] = mybon;
        const float gcr = bf2f((bf16)(cvt2(gam, 0.f) & 0xffffu));
        ((LAS float*)(lds + O_GC))[lane] = gcr;
#pragma unroll
        for (int t = 0; t < CH; t += 8) { v4u qb, qk;
            qb.x = cvt2(bf2f(Bt[t * PCK + lane]) * gam, bf2f(Bt[(t + 1) * PCK + lane]) * gam); qb.y = cvt2(bf2f(Bt[(t + 2) * PCK + lane]) * gam, bf2f(Bt[(t + 3) * PCK + lane]) * gam);
            qb.z = cvt2(bf2f(Bt[(t + 4) * PCK + lane]) * gam, bf2f(Bt[(t + 5) * PCK + lane]) * gam); qb.w = cvt2(bf2f(Bt[(t + 6) * PCK + lane]) * gam, bf2f(Bt[(t + 7) * PCK + lane]) * gam);
            qk.x = cvt2(bf2f(Kt[t * PCK + lane]) * gam, bf2f(Kt[(t + 1) * PCK + lane]) * gam); qk.y = cvt2(bf2f(Kt[(t + 2) * PCK + lane]) * gam, bf2f(Kt[(t + 3) * PCK + lane]) * gam);
            qk.z = cvt2(bf2f(Kt[(t + 4) * PCK + lane]) * gam, bf2f(Kt[(t + 5) * PCK + lane]) * gam); qk.w = cvt2(bf2f(Kt[(t + 6) * PCK + lane]) * gam, bf2f(Kt[(t + 7) * PCK + lane]) * gam);
            *(LAS v4u*)(BbT + lane * PKC + t) = qb; *(LAS v4u*)(KbT + lane * PKC + t) = qk; }
    }
    f32x16 accM, accMT, accG2, accT, accMakT, accMbr;
    zero16(accM); zero16(accMT); zero16(accMakT); zero16(accMbr); zero16(accG2);
    mm<64>(accM, lds + O_BT, PCK, 0, lds + O_AT, PCK, 0, r32, hi);
    mm<64>(accMT, lds + O_AT, PCK, 0, lds + O_BT, PCK, 0, r32, hi);
    mm<64>(accMakT, lds + O_AT, PCK, 0, lds + O_KT, PCK, 0, r32, hi);
    mm<64>(accMbr, lds + O_BT, PCK, 0, lds + O_RT, PCK, 0, r32, hi);
    mm<64>(accG2, lds + O_KT, PCK, 0, lds + O_RT, PCK, 0, r32, hi);
#pragma unroll
    for (int r = 0; r < 16; ++r) { const int row = crow(r, hi);
        accM[r] = (row < r32) ? accM[r] : 0.f; accMT[r] = (r32 < row) ? accMT[r] : 0.f; accMakT[r] = (r32 < row) ? accMakT[r] : 0.f;
        accMbr[r] = (row <= r32) ? accMbr[r] : 0.f; accG2[r] = (row <= r32) ? accG2[r] : 0.f; }
    asm volatile("" : "+v"(accM), "+v"(accMT), "+v"(accMakT), "+v"(accMbr), "+v"(accG2));
    storeT(accMT, lds + O_P0, PCC, 0, 0, r32, hi);
    storeT(accM, lds + O_PT0, PCC, 0, 0, r32, hi);
    storeT(accMakT, lds + O_MAK, PCC, 0, 0, r32, hi);
    storeT(accMbr, lds + O_MBRT, PCC, 0, 0, r32, hi);
    accT = accM;
#pragma unroll
    for (int r = 0; r < 16; ++r) if (crow(r, hi) == r32) accT[r] += 1.0f;
    storeT(accT, lds + O_TT0, PCC, 0, 0, r32, hi);
    if (nxt >= 0) preload(nxt, Z, L, B0, B1, qr, qk, qv, lane);
    {   f32x16 aP, aPT;
        zero16(aP); zero16(aPT);
        mm<32>(aP, lds + O_P0, PCC, 0, lds + O_PT0, PCC, 0, r32, hi); mm<32>(aPT, lds + O_PT0, PCC, 0, lds + O_P0, PCC, 0, r32, hi);
        storeT(aPT, lds + O_P1, PCC, 0, 0, r32, hi); storeT(aP, lds + O_PT1, PCC, 0, 0, r32, hi);
        mm<32>(accT, lds + O_P1, PCC, 0, lds + O_TT0, PCC, 0, r32, hi); storeT(accT, lds + O_TT1, PCC, 0, 0, r32, hi);
        zero16(aP); zero16(aPT);
        mm<32>(aP, lds + O_P1, PCC, 0, lds + O_PT1, PCC, 0, r32, hi); mm<32>(aPT, lds + O_PT1, PCC, 0, lds + O_P1, PCC, 0, r32, hi);
        storeT(aPT, lds + O_P0, PCC, 0, 0, r32, hi); storeT(aP, lds + O_PT0, PCC, 0, 0, r32, hi);
        mm<32>(accT, lds + O_P0, PCC, 0, lds + O_TT1, PCC, 0, r32, hi); storeT(accT, lds + O_TT0, PCC, 0, 0, r32, hi);
        zero16(aP); zero16(aPT);
        mm<32>(aP, lds + O_P0, PCC, 0, lds + O_PT0, PCC, 0, r32, hi); mm<32>(aPT, lds + O_PT0, PCC, 0, lds + O_P0, PCC, 0, r32, hi);
        storeT(aPT, lds + O_P1, PCC, 0, 0, r32, hi); storeT(aP, lds + O_PT1, PCC, 0, 0, r32, hi);
        mm<32>(accT, lds + O_P1, PCC, 0, lds + O_TT0, PCC, 0, r32, hi); storeT(accT, lds + O_TT1, PCC, 0, 0, r32, hi);
        zero16(aPT);
        mm<32>(aPT, lds + O_PT1, PCC, 0, lds + O_P1, PCC, 0, r32, hi);
        storeT(aPT, lds + O_P0, PCC, 0, 0, r32, hi);
        mm<32>(accT, lds + O_P0, PCC, 0, lds + O_TT1, PCC, 0, r32, hi); storeT(accT, lds + O_TT0, PCC, 0, 0, r32, hi);
    }
    {   f32x16 acc; zero16(acc);
        mm<32>(acc, lds + O_TT0, PCC, 0, lds + O_MAK, PCC, 0, r32, hi);
        storeT(acc, lds + O_G1, PCC, 0, 0, r32, hi);
#pragma unroll
        for (int kb = 0; kb < 2; ++kb) { zero16(acc);
            mm<32>(acc, lds + O_TT0, PCC, 0, lds + O_ATT, PKC, 32 * kb, r32, hi);
            storeT(acc, lds + O_AT2, PKC, 32 * kb, 0, r32, hi); }
        mm<32>(accG2, lds + O_G1, PCC, 0, lds + O_MBRT, PCC, 0, r32, hi);
        storeTg(accG2, G2T + (size_t)unit * 1024, 32, 0, 0, r32, hi);
        const bf16x8 id0 = idfrag(0, r32, hi), id1 = idfrag(1, r32, hi);
#pragma unroll
        for (int kb = 0; kb < 2; ++kb) { zero16(acc);
            mm<32>(acc, lds + O_AT2, PKC, 32 * kb, lds + O_MBRT, PCC, 0, r32, hi);
            acc = __builtin_amdgcn_mfma_f32_32x32x16_bf16(*(const LAS bf16x8*)(lds + O_RTT + ((32 * kb + r32) * PKC + 8 * hi) * 2), id0, acc, 0, 0, 0);
            acc = __builtin_amdgcn_mfma_f32_32x32x16_bf16(*(const LAS bf16x8*)(lds + O_RTT + ((32 * kb + r32) * PKC + 16 + 8 * hi) * 2), id1, acc, 0, 0, 0);
            storeTg(acc, RRT + (size_t)unit * 2048, 64, 0, 32 * kb, r32, hi); }
        const float gcv0 = ((const LAS float*)(lds + O_GC))[r32], gcv1 = ((const LAS float*)(lds + O_GC))[32 + r32];
#pragma unroll
        for (int rb = 0; rb < 2; ++rb)
#pragma unroll
            for (int cb = 0; cb < 2; ++cb) { zero16(acc);
                mm<32>(acc, lds + O_AT2, PKC, 32 * rb, lds + O_BBT, PKC, 32 * cb, r32, hi);
                if (rb == cb) { const float gv = cb ? gcv1 : gcv0;
#pragma unroll
                    for (int r = 0; r < 16; ++r) if (crow(r, hi) == r32) acc[r] += gv; }
                storeTg(acc, TRT + (size_t)unit * 4096, 64, 32 * cb, 32 * rb, r32, hi); }
#pragma unroll
        for (int cb = 0; cb < 2; ++cb) { zero16(acc);
            mm<32>(acc, lds + O_G1, PCC, 0, lds + O_BBT, PKC, 32 * cb, r32, hi);
            acc = __builtin_amdgcn_mfma_f32_32x32x16_bf16(id0, *(const LAS bf16x8*)(lds + O_KBT + ((32 * cb + r32) * PKC + 8 * hi) * 2), acc, 0, 0, 0);
            acc = __builtin_amdgcn_mfma_f32_32x32x16_bf16(id1, *(const LAS bf16x8*)(lds + O_KBT + ((32 * cb + r32) * PKC + 16 + 8 * hi) * 2), acc, 0, 0, 0);
            storeT(acc, lds + O_VKT, PKC, 32 * cb, 0, r32, hi); }
#pragma unroll
        for (int vb = 0; vb < 2; ++vb)
#pragma unroll
            for (int kb = 0; kb < 2; ++kb) { zero16(acc);
                mm<32>(acc, lds + O_VKT, PKC, 32 * kb, lds + O_VC, PKC, 32 * vb, r32, hi);
                v4u q0, q1; q0.x = cvt2(acc[0], acc[1]); q0.y = cvt2(acc[2], acc[3]); q0.z = cvt2(acc[4], acc[5]); q0.w = cvt2(acc[6], acc[7]);
                q1.x = cvt2(acc[8], acc[9]); q1.y = cvt2(acc[10], acc[11]); q1.z = cvt2(acc[12], acc[13]); q1.w = cvt2(acc[14], acc[15]);
                GAS v4u* sl = (GAS v4u*)(SLOT + (size_t)unit * 2048 + ((vb * 2 + kb) * 64 + lane) * 8);
                sl[0] = q0; sl[1] = q1; }
        {   const LAS v4u* vs = (const LAS v4u*)(lds + O_VC + lane * PKC * 2);
            GAS v4u* vd = (GAS v4u*)(VCG + (size_t)unit * 2048 + lane * 32);
            vd[0] = vs[0]; vd[1] = vs[1]; vd[2] = vs[2]; vd[3] = vs[3]; }
    }
}

constexpr int CHN_SLOT = 17408, CHN_S = 2 * CHN_SLOT, CHN_PT = 72;
#define CHN_BAR() do { asm volatile("s_waitcnt lgkmcnt(0)" ::: "memory"); __builtin_amdgcn_s_barrier(); asm volatile("" ::: "memory"); } while (0)
__device__ __forceinline__ void rwkv_chain(int chain, const bf16* TRT, unsigned* SLOT, LAS unsigned char* lds, int tid) {
    const int lane = tid & 63, wv = __builtin_amdgcn_readfirstlane(tid >> 6), r32 = lane & 31, hi = lane >> 5;
    constexpr int NIT = NCH - 1;
    if (wv >= 2 && wv < 6) {
        const int lt = tid - 128;
        const unsigned char* gT = (const unsigned char*)(TRT + (size_t)chain * NCH * 4096);
        const unsigned char* gS = (const unsigned char*)(SLOT + (size_t)chain * NCH * 2048);
        const bool isT = lt < 128;
        const unsigned char* gsrc = isT ? gT + lt * 64 : gS + (lt - 128) * 64;
        const int ldst = isT ? ((lt >> 1) * (CHN_PT * 2) + (lt & 1) * 64) : (64 * CHN_PT * 2 + (lt - 128) * 64);
        struct Set { v4u q[4]; };
        Set R0, R1, R2, R3, R4, R5, R6, R7;
#define CH_RAW(R, c_) do { const int cc_ = ((c_) < NIT) ? (c_) : NIT - 1; const unsigned char* p_ = gsrc + (size_t)cc_ * 8192; \
        _Pragma("unroll") for (int i_ = 0; i_ < 4; ++i_) R.q[i_] = *(const GAS v4u*)(p_ + 16 * i_); } while (0)
#define CH_PUT(R, buf) do { LAS unsigned char* d_ = lds + (buf) * CHN_SLOT + ldst; \
        _Pragma("unroll") for (int i_ = 0; i_ < 4; ++i_) *(LAS v4u*)(d_ + 16 * i_) = R.q[i_]; } while (0)
#define CH_ITER(R, c_) do { CH_PUT(R, ((c_) + 1) & 1); CH_RAW(R, (c_) + 9); CHN_BAR(); } while (0)
        CH_RAW(R0, 0); CH_RAW(R1, 1); CH_RAW(R2, 2); CH_RAW(R3, 3); CH_RAW(R4, 4); CH_RAW(R5, 5); CH_RAW(R6, 6); CH_RAW(R7, 7);
        CH_PUT(R0, 0); CH_RAW(R0, 8);
        CHN_BAR();
        for (int c = 0; c + 7 < NIT; c += 8) { CH_ITER(R1, c); CH_ITER(R2, c + 1); CH_ITER(R3, c + 2); CH_ITER(R4, c + 3); CH_ITER(R5, c + 4); CH_ITER(R6, c + 5); CH_ITER(R7, c + 6); CH_ITER(R0, c + 7); }
        CH_ITER(R1, 120); CH_ITER(R2, 121); CH_ITER(R3, 122); CH_ITER(R4, 123); CH_ITER(R5, 124); CH_ITER(R6, 125); CH_ITER(R7, 126);
#undef CH_RAW
#undef CH_PUT
#undef CH_ITER
    } else if (wv < 2) {
        const int vb = wv;
        LAS unsigned char* sl = lds + CHN_S + vb * (32 * CHN_PT * 2);
        for (int i = lane; i < 32 * CHN_PT / 2; i += 64) ((LAS unsigned*)sl)[i] = 0u;
        CHN_BAR();
        for (int c = 0; c < NIT; ++c) {
            const LAS unsigned char* bs = lds + (c & 1) * CHN_SLOT;
            bf16x8 sfr[4];
#pragma unroll
            for (int ks = 0; ks < 4; ++ks) sfr[ks] = *(const LAS bf16x8*)(sl + (r32 * CHN_PT + 16 * ks + 8 * hi) * 2);
            bf16* sg = (bf16*)(SLOT + ((size_t)chain * NCH + c) * 2048 + vb * 1024);
            f32x16 acc[2]; bf16x8 tr[2][4];
#pragma unroll
            for (int kb = 0; kb < 2; ++kb) {
                const LAS v4u* wp = (const LAS v4u*)(bs + 64 * CHN_PT * 2 + ((vb * 2 + kb) * 64 + lane) * 32);
                const v4u w0 = wp[0], w1 = wp[1];
                acc[kb][0] = bflo(w0.x); acc[kb][1] = bfhi(w0.x); acc[kb][2] = bflo(w0.y); acc[kb][3] = bfhi(w0.y); acc[kb][4] = bflo(w0.z); acc[kb][5] = bfhi(w0.z); acc[kb][6] = bflo(w0.w); acc[kb][7] = bfhi(w0.w);
                acc[kb][8] = bflo(w1.x); acc[kb][9] = bfhi(w1.x); acc[kb][10] = bflo(w1.y); acc[kb][11] = bfhi(w1.y); acc[kb][12] = bflo(w1.z); acc[kb][13] = bfhi(w1.z); acc[kb][14] = bflo(w1.w); acc[kb][15] = bfhi(w1.w);
#pragma unroll
                for (int ks = 0; ks < 4; ++ks) tr[kb][ks] = *(const LAS bf16x8*)(bs + ((32 * kb + r32) * CHN_PT + 16 * ks + 8 * hi) * 2);
            }
#pragma unroll
            for (int ks = 0; ks < 4; ++ks) {
                acc[0] = __builtin_amdgcn_mfma_f32_32x32x16_bf16(tr[0][ks], sfr[ks], acc[0], 0, 0, 0);
                acc[1] = __builtin_amdgcn_mfma_f32_32x32x16_bf16(tr[1][ks], sfr[ks], acc[1], 0, 0, 0); }
#pragma unroll
            for (int kb = 0; kb < 2; ++kb) { storeT(acc[kb], sl, CHN_PT, 0, 32 * kb, r32, hi); storeTg(acc[kb], sg, 64, 0, 32 * kb, r32, hi); }
            CHN_BAR();
        }
    } else {
        for (int c = 0; c < NIT + 1; ++c) CHN_BAR();
    }
}

#undef CHN_BAR
__device__ __forceinline__ void rwkv_out_item(int unit, const unsigned* SLOT, const bf16* RRT, const bf16* G2T, const bf16* VCG, const float* BONUS, const bf16* Z, const bf16* L,
                                              const float* mu, const float* lnw, const float* lnb, bf16* Omix, int lane) {
    const int chain = unit >> 7, c = unit & 127, b = chain >> 4, h = chain & 15, r32 = lane & 31, hi = lane >> 5;
    const int t = b * SEQ + c * CH + r32;
    f32x16 o[2]; zero16(o[0]); zero16(o[1]);
    if (c > 0) {
        bf16x8 rr[4];
#pragma unroll
        for (int ks = 0; ks < 4; ++ks) rr[ks] = *(const GAS bf16x8*)(RRT + (size_t)unit * 2048 + r32 * 64 + 16 * ks + 8 * hi);
#pragma unroll
        for (int vb = 0; vb < 2; ++vb) { const bf16* sg = (const bf16*)(SLOT + (size_t)(unit - 1) * 2048 + vb * 1024);
#pragma unroll
            for (int ks = 0; ks < 4; ++ks) o[vb] = __builtin_amdgcn_mfma_f32_32x32x16_bf16(*(const GAS bf16x8*)(sg + r32 * 64 + 16 * ks + 8 * hi), rr[ks], o[vb], 0, 0, 0); }
    }
    {   bf16x8 g2[2];
#pragma unroll
        for (int ks = 0; ks < 2; ++ks) g2[ks] = *(const GAS bf16x8*)(G2T + (size_t)unit * 1024 + r32 * 32 + 16 * ks + 8 * hi);
#pragma unroll
        for (int vb = 0; vb < 2; ++vb)
#pragma unroll
            for (int ks = 0; ks < 2; ++ks) o[vb] = __builtin_amdgcn_mfma_f32_32x32x16_bf16(*(const GAS bf16x8*)(VCG + (size_t)unit * 2048 + (32 * vb + r32) * 32 + 16 * ks + 8 * hi), g2[ks], o[vb], 0, 0, 0);
    }
    float s = 0.f;
#pragma unroll
    for (int r = 0; r < 16; ++r) s += o[0][r] + o[1][r];
    s += __shfl_xor(s, 32);
    const float mean = s * (1.f / 64.f); float q = 0.f;
#pragma unroll
    for (int r = 0; r < 16; ++r) { o[0][r] -= mean; o[1][r] -= mean; q += o[0][r] * o[0][r] + o[1][r] * o[1][r]; }
    q += __shfl_xor(q, 32);
    const float rstd = __builtin_amdgcn_rsqf(q * (1.f / 64.f) + GN_EPS);
    const float bon = BONUS[(size_t)t * RH + h];
    const bool first = (t % SEQ) == 0;
#pragma unroll
    for (int vb = 0; vb < 2; ++vb)
#pragma unroll
        for (int g = 0; g < 4; ++g) { const int c4 = h * 64 + 32 * vb + 8 * g + 4 * hi;
            const f32x4 lw4 = *(const GAS f32x4*)(lnw + c4), lb4 = *(const GAS f32x4*)(lnb + c4), mu4 = *(const GAS f32x4*)(mu + 2048 + c4);
            const v2u vcw = *(const GAS v2u*)(Z + (size_t)t * ZW + Z_V + c4);
            v2u vpw = {0u, 0u}; if (!first) vpw = *(const GAS v2u*)(Z + (size_t)t * ZW - ZW + Z_V + c4);
            const v2u gw = *(const GAS v2u*)(L + (size_t)t * LW + 2048 + c4);
            const float vc[4] = {bflo(vcw.x), bfhi(vcw.x), bflo(vcw.y), bfhi(vcw.y)}, vp[4] = {bflo(vpw.x), bfhi(vpw.x), bflo(vpw.y), bfhi(vpw.y)}, gg[4] = {bflo(gw.x), bfhi(gw.x), bflo(gw.y), bfhi(gw.y)};
            float y[4];
#pragma unroll
            for (int e = 0; e < 4; ++e) { const float v = vc[e] + (vp[e] - vc[e]) * mu4[e]; y[e] = (o[vb][4 * g + e] * rstd * lw4[e] + lb4[e] + bon * v) * gg[e]; }
            v2u ow; ow.x = pk2(y[0], y[1]); ow.y = pk2(y[2], y[3]);
            *(GAS v2u*)(Omix + (size_t)t * 2048 + 1024 + c4) = ow; }
}
}


#define WIN ((bf16*)(ws + WS_WIN))
#define WKPE ((bf16*)(ws + WS_WKPE))
#define KPEP ((float*)(ws + WS_KPEP))
#define WQB ((bf16*)(ws + WS_WQB))
#define WKVB ((bf16*)(ws + WS_WKVB))
#define WLORA ((bf16*)(ws + WS_WLORA))
#define WOUT ((bf16*)(ws + WS_WOUT))
#define WPG ((bf16*)(ws + WS_WPG))
#define WPP ((bf16*)(ws + WS_WPP))
#define WGU ((bf16*)(ws + WS_WGU))
#define WD ((bf16*)(ws + WS_WD))
#define WD2 ((bf16*)(ws + WS_WD2))
#define H ((bf16*)(ws + WS_H))
#define U ((bf16*)(ws + WS_U))
#define Zb ((bf16*)(ws + WS_Z))
#define AQ ((bf16*)(ws + WS_AQ))
#define AKV ((bf16*)(ws + WS_AKV))
#define AL ((bf16*)(ws + WS_AL))
#define QRAW ((bf16*)(ws + WS_QRAW))
#define KVRAW ((bf16*)(ws + WS_KVRAW))
#define LORA ((bf16*)(ws + WS_LORA))
#define QH ((bf16*)(ws + WS_QH))
#define KH ((bf16*)(ws + WS_KH))
#define VT ((bf16*)(ws + WS_VT))
#define OMIX ((bf16*)(ws + WS_OMIX))
#define TRT ((bf16*)(ws + WS_TRT))
#define OTMP ((bf16*)(ws + WS_OTMP))
#define AST ((f32x2*)(ws + WS_AST))
#define SLOT ((unsigned*)(ws + WS_SLOT))
#define RRT ((bf16*)out)
#define G2T ((bf16*)out + (size_t)8 * 1024 * 1024)
#define VCG ((bf16*)(ws + WS_VCG))
#define BONUS ((float*)(ws + WS_BONUS))
#define PB ((bf16*)(ws + WS_PB))
#define PPLE ((float*)(ws + WS_PPLE))
#define ROPE ((f32x2*)(ws + WS_ROPE))
#define SS0 ((float*)(ws + WS_CTL) + CW_SS)
#define SS1 (SS0 + T)
#define SS2 (SS0 + 2 * T)
#define SS3 (SS0 + 3 * T)
__global__ void __launch_bounds__(NTHR, 2) mk_fwd(Args args) {
    extern __shared__ __attribute__((aligned(16))) unsigned char lds_raw[];
    LAS unsigned char* lds = (LAS unsigned char*)lds_raw;
    volatile LAS unsigned* MISC = (volatile LAS unsigned*)(lds + MISC_OFF);
    const int tid = threadIdx.x, lane = tid & 63, wave = __builtin_amdgcn_readfirstlane(tid >> 6);
    const int G = gridDim.x, bx = blockIdx.x, vcu = (G % 8 == 0) ? (bx % 8) * (G / 8) + bx / 8 : bx;
    unsigned char* ws = args.ws;
    gu32* ctl = (gu32*)(ws + WS_CTL);
    for (int u = tid; u < (LDS_BYTES - LDSCTL_OFF) / 4; u += NTHR) ((LAS unsigned*)(lds + LDSCTL_OFF))[u] = 0u;
    __syncthreads();
    XcdBarrier bar; bar.bar = (unsigned*)(ctl + CW_BAR); bar.x = 0; bar.st = nullptr;
    if (N_LAUNCHES == 1) bar = xcd_barrier_post((unsigned*)(ctl + CW_BAR), MISC + 8);
#define GRID_BAR() do { if (N_LAUNCHES == 1) xcd_barrier(bar); } while (0)
    const int lo = args.ph_lo, hi = args.ph_hi;
#define IN(k) (lo <= (k) && (k) < hi)
#define BOTH(k) (IN(k) && IN((k) + 1))
    const int gw = vcu * NWAVES + wave, NGW = G * NWAVES;
    const float* x = args.in[0]; float* out = args.out;
    LAS float* scr = (LAS float*)(lds + RING_OFF + wave * 16384);

    if (IN(0)) {
        int base = 0;
        run_job(mk_job(args.in[3], args.in[4], args.in[2], WGU, DM, FF, 2 * FF, DM, 0, 1), gw, NGW, base, scr, lane);
        run_job(mk_job(args.in[7], nullptr, args.in[6], WIN, DM, ZW, ZW, DM, 0, 0, 4160, 0, 768, 64), gw, NGW, base, scr, lane);
        run_job(mk_job(args.in[7], nullptr, args.in[6], WKPE, DM, 64, 256, DM, 0, 0, 4160, 768), gw, NGW, base, scr, lane);
        run_job(mk_job(args.in[5], nullptr, nullptr, WD, FF, DM, DM, FF, 0, 0), gw, NGW, base, scr, lane);
        for (int e = gw * 64 + lane; e < SEQ * 32; e += NGW * 64) { const int s = e >> 5, i = e & 31;
            const float inv_freq = __builtin_amdgcn_exp2f(-(float)i * (13.287712379549449f / 32.0f));
            float rev = ((float)s * inv_freq) * 0.15915494309189535f; rev -= floorf(rev);
            f32x2 cs; cs.x = __builtin_amdgcn_cosf(rev); cs.y = __builtin_amdgcn_sinf(rev); ROPE[e] = cs; }
        xb_pass(x, H, SS0, gw, NGW, lane);
        if (BOTH(0)) GRID_BAR();
    }
    if (IN(1)) {
        pg8::Gemm g{H, WGU, T, 2 * FF, DM}; pg8::StaticOrder S; S.init(T, 2 * FF, G, bx);
        pg8::EpiSwiGLU E{U, FF, SS0};
        pg8::gemm_phase<pg8::EpiSwiGLU, pg8::StaticOrder, true, true>(lds + RING_OFF, g, S, E);
        if (bx >= (G >> 1)) { int base = 0;
            const int gw2 = (bx - (G >> 1)) * NWAVES + wave, ngw2 = (G - (G >> 1)) * NWAVES;
            run_job(mk_job(args.in[25], nullptr, nullptr, WOUT, DM, DM, DM, DM, 0, 0), gw2, ngw2, base, scr, lane);
            run_job(mk_job(args.in[31], nullptr, args.in[30], WPG, DM, DM, DM, DM, 0, 0), gw2, ngw2, base, scr, lane);
            run_job(mk_job(args.in[9], nullptr, args.in[8], WQB, QL, 1536, 1536, QL, 0, 0), gw2, ngw2, base, scr, lane);
            run_job(mk_job(args.in[11], nullptr, args.in[10], WKVB, KVL, 2048, 2048, KVL, 0, 0), gw2, ngw2, base, scr, lane);
            run_job(mk_job(args.in[16], nullptr, nullptr, WLORA, 64, 1024, 1024, 256, 0, 0), gw2, ngw2, base, scr, lane);
            run_job(mk_job(args.in[18], nullptr, nullptr, WLORA + (size_t)1024 * 256, 64, 1024, 1024, 256, 64, 0), gw2, ngw2, base, scr, lane);
            run_job(mk_job(args.in[19], nullptr, nullptr, WLORA + (size_t)2048 * 256, 128, 1024, 1024, 256, 128, 0), gw2, ngw2, base, scr, lane);
            run_job(mk_job(args.in[32], nullptr, nullptr, WPP, PLE, DM, DM, PLE, 0, 0), gw2, ngw2, base, scr, lane);
            { const float* p = args.in[1];
              for (int e = gw2 * 64 + lane; e < T * PLE / 4; e += ngw2 * 64) { const f32x4 v = *(const GAS f32x4*)(p + (size_t)e * 4); v2u o; o.x = pk2(v.x, v.y); o.y = pk2(v.z, v.w); *(GAS v2u*)(PB + (size_t)e * 4) = o; } }
 }
        if (BOTH(1)) GRID_BAR();
    }
    if (IN(2)) {
        pg8::Gemm g{U, WD, T, DM, FF}; pg8::StaticOrder S; S.init(T, DM, G, bx);
        pg8::EpiRes<false> E{x, DM, 0.5f, H, SS1};
        pg8::gemm_phase<pg8::EpiRes<false>, pg8::StaticOrder, false, true>(lds + RING_OFF, g, S, E);
        if (IN(2) && IN(4)) GRID_BAR();
    }
    if (IN(4)) {
        pg8::Gemm g{H, WIN, T, ZW, DM}; pg8::StaticOrder S; S.init(T, ZW, G, bx);
        pg8::EpiBf16 E{Zb, ZW, SS1};
        pg8::gemm_phase<pg8::EpiBf16, pg8::StaticOrder, true, true>(lds + RING_OFF, g, S, E);
        if (BOTH(4)) GRID_BAR();
    }
    if (IN(5)) {
        for (int t = gw; t < T; t += NGW) prep_a_row(t, Zb, args.in[14], AQ, AKV, AL, lane);
        if (BOTH(5)) GRID_BAR();
    }
    if (IN(6)) {
        {   pg8::Gemm g{AQ, WQB, T, 1536, QL}; pg8::StaticOrder S; S.init(T, 1536, G, bx); pg8::EpiBf16 E{QRAW, 1536, nullptr};
            pg8::gemm_phase<pg8::EpiBf16, pg8::StaticOrder, true, true>(lds + RING_OFF, g, S, E); }
        {   pg8::Gemm g{AKV, WKVB, T, 2048, KVL}; pg8::StaticOrder S; S.init(T, 2048, G, (bx + 192) % G); pg8::EpiBf16 E{KVRAW, 2048, nullptr};
            pg8::gemm_phase<pg8::EpiBf16, pg8::StaticOrder, true, true>(lds + RING_OFF, g, S, E); }
        {   pg8::Gemm g{AL, WLORA, T, LW, 256}; pg8::StaticOrder S; S.init(T, LW, G, (bx + 64) % G); pg8::EpiBf16 E{LORA, LW, nullptr};
            pg8::gemm_phase<pg8::EpiBf16, pg8::StaticOrder, true, true>(lds + RING_OFF, g, S, E); }
        __syncthreads();
        for (int task = (vcu + 64) % G; task < T / 32; task += G) kpe_task(task, H, WKPE, SS1, KPEP, lds, tid);
        if (BOTH(6)) GRID_BAR();
    }
    if (IN(7)) {
        if (wave < ck::UNITS_PER_WG) {
            ck::Bat B0, B1; unsigned short qr, qk, qv; const int NU = 32 * ck::NCH, st = ck::UNITS_PER_WG * G; int u = vcu * ck::UNITS_PER_WG + wave;
            if (u < NU) ck::preload(u, Zb, LORA, B0, B1, qr, qk, qv, lane);
            for (; u < NU; u += st)
                ck::chunk_pre(u, Zb, LORA, args.in[14], args.in[15], args.in[17], args.in[20], args.in[21], args.in[22], BONUS, TRT, SLOT, RRT, G2T, VCG, lds + wave * ck::UNIT_LDS, lane,
                              B0, B1, qr, qk, qv, (u + st < NU) ? u + st : -1);
        } else {
            const int nmw = NWAVES - ck::UNITS_PER_WG;
            for (int task = vcu * nmw + (wave - ck::UNITS_PER_WG); task < 16 * 64 * 8; task += G * nmw)
                mla_prep_task(task, QRAW, KVRAW, args.in[12], args.in[13], ROPE, QH, KH, VT, lane, KPEP);
        }
        if (BOTH(7)) GRID_BAR();
    }
    if (IN(8)) {
        for (int rep = 0; rep < REP(8); ++rep) {
        if (vcu < 32) { ck::rwkv_chain(vcu, TRT, SLOT, lds, tid); __syncthreads(); }
        for (;;) {
            if (tid == 0) MISC[16] = __hip_atomic_fetch_add(ctl + CW_QUEUE + 64 * rep, 1u, RLX_AGENT);
            __syncthreads();
            const unsigned idx = MISC[16];
            __syncthreads();
            if (idx >= 512u) break;
            { const int part = (int)((idx >> 4) & 1u);
              att::attn_unit((int)(idx & 15u), 15 - (int)(idx >> 5), part, QH, KH, VT, part ? OTMP : OMIX, part ? 1024 : 2048, AST + (size_t)part * T * MLA_H, lds); }
        }
        }
        if (BOTH(8)) GRID_BAR();
    }
    if (IN(9)) {
        { int base = 0;
          run_job(mk_job(args.in[27], args.in[28], args.in[26], WGU, DM, FF, 8192, DM, 0, 1, 0, 0, 1 << 30, 0, 0), gw, NGW, base, scr, lane); }
        for (int it = gw; it < T * 2; it += NGW) att::attn_merge_item(it, OMIX, OTMP, AST, lane);
        for (int u = gw; u < 32 * ck::NCH; u += NGW) ck::rwkv_out_item(u, SLOT, RRT, G2T, VCG, BONUS, Zb, LORA, args.in[14], args.in[23], args.in[24], OMIX, lane);
        if (BOTH(9)) GRID_BAR();
    }
    if (IN(10)) {
        { int base = 0;
          run_job(mk_job(args.in[27], args.in[28], args.in[26], WGU, DM, FF, 2 * FF - 8192, DM, 0, 1, 0, 0, 1 << 30, 0, 8192), gw, NGW, base, scr, lane);
          run_job(mk_job(args.in[29], nullptr, nullptr, WD2, FF, DM, 1024, FF, 0, 0, 0, 0, 1 << 30, 0, 0), gw, NGW, base, scr, lane); }
        __syncthreads();
        pg8::Gemm g{OMIX, WOUT, T, DM, DM}; pg8::StaticOrder S; S.init(T, DM, G, bx);
        pg8::EpiRes<true> E{nullptr, DM, 1.0f, H, SS2};
        pg8::gemm_phase<pg8::EpiRes<true>, pg8::StaticOrder, false, true>(lds + RING_OFF, g, S, E);
        if (IN(10) && IN(12)) GRID_BAR();
    }
    if (IN(12)) {
        pg8::Gemm g{H, WGU, T, 2 * FF, DM}; pg8::StaticOrder S; S.init(T, 2 * FF, G, bx);
        pg8::EpiSwiGLU E{U, FF, SS2};
        pg8::gemm_phase<pg8::EpiSwiGLU, pg8::StaticOrder, true, true>(lds + RING_OFF, g, S, E);
        if (bx >= (G >> 1)) { int base = 0; const int hg = G >> 1;
            run_job(mk_job(args.in[29], nullptr, nullptr, WD2, FF, DM, 1024, FF, 0, 0, 0, 0, 1 << 30, 0, 1024), (bx - hg) * NWAVES + wave, (G - hg) * NWAVES, base, scr, lane);
            __syncthreads();
            pg8::Gemm g2{PB, WPP, T, DM, PLE}; pg8::StaticOrder S2; S2.init(T, DM, G - hg, bx - hg); pg8::EpiBf16NP E2{(pg8::bf16_t*)PPLE, DM};
            pg8::gemm_phase<pg8::EpiBf16NP, pg8::StaticOrder, true, true>(lds + RING_OFF, g2, S2, E2); }
        if (BOTH(12)) GRID_BAR();
    }
    if (IN(13)) {
        pg8::Gemm g{U, WD2, T, DM, FF}; pg8::StaticOrder S; S.init(T, DM, G, bx);
        pg8::EpiRes<true> E{nullptr, DM, 0.5f, H, SS3};
        pg8::gemm_phase<pg8::EpiRes<true>, pg8::StaticOrder, false, true>(lds + RING_OFF, g, S, E);
        if (IN(13) && IN(15)) GRID_BAR();
    }
    if (IN(15)) {
        {   pg8::Gemm g{H, WPG, T, DM, DM}; pg8::StaticOrder S; S.init(T, DM, G, bx); pg8::EpiPle E{H, (const pg8::bf16_t*)PPLE, out, DM, SS3};
            pg8::gemm_phase<pg8::EpiPle, pg8::StaticOrder, false, true>(lds + RING_OFF, g, S, E); }
    }
#undef IN
#undef BOTH
#undef GRID_BAR
}

extern "C" void kernel_launch(void* const* d_in, const int* in_sizes, int n_in, void* d_out, int out_size, void* d_ws, size_t ws_size, hipStream_t stream) {
    static int grid = 0;
    if (grid == 0) {
        if (n_in != 33 || out_size != T * DM || ws_size < WS_END) { fprintf(stderr, "kernel_launch: unexpected shapes (n_in %d, out %d, ws %zu, need %zu)\n", n_in, out_size, ws_size, (size_t)WS_END); grid = -1; return; }
        int dev = 0, cus = 0, per_cu = 0;
        if (hipGetDevice(&dev) != hipSuccess || hipDeviceGetAttribute(&cus, hipDeviceAttributeMultiprocessorCount, dev) != hipSuccess) { grid = -1; return; }
        if (hipFuncSetAttribute((const void*)mk_fwd, hipFuncAttributeMaxDynamicSharedMemorySize, LDS_BYTES) != hipSuccess) { fprintf(stderr, "kernel_launch: hipFuncSetAttribute failed\n"); grid = -1; return; }
        if (hipOccupancyMaxActiveBlocksPerMultiprocessor(&per_cu, (const void*)mk_fwd, NTHR, LDS_BYTES) != hipSuccess || per_cu < 1) { fprintf(stderr, "kernel_launch: occupancy query says %d blocks per CU\n", per_cu); (void)hipGetLastError(); grid = -1; return; }
        grid = cus;
        fprintf(stderr, "kernel_launch: grid %d, per_cu %d, ws %zu\n", grid, per_cu, ws_size);
    }
    if (grid < 0) return;
    (void)hipMemsetAsync((char*)d_ws + WS_CTL, 0, CTL_ZERO_BYTES, stream);
    Args a{};
    for (int i = 0; i < 33; ++i) a.in[i] = (const float*)d_in[i];
    a.out = (float*)d_out; a.ws = (unsigned char*)d_ws;
    for (int li = 0; li < N_LAUNCHES; ++li) {
        a.ph_lo = (N_LAUNCHES == 1) ? 0 : li; a.ph_hi = (N_LAUNCHES == 1) ? NPH : li + 1;
        hipLaunchKernelGGL(mk_fwd, dim3(grid), dim3(NTHR), LDS_BYTES, stream, a);
    }
}
```

```cpp
#include <hip/hip_runtime.h>
#include <cstdio>
#include <cstdint>
namespace pg8 {
#define PG8_LAS __attribute__((address_space(3)))
typedef unsigned short bf16_t;
typedef short bf16x8 __attribute__((ext_vector_type(8)));
typedef float f32x4 __attribute__((ext_vector_type(4)));
typedef unsigned u32x4 __attribute__((ext_vector_type(4)));
typedef unsigned u32x2 __attribute__((ext_vector_type(2)));
constexpr int BM = 256, BK = 64, HALF = 128, HTB = HALF * BK * 2  , STAGE_BYTES = 8 * HTB, NXCD = 8, WGM = 8;

__host__ __device__ __forceinline__ int lds_byte(int r, int c) { const int st = (r >> 4) * 2 + (c >> 5), rr = r & 15, cc = c & 31, ob = rr * 64 + cc * 2; return st * 1024 + (ob ^ (((ob >> 9) & 1) << 5)); }
__host__ __device__ __forceinline__ void stage_rc(int b, int& R, int& C) { const int st = b / 1024, sb = b % 1024, swz = sb ^ (((sb >> 9) & 1) << 5); R = (st >> 1) * 16 + swz / 64; C = (st & 1) * 32 + (swz % 64) / 2; }
__host__ __device__ __forceinline__ int perm32(int rho) { const int n = rho >> 4, i = rho & 15; return 8 * (i >> 2) + 4 * n + (i & 3); }

struct Unit { int pm, pn; };
struct Gemm { const bf16_t* A; const bf16_t* Bt; int M, N, K; int ld; size_t kofs; };

struct StaticOrder {
    int nM, nN, nwg, G, c;
    __host__ __device__ void init(int M, int N, int G_, int c_) { nM = M / BM; nN = N / BM; nwg = nM * nN; G = G_; c = c_; }
    __host__ __device__ bool next(int i, Unit& u) const {
        const long L = (long)i * G + c; if (L >= nwg) return false;
        int wgid = (int)L; { const int q = nwg / NXCD, r = nwg % NXCD, xcd = wgid % NXCD, off = wgid / NXCD; wgid = (xcd < r ? xcd * (q + 1) : r * (q + 1) + (xcd - r) * q) + off; }
        const int nig = WGM * nN, gid = wgid / nig, fm = gid * WGM, gsz = (nM - fm) < WGM ? (nM - fm) : WGM;
        u.pm = fm + ((wgid % nig) % gsz); u.pn = (wgid % nig) / gsz; return true;
    }
    __device__ __forceinline__ void a_ready(const Unit&) const {}
    __device__ __forceinline__ void done(const Unit&) const {}
};


__device__ __forceinline__ unsigned cvt_pk_bf16(float lo, float hi) { unsigned r; asm volatile("v_cvt_pk_bf16_f32 %0, %1, %2" : "=v"(r) : "v"(lo), "v"(hi)); return r; }
__device__ __forceinline__ float fast_sigmoid(float x) { return __builtin_amdgcn_rcpf(1.0f + __builtin_amdgcn_exp2f(-1.4426950408889634f * x)); }

__device__ __forceinline__ float row_rstd(const float* ss, int row) { return ss ? __builtin_amdgcn_rsqf(ss[row] * (1.0f / 2048.0f) + 1e-6f) : 1.0f; }
__device__ __forceinline__ void pf_rows_lds(PG8_LAS unsigned char* slot, const float* ss, int rowbase, int lane) {
    if (ss) { const float* src = ss + rowbase + lane;
        __builtin_amdgcn_global_load_lds((const unsigned*)src, (PG8_LAS unsigned*)slot, 4, 0, 0);
        __builtin_amdgcn_global_load_lds((const unsigned*)(src + HALF), (PG8_LAS unsigned*)(slot + 256), 4, 0, 0); }
}
__device__ __forceinline__ void rstd8_lds(float (&rs8)[2][4], const PG8_LAS unsigned char* slot, const float* ss, int fr) {
    if (ss) {
#pragma unroll
        for (int ai = 0; ai < 2; ++ai)
#pragma unroll
            for (int m = 0; m < 4; ++m) rs8[ai][m] = *(const PG8_LAS float*)(slot + ai * 256 + (m * 16 + fr) * 4);
#pragma unroll
        for (int ai = 0; ai < 2; ++ai)
#pragma unroll
            for (int m = 0; m < 4; ++m) rs8[ai][m] = __builtin_amdgcn_rsqf(rs8[ai][m] * (1.0f / 2048.0f) + 1e-6f);
    } else {
#pragma unroll
        for (int ai = 0; ai < 2; ++ai)
#pragma unroll
            for (int m = 0; m < 4; ++m) rs8[ai][m] = 1.0f;
    }
}
__device__ __forceinline__ void load_rstd8(float (&rs8)[2][4], const float* ss, int row0) {
    if (ss) {
#pragma unroll
        for (int ai = 0; ai < 2; ++ai)
#pragma unroll
            for (int m = 0; m < 4; ++m) rs8[ai][m] = ss[row0 + ai * HALF + m * 16];
#pragma unroll
        for (int ai = 0; ai < 2; ++ai)
#pragma unroll
            for (int m = 0; m < 4; ++m) rs8[ai][m] = __builtin_amdgcn_rsqf(rs8[ai][m] * (1.0f / 2048.0f) + 1e-6f);
    } else {
#pragma unroll
        for (int ai = 0; ai < 2; ++ai)
#pragma unroll
            for (int m = 0; m < 4; ++m) rs8[ai][m] = 1.0f;
    }
}
struct EpiBf16 {
    static constexpr bool PERM = true, AFTER_DRAIN = false, PF = true;
    bf16_t* O; int ldc; const float* ss;
    __device__ __forceinline__ void prefetch(PG8_LAS unsigned char* slot, const Unit& u, int wr, int lane) const { pf_rows_lds(slot, ss, u.pm * BM + wr * 64, lane); }
    __device__ __forceinline__ void operator()(const f32x4 (&acc)[2][2][4][2], const Unit& u, int wr, int wc, int fr, int fq, const PG8_LAS unsigned char* slot) const {
        const int row0 = u.pm * BM + wr * 64 + fr, col0 = u.pn * BM + wc * 32 + 8 * fq;
        float rs8[2][4];
        rstd8_lds(rs8, slot, ss, fr);
#pragma unroll
        for (int ai = 0; ai < 2; ++ai)
#pragma unroll
            for (int m = 0; m < 4; ++m) { const int row = row0 + ai * HALF + m * 16; const float rs = rs8[ai][m]; bf16_t* rowp = O + (size_t)row * ldc + col0;
#pragma unroll
                for (int bj = 0; bj < 2; ++bj) { const f32x4 v0 = acc[ai][bj][m][0] * rs, v1 = acc[ai][bj][m][1] * rs;
                    u32x4 w; w.x = cvt_pk_bf16(v0[0], v0[1]); w.y = cvt_pk_bf16(v0[2], v0[3]); w.z = cvt_pk_bf16(v1[0], v1[1]); w.w = cvt_pk_bf16(v1[2], v1[3]);
                    *(u32x4*)(rowp + bj * HALF) = w; } }
    }
};
struct EpiSwiGLU {
    static constexpr bool PERM = true, AFTER_DRAIN = false, PF = true;
    bf16_t* O; int ldc; const float* ss;
    __device__ __forceinline__ void prefetch(PG8_LAS unsigned char* slot, const Unit& u, int wr, int lane) const { pf_rows_lds(slot, ss, u.pm * BM + wr * 64, lane); }
    __device__ __forceinline__ void operator()(const f32x4 (&acc)[2][2][4][2], const Unit& u, int wr, int wc, int fr, int fq, const PG8_LAS unsigned char* slot) const {
        const int row0 = u.pm * BM + wr * 64 + fr, hid0 = u.pn * 128 + wc * 16 + 4 * fq;
        float rs8[2][4];
        rstd8_lds(rs8, slot, ss, fr);
#pragma unroll
        for (int ai = 0; ai < 2; ++ai)
#pragma unroll
            for (int m = 0; m < 4; ++m) { const int row = row0 + ai * HALF + m * 16; const float rs = rs8[ai][m]; bf16_t* rowp = O + (size_t)row * ldc + hid0;
#pragma unroll
                for (int bj = 0; bj < 2; ++bj) { const f32x4 g = acc[ai][bj][m][0] * rs, up = acc[ai][bj][m][1] * rs; float o[4];
#pragma unroll
                    for (int e = 0; e < 4; ++e) o[e] = g[e] * up[e] * fast_sigmoid(g[e]);
                    u32x2 w; w.x = cvt_pk_bf16(o[0], o[1]); w.y = cvt_pk_bf16(o[2], o[3]);
                    *(u32x2*)(rowp + bj * 64) = w; } }
    }
};
__device__ __forceinline__ f32x4 bf4_to_f32(const u32x2 w) { f32x4 r; r[0] = __builtin_bit_cast(float, w.x << 16); r[1] = __builtin_bit_cast(float, w.x & 0xffff0000u); r[2] = __builtin_bit_cast(float, w.y << 16); r[3] = __builtin_bit_cast(float, w.y & 0xffff0000u); return r; }
template <bool RB>
struct EpiRes {
    static constexpr bool PERM = false, AFTER_DRAIN = false, PF = false;
    const float* resid; int ldc; float scale; bf16_t* xb; float* ss_out;
    __device__ __forceinline__ void operator()(const f32x4 (&acc)[2][2][4][2], const Unit& u, int wr, int wc, int fr, int fq) const {
        const int row0 = u.pm * BM + wr * 64 + fr, col0 = u.pn * BM + wc * 32 + 4 * fq;
        const float* const resid_ = resid; bf16_t* const xb_ = xb; float* const ss_ = ss_out; const float scale_ = scale; const int ldc_ = ldc;
        f32x4 rs[2][2][2]; u32x2 rb[2][2][2];
#pragma unroll
        for (int bj = 0; bj < 2; ++bj)
#pragma unroll
            for (int n = 0; n < 2; ++n) { const size_t o0 = (size_t)row0 * ldc_ + col0 + bj * HALF + n * 16;
                if constexpr (RB) rb[0][bj][n] = *(const u32x2*)(xb_ + o0); else rs[0][bj][n] = __builtin_nontemporal_load((const f32x4*)(resid_ + o0)); }
#pragma unroll
        for (int gi = 0; gi < 8; ++gi) { const int ai = gi >> 2, m = gi & 3; const int row = row0 + ai * HALF + m * 16; const size_t off = (size_t)row * ldc_ + col0;
            if (gi < 7) { const size_t offn = (size_t)(row0 + ((gi + 1) >> 2) * HALF + ((gi + 1) & 3) * 16) * ldc_ + col0;
#pragma unroll
                for (int bj = 0; bj < 2; ++bj)
#pragma unroll
                    for (int n = 0; n < 2; ++n) { if constexpr (RB) rb[(gi + 1) & 1][bj][n] = *(const u32x2*)(xb_ + offn + bj * HALF + n * 16); else rs[(gi + 1) & 1][bj][n] = __builtin_nontemporal_load((const f32x4*)(resid_ + offn + bj * HALF + n * 16)); } }
            float q = 0.f;
#pragma unroll
            for (int bj = 0; bj < 2; ++bj)
#pragma unroll
                for (int n = 0; n < 2; ++n) { f32x4 r; if constexpr (RB) r = bf4_to_f32(rb[gi & 1][bj][n]); else r = rs[gi & 1][bj][n];
                    const f32x4 o = r + acc[ai][bj][m][n] * scale_;
                    u32x2 w; w.x = cvt_pk_bf16(o[0], o[1]); w.y = cvt_pk_bf16(o[2], o[3]);
                    *(u32x2*)(xb_ + off + bj * HALF + n * 16) = w;
                    q += (o[0] * o[0] + o[1] * o[1]) + (o[2] * o[2] + o[3] * o[3]); }
            q += __shfl_xor(q, 16); q += __shfl_xor(q, 32);
            if (fq == 0) __hip_atomic_fetch_add((__attribute__((address_space(1))) float*)(ss_ + row), q, __ATOMIC_RELAXED, __HIP_MEMORY_SCOPE_AGENT);
            asm volatile("" ::: "memory"); }
    }
};
struct EpiKpe {
    static constexpr bool PERM = true, AFTER_DRAIN = false, PF = false;
    float* P; int Mrows; const float* ss;
    __device__ __forceinline__ void operator()(const f32x4 (&acc)[2][2][4][2], const Unit& u, int wr, int wc, int fr, int fq) const {
        if (wc >= 2) return;
        const int row0 = u.pm * BM + wr * 64 + fr, col0 = wc * 32 + 8 * fq;
#pragma unroll
        for (int ai = 0; ai < 2; ++ai)
#pragma unroll
            for (int m = 0; m < 4; ++m) { const int row = row0 + ai * HALF + m * 16; const float rs = row_rstd(ss, row); float* dst = P + ((size_t)u.pn * Mrows + row) * 64 + col0;
                *(f32x4*)dst = acc[ai][0][m][0] * rs; *(f32x4*)(dst + 4) = acc[ai][0][m][1] * rs; }
    }
};
struct EpiF32 {
    static constexpr bool PERM = false, AFTER_DRAIN = false, PF = false;
    float* C; int ldc;
    __device__ __forceinline__ void operator()(const f32x4 (&acc)[2][2][4][2], const Unit& u, int wr, int wc, int fr, int fq) const {
        const int row0 = u.pm * BM + wr * 64 + fr, col0 = u.pn * BM + wc * 32 + 4 * fq;
#pragma unroll
        for (int ai = 0; ai < 2; ++ai)
#pragma unroll
            for (int m = 0; m < 4; ++m) { float* rowp = C + (size_t)(row0 + ai * HALF + m * 16) * ldc + col0;
#pragma unroll
                for (int bj = 0; bj < 2; ++bj)
#pragma unroll
                    for (int n = 0; n < 2; ++n) *(f32x4*)(rowp + bj * HALF + n * 16) = acc[ai][bj][m][n]; }
    }
};
struct EpiBf16NP {
    static constexpr bool PERM = false, AFTER_DRAIN = false, PF = false;
    bf16_t* C; int ldc;
    __device__ __forceinline__ void operator()(const f32x4 (&acc)[2][2][4][2], const Unit& u, int wr, int wc, int fr, int fq) const {
        const int row0 = u.pm * BM + wr * 64 + fr, col0 = u.pn * BM + wc * 32 + 4 * fq;
#pragma unroll
        for (int ai = 0; ai < 2; ++ai)
#pragma unroll
            for (int m = 0; m < 4; ++m) { bf16_t* rowp = C + (size_t)(row0 + ai * HALF + m * 16) * ldc + col0;
#pragma unroll
                for (int bj = 0; bj < 2; ++bj)
#pragma unroll
                    for (int n = 0; n < 2; ++n) { const f32x4 v = acc[ai][bj][m][n]; u32x2 w; w.x = cvt_pk_bf16(v[0], v[1]); w.y = cvt_pk_bf16(v[2], v[3]); *(u32x2*)(rowp + bj * HALF + n * 16) = w; } }
    }
};
struct EpiPle {
    static constexpr bool PERM = false, AFTER_DRAIN = false, PF = false;
    const bf16_t* x; const bf16_t* P; float* out; int ldc; const float* ss;
    __device__ __forceinline__ void operator()(const f32x4 (&acc)[2][2][4][2], const Unit& u, int wr, int wc, int fr, int fq) const {
        const int row0 = u.pm * BM + wr * 64 + fr, col0 = u.pn * BM + wc * 32 + 4 * fq;
        const bf16_t* const x_ = x; const bf16_t* const P_ = P; float* const out_ = out; const int ldc_ = ldc;
        float rs8[2][4];
        load_rstd8(rs8, ss, row0);
        u32x2 xs[2][2], ps[2][2];
#pragma unroll
        for (int n = 0; n < 2; ++n) { xs[0][n] = *(const u32x2*)(x_ + (size_t)row0 * ldc_ + col0 + n * 16); ps[0][n] = __builtin_nontemporal_load((const u32x2*)(P_ + (size_t)row0 * ldc_ + col0 + n * 16)); }
#pragma unroll
        for (int st = 0; st < 16; ++st) { const int ai = st >> 3, m = (st >> 1) & 3, bj = st & 1; const size_t off = (size_t)(row0 + ai * HALF + m * 16) * ldc_ + col0 + bj * HALF; const float rsd = rs8[ai][m];
            if (st < 15) { const int s2 = st + 1; const size_t offn = (size_t)(row0 + (s2 >> 3) * HALF + ((s2 >> 1) & 3) * 16) * ldc_ + col0 + (s2 & 1) * HALF;
#pragma unroll
                for (int n = 0; n < 2; ++n) { xs[s2 & 1][n] = *(const u32x2*)(x_ + offn + n * 16); ps[s2 & 1][n] = __builtin_nontemporal_load((const u32x2*)(P_ + offn + n * 16)); } }
#pragma unroll
            for (int n = 0; n < 2; ++n) { const f32x4 xv = bf4_to_f32(xs[st & 1][n]), pv = bf4_to_f32(ps[st & 1][n]); f32x4 o;
#pragma unroll
                for (int e = 0; e < 4; ++e) o[e] = xv[e] + fast_sigmoid(acc[ai][bj][m][n][e] * rsd) * pv[e];
                *(f32x4*)(out_ + off + n * 16) = o; }
            asm volatile("" ::: "memory"); }
    }
};

template <class Epi, class Sched, bool ALIGN_EPI = false, bool SP2 = false>
__device__ __forceinline__ void gemm_phase(PG8_LAS unsigned char* lds, const Gemm g, const Sched S, const Epi E) {
    const int tid = threadIdx.x, wid = __builtin_amdgcn_readfirstlane(tid >> 6), lane = tid & 63, wr = wid >> 2, wc = wid & 3, fr = lane & 15, fq = lane >> 4;
    const int K = g.K, nt = K / BK, LD = g.ld ? g.ld : K;
    unsigned voffA[2], voffB[2];
#pragma unroll
    for (int i = 0; i < 2; ++i) { int R, C; stage_rc(tid * 16 + i * 8192, R, C); const int Rb = Epi::PERM ? ((R & ~31) + perm32(R & 31)) : R;
        voffA[i] = (unsigned)(R * LD + C) * 2u; voffB[i] = (unsigned)(Rb * LD + C) * 2u; }
    const size_t kstep = (size_t)(BK * 2);
    const size_t hstep = (size_t)HALF * LD * 2;
    const size_t tstep = 2 * hstep;
    const unsigned ldsw = (unsigned)wid * 1024u;
    const int aoff = lds_byte(wr * 64 + fr, fq * 8), boff = lds_byte(wc * 32 + fr, fq * 8);
#define PG8_SA(b, h) (((b) * 2 + (h)) * HTB)
#define PG8_SB(b, h) ((4 + (b) * 2 + (h)) * HTB)
#define PG8_STAGE(bufoff, gbase, voff) do { _Pragma("unroll") for (int _i = 0; _i < 2; ++_i) \
        __builtin_amdgcn_global_load_lds((const unsigned*)((const char*)(gbase) + (voff)[_i]), (PG8_LAS unsigned*)(lds + (bufoff) + ldsw + _i * 8192), 16, 0, 0); } while (0)
#define PG8_LDA(dst, b, h) do { _Pragma("unroll") for (int m = 0; m < 4; ++m) _Pragma("unroll") for (int k = 0; k < 2; ++k) dst[m][k] = *(const PG8_LAS bf16x8*)(lds + PG8_SA(b, h) + aoff + m * 2048 + k * 1024); } while (0)
#define PG8_LDB(dst, b, h) do { _Pragma("unroll") for (int n = 0; n < 2; ++n) _Pragma("unroll") for (int k = 0; k < 2; ++k) dst[n][k] = *(const PG8_LAS bf16x8*)(lds + PG8_SB(b, h) + boff + n * 2048 + k * 1024); } while (0)
#define PG8_MMA(ai, bj, At, Bt) do { __builtin_amdgcn_s_setprio(1); _Pragma("unroll") for (int m = 0; m < 4; ++m) _Pragma("unroll") for (int n = 0; n < 2; ++n) _Pragma("unroll") for (int k = 0; k < 2; ++k) \
        acc[ai][bj][m][n] = __builtin_amdgcn_mfma_f32_16x16x32_bf16(Bt[n][k], At[m][k], acc[ai][bj][m][n], 0, 0, 0); __builtin_amdgcn_s_setprio(0); } while (0)
#define PG8_WAIT_V(n) asm volatile("s_waitcnt vmcnt(" #n ")" ::: "memory")
#define PG8_WAIT_L(n) asm volatile("s_waitcnt lgkmcnt(" #n ")" ::: "memory")
#define PG8_BAR __builtin_amdgcn_s_barrier()
#define PG8_SCHED __builtin_amdgcn_sched_barrier(0)
    Unit cur, nxt; int ui = 0;
    if (!S.next(0, cur)) return;
    f32x4 acc[2][2][4][2];
#pragma unroll
    for (int a = 0; a < 2; ++a)
#pragma unroll
        for (int b = 0; b < 2; ++b)
#pragma unroll
            for (int m = 0; m < 4; ++m)
#pragma unroll
                for (int n = 0; n < 2; ++n) acc[a][b][m][n] = (f32x4){0.f, 0.f, 0.f, 0.f};
    bf16x8 At[4][2], B0[2][2], B1[2][2];
    const size_t bstep = g.kofs ? g.kofs : tstep;
    const char* cA = (const char*)g.A + (size_t)cur.pm * tstep + (size_t)cur.pn * g.kofs; const char* cB = (const char*)g.Bt + (size_t)cur.pn * bstep;
    S.a_ready(cur);
    if constexpr (SP2) {
        PG8_STAGE(PG8_SB(0, 0), cB, voffB); PG8_STAGE(PG8_SB(0, 1), cB + hstep, voffB); PG8_STAGE(PG8_SA(0, 0), cA, voffA); PG8_STAGE(PG8_SA(0, 1), cA + hstep, voffA);
        if (wr == 1) PG8_BAR;
        PG8_WAIT_V(2); PG8_BAR;
        PG8_STAGE(PG8_SB(1, 0), cB + kstep, voffB); PG8_STAGE(PG8_SA(1, 0), cA + kstep, voffA); PG8_STAGE(PG8_SB(1, 1), cB + hstep + kstep, voffB);
        PG8_WAIT_V(6); PG8_BAR;
    } else {
        PG8_STAGE(PG8_SB(0, 0), cB, voffB); PG8_STAGE(PG8_SA(0, 0), cA, voffA); PG8_STAGE(PG8_SB(0, 1), cB + hstep, voffB); PG8_STAGE(PG8_SA(0, 1), cA + hstep, voffA);
        if (wr == 1) PG8_BAR;
        PG8_WAIT_V(4); PG8_BAR;
        PG8_STAGE(PG8_SB(1, 0), cB + kstep, voffB); PG8_STAGE(PG8_SA(1, 0), cA + kstep, voffA); PG8_STAGE(PG8_SB(1, 1), cB + hstep + kstep, voffB);
        PG8_WAIT_V(6); PG8_BAR;
    }
    for (;;) {
        const bool has_next = S.next(ui + 1, nxt);
        const char* nA = has_next ? (const char*)g.A + (size_t)nxt.pm * tstep + (size_t)nxt.pn * g.kofs : cA; const char* nB = has_next ? (const char*)g.Bt + (size_t)nxt.pn * bstep : cB;
        for (int t = 0; t < nt; t += 2) {
            const bool last = (t == nt - 2);
            const char* a1 = cA + (size_t)(t + 1) * kstep;
            const char* a2 = last ? nA : cA + (size_t)(t + 2) * kstep; const char* b2 = last ? nB : cB + (size_t)(t + 2) * kstep;
            const char* a3 = a2 + kstep; const char* b3 = b2 + kstep;
            if (last && has_next) S.a_ready(nxt);
            if constexpr (Epi::PF) { if (last) E.prefetch(lds + STAGE_BYTES + wid * 512, cur, wr, lane); }
            if constexpr (SP2) {
            PG8_LDB(B0, 0, 0); PG8_LDB(B1, 0, 1); PG8_SCHED; PG8_LDA(At, 0, 0); PG8_STAGE(PG8_SA(1, 1), a1 + hstep, voffA);
            PG8_WAIT_V(8); PG8_WAIT_L(0); PG8_BAR; PG8_MMA(0, 0, At, B0); PG8_MMA(0, 1, At, B1); PG8_BAR; PG8_SCHED;
            PG8_LDA(At, 0, 1); PG8_STAGE(PG8_SB(0, 0), b2, voffB); PG8_STAGE(PG8_SB(0, 1), b2 + hstep, voffB); PG8_STAGE(PG8_SA(0, 0), a2, voffA);
            PG8_WAIT_V(8); PG8_WAIT_L(0); PG8_BAR; PG8_MMA(1, 0, At, B0); PG8_MMA(1, 1, At, B1); PG8_BAR; PG8_SCHED;
            PG8_LDB(B0, 1, 0); PG8_LDB(B1, 1, 1); PG8_SCHED; PG8_LDA(At, 1, 0); PG8_STAGE(PG8_SA(0, 1), a2 + hstep, voffA);
            PG8_WAIT_V(8); PG8_WAIT_L(0); PG8_BAR; PG8_MMA(0, 0, At, B0); PG8_MMA(0, 1, At, B1); PG8_BAR; PG8_SCHED;
            PG8_LDA(At, 1, 1); PG8_STAGE(PG8_SB(1, 0), b3, voffB); PG8_STAGE(PG8_SB(1, 1), b3 + hstep, voffB); PG8_STAGE(PG8_SA(1, 0), a3, voffA);
            PG8_WAIT_V(8); PG8_WAIT_L(0); PG8_BAR; PG8_MMA(1, 0, At, B0); PG8_MMA(1, 1, At, B1); PG8_BAR; PG8_SCHED;
            } else {
            PG8_LDB(B0, 0, 0); PG8_SCHED; PG8_LDA(At, 0, 0); PG8_STAGE(PG8_SA(1, 1), a1 + hstep, voffA);
            PG8_WAIT_L(8); PG8_BAR; PG8_WAIT_L(0); PG8_MMA(0, 0, At, B0); PG8_BAR; PG8_SCHED;
            PG8_LDB(B1, 0, 1); PG8_STAGE(PG8_SB(0, 0), b2, voffB);
            PG8_BAR; PG8_WAIT_L(0); PG8_MMA(0, 1, At, B1); PG8_BAR;
            PG8_LDA(At, 0, 1); PG8_STAGE(PG8_SA(0, 0), a2, voffA);
            PG8_BAR; PG8_WAIT_L(0); PG8_MMA(1, 0, At, B0); PG8_BAR; PG8_SCHED;
            PG8_STAGE(PG8_SB(0, 1), b2 + hstep, voffB);
            PG8_WAIT_V(6); PG8_BAR; PG8_MMA(1, 1, At, B1); PG8_BAR;
            PG8_LDB(B0, 1, 0); PG8_SCHED; PG8_LDA(At, 1, 0); PG8_STAGE(PG8_SA(0, 1), a2 + hstep, voffA);
            PG8_WAIT_L(8); PG8_BAR; PG8_WAIT_L(0); PG8_MMA(0, 0, At, B0); PG8_BAR; PG8_SCHED;
            PG8_LDB(B1, 1, 1); PG8_STAGE(PG8_SB(1, 0), b3, voffB);
            PG8_BAR; PG8_WAIT_L(0); PG8_MMA(0, 1, At, B1); PG8_BAR;
            PG8_LDA(At, 1, 1); PG8_STAGE(PG8_SA(1, 0), a3, voffA);
            PG8_BAR; PG8_WAIT_L(0); PG8_MMA(1, 0, At, B0); PG8_BAR; PG8_SCHED;
            PG8_STAGE(PG8_SB(1, 1), b3 + hstep, voffB);
            PG8_WAIT_V(6); PG8_BAR; PG8_MMA(1, 1, At, B1); PG8_BAR;
            }
        }
        if constexpr (ALIGN_EPI) { if (wr == 0) PG8_BAR; }
        if constexpr (!Epi::AFTER_DRAIN) { if constexpr (Epi::PF) E(acc, cur, wr, wc, fr, fq, lds + STAGE_BYTES + wid * 512); else E(acc, cur, wr, wc, fr, fq); S.done(cur); }
        if (!has_next) break;
#pragma unroll
        for (int a = 0; a < 2; ++a)
#pragma unroll
            for (int b = 0; b < 2; ++b)
#pragma unroll
                for (int m = 0; m < 4; ++m)
#pragma unroll
                    for (int n = 0; n < 2; ++n) acc[a][b][m][n] = (f32x4){0.f, 0.f, 0.f, 0.f};
        cur = nxt; cA = nA; cB = nB; ++ui;
        if constexpr (ALIGN_EPI) { if (wr == 1) PG8_BAR; }
    }
    PG8_WAIT_V(0);
    if constexpr (!ALIGN_EPI) { if (wr == 0) PG8_BAR; }
    PG8_BAR;
    if constexpr (Epi::AFTER_DRAIN) { E.fused(acc, cur, wr, wc, fr, fq, lds, wid, lane); S.done(cur); }
#undef PG8_SA
#undef PG8_SB
#undef PG8_STAGE
#undef PG8_LDA
#undef PG8_LDB
#undef PG8_MMA
#undef PG8_WAIT_V
#undef PG8_WAIT_L
#undef PG8_BAR
#undef PG8_SCHED
}
}

#ifndef MK_N_LAUNCHES
#define MK_N_LAUNCHES 1
#endif
#ifndef PROBE_PHASE
#define PROBE_PHASE -1
#endif
#define REP(k) (((k) == PROBE_PHASE) ? 2 : 1)
constexpr int NPH = 16;
constexpr int N_LAUNCHES = MK_N_LAUNCHES;
constexpr int NWAVES = 8, NTHR = 512;
constexpr int BATCH = 2, SEQ = 4096, T = BATCH * SEQ, DM = 2048, FF = 5632, PLE = 256;
constexpr int MLA_H = 8, QKH = 192, VH = 128, QL = 512, KVL = 256;
constexpr int RH = 16, RD = 1024;
constexpr int ZW = 4096;
constexpr int Z_R = 768, Z_K = 1792, Z_V = 2816, Z_LORA = 3840;
constexpr int LW = 3072;
constexpr float EPS = 1e-6f, GN_EPS = 64e-5f;
constexpr float QSCALE = 1.4426950408889634f * 0.07216878364870322f;

constexpr size_t MiB = 1u << 20;
constexpr size_t WS_CTL = 0, CTL_ZERO_BYTES = 1 * MiB;
constexpr size_t WS_ROPE = 1 * MiB;
constexpr size_t WS_BONUS = 2 * MiB;
constexpr size_t WS_WIN = 3 * MiB;
constexpr size_t WS_WQB = 20 * MiB;
constexpr size_t WS_WKVB = WS_WQB + 1536 * 512 * 2;
constexpr size_t WS_WLORA = WS_WKVB + 2048 * 256 * 2;
constexpr size_t WS_WOUT = 25 * MiB;
constexpr size_t WS_WPG = 33 * MiB;
constexpr size_t WS_WPP = 41 * MiB;
constexpr size_t WS_WGU = 42 * MiB;
constexpr size_t WS_WD = 86 * MiB;
constexpr size_t WS_WD2 = 3 * MiB;
static_assert(WS_WD2 + (size_t)2048 * 5632 * 2 <= WS_WOUT && WS_WPP + 2048 * 256 * 2 <= WS_WGU, "ws map 2");
constexpr size_t WS_H = 108 * MiB;
constexpr size_t WS_U = 140 * MiB;
constexpr size_t WS_X = 228 * MiB;
constexpr size_t WS_END = 408 * MiB;
constexpr size_t WS_Z = WS_U, WS_AQ = WS_U + 64 * MiB, WS_AKV = WS_AQ + 8 * MiB, WS_AL = WS_AKV + 4 * MiB, WS_KPEP = WS_AL + 4 * MiB;
constexpr size_t WS_WKPE = WS_WIN + 16 * MiB;
constexpr size_t WS_QRAW = WS_X, WS_KVRAW = WS_X + 24 * MiB, WS_LORA = WS_X + 56 * MiB;
constexpr size_t WS_QH = WS_X + 104 * MiB, WS_KH = WS_X + 128 * MiB, WS_VT = WS_X + 152 * MiB;
constexpr size_t WS_OMIX = WS_X;
constexpr size_t WS_TRT = WS_WGU;
constexpr size_t WS_SLOT = WS_TRT + 32 * MiB;
constexpr size_t WS_RRT = WS_SLOT + 32 * MiB;
constexpr size_t WS_G2T = WS_RRT + 16 * MiB;
constexpr size_t WS_VCG = WS_AQ;
static_assert(WS_G2T + 8 * MiB <= WS_U && WS_VCG + 16 * MiB <= WS_X, "chunk matrices");
constexpr size_t WS_OTMP = WS_X + 32 * MiB;
constexpr size_t WS_AST = WS_X + 172 * MiB;
constexpr size_t WS_PB = WS_X + 168 * MiB, WS_PPLE = WS_X + 8 * MiB;
static_assert(WS_WLORA + 3072 * 256 * 2 <= WS_WOUT && WS_VT + 16 * MiB <= WS_END && WS_AL + 4 * MiB <= WS_X, "ws map");
constexpr int CW_BAR = 4096, CW_QUEUE = 64, CW_SS = 32768;

constexpr int RING_OFF = 0, RING_BYTES = 131072;
constexpr int LDSCTL_OFF = 157696, MISC_OFF = LDSCTL_OFF + 320;
constexpr int LDS_BYTES = 159744;

#define GAS __attribute__((address_space(1)))
#define LAS __attribute__((address_space(3)))
typedef unsigned short bf16;
typedef unsigned v4u __attribute__((ext_vector_type(4)));
typedef unsigned v2u __attribute__((ext_vector_type(2)));
typedef float f32x4 __attribute__((ext_vector_type(4)));
typedef float f32x2 __attribute__((ext_vector_type(2)));
typedef float f32x16 __attribute__((ext_vector_type(16)));
typedef short bf16x8 __attribute__((ext_vector_type(8)));
typedef GAS unsigned gu32;
#define RLX_AGENT __ATOMIC_RELAXED, __HIP_MEMORY_SCOPE_AGENT
#define LDS_WAIT() asm volatile("s_waitcnt lgkmcnt(0)" ::: "memory")
#define VM_WAIT() asm volatile("s_waitcnt vmcnt(0)" ::: "memory")
__device__ __forceinline__ unsigned f2bf(float f) { unsigned u = __builtin_bit_cast(unsigned, f); return (u + 0x7fffu + ((u >> 16) & 1u)) >> 16; }
__device__ __forceinline__ unsigned pk2(float lo, float hi) { return f2bf(lo) | (f2bf(hi) << 16); }
__device__ __forceinline__ float bf2f(unsigned short h) { return __builtin_bit_cast(float, (unsigned)h << 16); }
__device__ __forceinline__ float bflo(unsigned w) { return __builtin_bit_cast(float, w << 16); }
__device__ __forceinline__ float bfhi(unsigned w) { return __builtin_bit_cast(float, w & 0xffff0000u); }
__device__ __forceinline__ float sigmoidf_(float x) { return __builtin_amdgcn_rcpf(1.0f + __builtin_amdgcn_exp2f(-1.4426950408889634f * x)); }
__device__ __forceinline__ float wave_sum(float v) {
#pragma unroll
    for (int o = 1; o < 64; o <<= 1) v += __shfl_xor(v, o);
    return v;
}

#define XB_TMO      128
#define XB_XCNT(j)  (256  + 64 * (j))
#define XB_XSUB(j)  (1280 + 64 * (j))
#define XB_XGEN(j)  (2304 + 64 * (j))
#define XB_TOP      3328
#define XB_TOPGEN   3392
#define XCD_BAR_WORDS 3456
#define XB_SPIN_CAP (1u << 18)

__device__ __forceinline__ unsigned xb_ld(unsigned* p)              { return __hip_atomic_load(p, __ATOMIC_RELAXED, __HIP_MEMORY_SCOPE_AGENT); }
__device__ __forceinline__ unsigned xb_add(unsigned* p, unsigned v) { return __hip_atomic_fetch_add(p, v, __ATOMIC_RELAXED, __HIP_MEMORY_SCOPE_AGENT); }
__device__ __forceinline__ unsigned xb_xcc_id() { return (unsigned)__builtin_amdgcn_s_getreg((3 << 11) | 20) & 0xFu; }
#define XB_SPIN(cond, bar) do { unsigned _sp = 0; while (cond) { __builtin_amdgcn_s_sleep(1); \
    if ((++_sp & 255u) == 0u) { if (xb_ld(&(bar)[XB_TMO])) break; if (_sp > XB_SPIN_CAP) { atomicAdd(&(bar)[XB_TMO], 1u); break; } } } } while (0)

struct XcdBarrier {
    unsigned* bar; unsigned x;
    volatile LAS unsigned* st;
};

__device__ __forceinline__ XcdBarrier xcd_barrier_post(unsigned* bar, volatile LAS unsigned* st) {
    XcdBarrier b; b.bar = bar; b.x = xb_xcc_id(); b.st = st;
    if (threadIdx.x == 0) (void)xb_add(&bar[XB_XCNT(b.x)], 1u);
    return b;
}
__device__ __forceinline__ void xcd_barrier_complete(unsigned* bar, unsigned x, unsigned& nloc, unsigned& nx) {
    const unsigned G = gridDim.x * gridDim.y * gridDim.z;
    unsigned sum, cnt, mine, sp = 0u;
    for (;;) {
        sum = 0u; cnt = 0u; mine = 0u;
#pragma unroll
        for (unsigned j = 0; j < 16; ++j) { const unsigned c = xb_ld(&bar[XB_XCNT(j)]); sum += c; cnt += (c > 0u) ? 1u : 0u; mine = (j == x) ? c : mine; }
        if (sum == G) break;
        __builtin_amdgcn_s_sleep(1);
        if ((++sp & 255u) == 0u) { if (xb_ld(&bar[XB_TMO])) break; if (sp > XB_SPIN_CAP) { atomicAdd(&bar[XB_TMO], 1u); break; } }
    }
    nloc = mine > 0u ? mine : 1u; nx = cnt > 0u ? cnt : 1u;
}

__device__ __forceinline__ void xcd_barrier(const XcdBarrier& b) {
    asm volatile("s_waitcnt vmcnt(0)" ::: "memory");
    __syncthreads();
    if (threadIdx.x == 0) {
        unsigned* bar = b.bar;
        __builtin_amdgcn_s_waitcnt(0);
        unsigned nloc = b.st[0], nx = b.st[1];
        if (nloc == 0u) { xcd_barrier_complete(bar, b.x, nloc, nx); b.st[0] = nloc; b.st[1] = nx; }
        const unsigned old = xb_add(&bar[XB_XSUB(b.x)], 1u);
        const unsigned gen = old / nloc;
        if (old + 1u == (gen + 1u) * nloc) {
            __builtin_amdgcn_fence(__ATOMIC_RELEASE, "agent");
            asm volatile("s_waitcnt vmcnt(0)" ::: "memory");
            const unsigned og = xb_add(&bar[XB_TOP], 1u);
            const unsigned tg = og / nx;
            if (og + 1u == (tg + 1u) * nx) xb_add(&bar[XB_TOPGEN], 1u);
            else XB_SPIN(xb_ld(&bar[XB_TOPGEN]) == tg, bar);
            __builtin_amdgcn_fence(__ATOMIC_ACQUIRE, "agent");
            xb_add(&bar[XB_XGEN(b.x)], 1u);
            asm volatile("s_waitcnt vmcnt(0)" ::: "memory");
        } else {
            XB_SPIN(xb_ld(&bar[XB_XGEN(b.x)]) == gen, bar);
            __builtin_amdgcn_fence(__ATOMIC_ACQUIRE, "agent");
            asm volatile("s_waitcnt vmcnt(0)" ::: "memory");
        }
    }
    __syncthreads();
}


struct Args { const float* in[33]; float* out; unsigned char* ws; int ph_lo, ph_hi; };

struct WJob { const float* W0; const float* W1; const float* gain; bf16* dst; int K, N, NP, KD, koff, mode, LDN, coff, skip_at, skip_by, nlo; };
__device__ __forceinline__ int job_items(const WJob& j) { return (j.KD / 64) * (j.NP / 32); }
__device__ __forceinline__ bf16* tr_load(const WJob& j, int item, int lane, f32x4 (&v)[8]) {
    const int nblk = j.NP / 32, kb = item / nblk, nb = item % nblk, k0 = 64 * kb, n0 = j.nlo + 32 * nb;
    const int g = lane & 7, kc = lane >> 3, np = n0 + 4 * g, kk = k0 + 8 * kc;
    const float* W = j.W0; int col = np + j.coff + (np >= j.skip_at ? j.skip_by : 0); bool nvalid = np < j.N;
    if (j.mode == 1) { const int i = np & 7, jj = np >> 3; const ptrdiff_t dW = j.W1 - j.W0; W = j.W0 + ((i < 4) ? (ptrdiff_t)0 : dW); col = 4 * jj; nvalid = true; }
#pragma unroll
    for (int i = 0; i < 8; ++i) {
        const int k = kk + i - j.koff;
        const bool ok = nvalid && k >= 0 && k < j.K;
        v[i] = (f32x4){0.f, 0.f, 0.f, 0.f};
        if (ok) { v[i] = __builtin_nontemporal_load((const GAS f32x4*)(W + (size_t)k * j.LDN + col)); if (j.gain) v[i] = v[i] * j.gain[k]; }
    }
    return j.dst + (size_t)np * j.KD + kk;
}
__device__ __forceinline__ void tr_store(const WJob& j, const f32x4 (&v)[8], bf16* d) {
#pragma unroll
    for (int q = 0; q < 4; ++q) { v4u o; o.x = pk2(v[0][q], v[1][q]); o.y = pk2(v[2][q], v[3][q]); o.z = pk2(v[4][q], v[5][q]); o.w = pk2(v[6][q], v[7][q]);
        *(GAS v4u*)(d + (size_t)q * j.KD) = o; }
}
__device__ __forceinline__ WJob mk_job(const float* W0, const float* W1, const float* gain, bf16* dst, int K, int N, int NP, int KD, int koff, int mode, int LDN = 0, int coff = 0, int skip_at = 1 << 30, int skip_by = 0, int nlo = 0) {
    WJob j; j.W0 = W0; j.W1 = W1; j.gain = gain; j.dst = dst; j.K = K; j.N = N; j.NP = NP; j.KD = KD; j.koff = koff; j.mode = mode; j.LDN = LDN ? LDN : N; j.coff = coff; j.skip_at = skip_at; j.skip_by = skip_by; j.nlo = nlo; return j;
}
__device__ __forceinline__ void run_job(const WJob& j, int gw, int NGW, int& base, LAS float* scr, int lane) {
    const int n = job_items(j);
    int first = (gw - base) % NGW; if (first < 0) first += NGW;
    (void)scr;
    for (int it = first; it < n; it += 2 * NGW) {
        f32x4 va[8], vb[8]; bf16* db = nullptr; const bool hb = it + NGW < n;
        bf16* da = tr_load(j, it, lane, va);
        if (hb) db = tr_load(j, it + NGW, lane, vb);
        tr_store(j, va, da);
        if (hb) tr_store(j, vb, db);
    }
    base = (base + n) % NGW;
}

__device__ __forceinline__ void rms_row_bf16(const float* xrow, bf16* orow, int lane) {
    const GAS f32x4* xr = (const GAS f32x4*)xrow + lane;
    f32x4 v[8]; float s = 0.f;
#pragma unroll
    for (int j = 0; j < 8; ++j) { v[j] = xr[64 * j]; s += (v[j].x * v[j].x + v[j].y * v[j].y) + (v[j].z * v[j].z + v[j].w * v[j].w); }
    const float rstd = 1.0f / sqrtf(wave_sum(s) * (1.f / DM) + EPS);
    GAS unsigned long long* o8 = (GAS unsigned long long*)orow + lane;
#pragma unroll
    for (int j = 0; j < 8; ++j) o8[64 * j] = (unsigned long long)pk2(v[j].x * rstd, v[j].y * rstd) | ((unsigned long long)pk2(v[j].z * rstd, v[j].w * rstd) << 32);
}
__device__ __forceinline__ void rms_pass(const float* X, bf16* H, int gw, int NGW, int lane) {
    for (int m = gw; m < T; m += NGW) rms_row_bf16(X + (size_t)m * DM, H + (size_t)m * DM, lane);
}
__device__ __forceinline__ void xb_pass(const float* X, bf16* XB, float* ss, int gw, int NGW, int lane) {
    for (int m = gw; m < T; m += 2 * NGW) {
        const int m2 = m + NGW; const bool hb = m2 < T;
        const GAS f32x4* xa = (const GAS f32x4*)(X + (size_t)m * DM) + lane; const GAS f32x4* xb = (const GAS f32x4*)(X + (size_t)(hb ? m2 : m) * DM) + lane;
        f32x4 va[8], vb[8]; float sa = 0.f, sb = 0.f;
#pragma unroll
        for (int j = 0; j < 8; ++j) va[j] = __builtin_nontemporal_load(xa + 64 * j);
#pragma unroll
        for (int j = 0; j < 8; ++j) vb[j] = __builtin_nontemporal_load(xb + 64 * j);
#pragma unroll
        for (int j = 0; j < 8; ++j) { sa += (va[j].x * va[j].x + va[j].y * va[j].y) + (va[j].z * va[j].z + va[j].w * va[j].w); sb += (vb[j].x * vb[j].x + vb[j].y * vb[j].y) + (vb[j].z * vb[j].z + vb[j].w * vb[j].w); }
        sa = wave_sum(sa); sb = wave_sum(sb);
        GAS unsigned long long* oa = (GAS unsigned long long*)(XB + (size_t)m * DM) + lane;
#pragma unroll
        for (int j = 0; j < 8; ++j) oa[64 * j] = (unsigned long long)pk2(va[j].x, va[j].y) | ((unsigned long long)pk2(va[j].z, va[j].w) << 32);
        if (lane == 0) ss[m] = sa;
        if (hb) { GAS unsigned long long* ob = (GAS unsigned long long*)(XB + (size_t)m2 * DM) + lane;
#pragma unroll
            for (int j = 0; j < 8; ++j) ob[64 * j] = (unsigned long long)pk2(vb[j].x, vb[j].y) | ((unsigned long long)pk2(vb[j].z, vb[j].w) << 32);
            if (lane == 0) ss[m2] = sb; }
    }
}

__device__ __forceinline__ void prep_a_row(int t, const bf16* Z, const float* mu, bf16* AQ, bf16* AKV, bf16* AL, int lane) {
    const bf16* zr = Z + (size_t)t * ZW;
    {
        const v4u w = *(const GAS v4u*)(zr + lane * 8);
        float x[8] = {bflo(w.x), bfhi(w.x), bflo(w.y), bfhi(w.y), bflo(w.z), bfhi(w.z), bflo(w.w), bfhi(w.w)};
        float s = 0.f;
#pragma unroll
        for (int e = 0; e < 8; ++e) s += x[e] * x[e];
        const float rstd = 1.0f / sqrtf(wave_sum(s) * (1.f / QL) + EPS);
        v4u o; o.x = pk2(x[0] * rstd, x[1] * rstd); o.y = pk2(x[2] * rstd, x[3] * rstd); o.z = pk2(x[4] * rstd, x[5] * rstd); o.w = pk2(x[6] * rstd, x[7] * rstd);
        *(GAS v4u*)(AQ + (size_t)t * QL + lane * 8) = o;
    }
    {
        const v2u w = *(const GAS v2u*)(zr + QL + lane * 4);
        float x[4] = {bflo(w.x), bfhi(w.x), bflo(w.y), bfhi(w.y)};
        const float s = (x[0] * x[0] + x[1] * x[1]) + (x[2] * x[2] + x[3] * x[3]);
        const float rstd = 1.0f / sqrtf(wave_sum(s) * (1.f / KVL) + EPS);
        v2u o; o.x = pk2(x[0] * rstd, x[1] * rstd); o.y = pk2(x[2] * rstd, x[3] * rstd);
        *(GAS v2u*)(AKV + (size_t)t * KVL + lane * 4) = o;
    }
    {
        const v2u w = *(const GAS v2u*)(zr + Z_LORA + lane * 4);
        v2u wp; wp.x = 0u; wp.y = 0u;
        if ((t % SEQ) != 0) wp = *(const GAS v2u*)(zr - ZW + Z_LORA + lane * 4);
        const f32x4 m4 = *(const GAS f32x4*)(mu + (Z_LORA - Z_R) + lane * 4);
        float c[4] = {bflo(w.x), bfhi(w.x), bflo(w.y), bfhi(w.y)}, p[4] = {bflo(wp.x), bfhi(wp.x), bflo(wp.y), bfhi(wp.y)}, o[4];
#pragma unroll
        for (int e = 0; e < 4; ++e) { const float zs = c[e] + (p[e] - c[e]) * m4[e];
            float r;
            if (lane < 16) r = 1.0f - 2.0f * __builtin_amdgcn_rcpf(__builtin_amdgcn_exp2f(2.8853900817779268f * zs) + 1.0f);
            else if (lane < 32) r = zs;
            else r = sigmoidf_(zs);
            o[e] = r; }
        v2u ow; ow.x = pk2(o[0], o[1]); ow.y = pk2(o[2], o[3]);
        *(GAS v2u*)(AL + (size_t)t * 256 + lane * 4) = ow;
    }
}

template <int CTRL> __device__ __forceinline__ float dpp_add(float x) { return x + __builtin_bit_cast(float, __builtin_amdgcn_update_dpp(0, __builtin_bit_cast(int, x), CTRL, 0xF, 0xF, true)); }
__device__ __forceinline__ float allreduce16(float x) { x = dpp_add<0xB1>(x); x = dpp_add<0x4E>(x); x = dpp_add<0x141>(x); x = dpp_add<0x140>(x); return x; }
__device__ __forceinline__ float wave_sum_dpp(float x) { x = allreduce16(x); x += __shfl_xor(x, 16); x += __shfl_xor(x, 32); return x; }
__device__ __forceinline__ float allreduce64(float x) { x = allreduce16(x); float a_ = x, b_ = x;
    asm volatile("s_nop 1\n\tv_permlane16_swap_b32 %0, %1" : "+v"(a_), "+v"(b_));
    x = a_ + b_; a_ = x; b_ = x;
    asm volatile("s_nop 1\n\tv_permlane32_swap_b32 %0, %1" : "+v"(a_), "+v"(b_));
    return a_ + b_; }
__device__ __forceinline__ void kpe_task(int task, const bf16* XB, const bf16* WK, const float* ss, float* KPE, LAS unsigned char* lds, int tid) {
    const int lane = tid & 63, wv = __builtin_amdgcn_readfirstlane(tid >> 6), r32 = lane & 31, hi = lane >> 5, r0 = task * 32;
    f32x16 acc0, acc1;
#pragma unroll
    for (int r = 0; r < 16; ++r) { acc0[r] = 0.f; acc1[r] = 0.f; }
    const bf16* ap = XB + (size_t)(r0 + r32) * DM + 256 * wv + 8 * hi;
    const bf16* bp0 = WK + (size_t)r32 * DM + 256 * wv + 8 * hi; const bf16* bp1 = bp0 + (size_t)32 * DM;
#pragma unroll
    for (int half = 0; half < 2; ++half) {
        bf16x8 a[8], b0[8], b1[8];
#pragma unroll
        for (int ks = 0; ks < 8; ++ks) { const int ko = (half * 8 + ks) * 16; a[ks] = *(const GAS bf16x8*)(ap + ko); b0[ks] = *(const GAS bf16x8*)(bp0 + ko); b1[ks] = *(const GAS bf16x8*)(bp1 + ko); }
#pragma unroll
        for (int ks = 0; ks < 8; ++ks) { acc0 = __builtin_amdgcn_mfma_f32_32x32x16_bf16(a[ks], b0[ks], acc0, 0, 0, 0); acc1 = __builtin_amdgcn_mfma_f32_32x32x16_bf16(a[ks], b1[ks], acc1, 0, 0, 0); }
    }
    LAS float* red = (LAS float*)lds;
#pragma unroll
    for (int r = 0; r < 16; ++r) { red[(wv * 32 + r) * 64 + lane] = acc0[r]; red[(wv * 32 + 16 + r) * 64 + lane] = acc1[r]; }
    __syncthreads();
#pragma unroll
    for (int q = 0; q < 4; ++q) { const int reg = 4 * wv + q; float s = 0.f;
#pragma unroll
        for (int w = 0; w < 8; ++w) s += red[(w * 32 + reg) * 64 + lane];
        const int tile = reg >> 4, rr = reg & 15, row = r0 + (rr & 3) + 8 * (rr >> 2) + 4 * hi, col = 32 * tile + r32;
        KPE[(size_t)row * 64 + col] = s * __builtin_amdgcn_rsqf(ss[row] * (1.0f / 2048.0f) + 1e-6f); }
    __syncthreads();
}
__device__ __forceinline__ int vpos(int kl) { const int ko = kl & 15; return (kl & 48) + 8 * ((ko >> 2) & 1) + 4 * (ko >> 3) + (ko & 3); }
__device__ __forceinline__ void mla_prep_task(int task, const bf16* QRAW, const bf16* KVRAW, const float* qn, const float* kn, const f32x2* rope,
                                              bf16* Qh, bf16* Kh, bf16* Vt, int lane, const float* KPEP) {
    const int ws = task & 7, tile = (task >> 3) & 63, bh = task >> 9, b = bh >> 3, h = bh & 7;
    const float qg0 = qn[lane], qg1 = qn[64 + lane], qg2 = qn[128 + lane], kg0 = kn[lane], kg1 = kn[64 + lane], kg2 = kn[128 + lane];
    unsigned short qx[8][3], kx[8][2], vx[8][2]; float kpe[8];
#pragma unroll
    for (int i = 0; i < 8; ++i) { const int t = b * SEQ + tile * 64 + ws * 8 + i;
        const bf16* qr = QRAW + (size_t)t * 1536 + h * QKH; const bf16* kr = KVRAW + (size_t)t * 2048 + h * 256;
        qx[i][0] = qr[lane]; qx[i][1] = qr[64 + lane]; qx[i][2] = qr[128 + lane];
        kx[i][0] = kr[lane]; kx[i][1] = kr[64 + lane];
        kpe[i] = KPEP[(size_t)t * 64 + lane];
        vx[i][0] = kr[128 + lane]; vx[i][1] = kr[192 + lane]; }
#pragma unroll
    for (int i = 0; i < 8; ++i) {
        const int kl = ws * 8 + i, s = tile * 64 + kl;
        const f32x2 cs = rope[s * 32 + (lane & 31)];
        const float sgn = (lane < 32) ? -1.0f : 1.0f;
        {   float x0 = bf2f(qx[i][0]), x1 = bf2f(qx[i][1]), x2 = bf2f(qx[i][2]);
            const float rstd = __builtin_amdgcn_rsqf(wave_sum_dpp(x0 * x0 + x1 * x1 + x2 * x2) * (1.f / QKH) + EPS);
            x0 *= rstd * qg0; x1 *= rstd * qg1; x2 *= rstd * qg2;
            const float pr = __shfl_xor(x2, 32);
            x2 = x2 * cs.x + sgn * pr * cs.y;
            bf16* qo = Qh + ((size_t)bh * SEQ + s) * QKH;
            qo[lane] = (bf16)f2bf(x0 * QSCALE); qo[64 + lane] = (bf16)f2bf(x1 * QSCALE); qo[128 + lane] = (bf16)f2bf(x2 * QSCALE); }
        {   float x0 = bf2f(kx[i][0]), x1 = bf2f(kx[i][1]), x2 = kpe[i];
            const float rstd = __builtin_amdgcn_rsqf(wave_sum_dpp(x0 * x0 + x1 * x1 + x2 * x2) * (1.f / QKH) + EPS);
            x0 *= rstd * kg0; x1 *= rstd * kg1; x2 *= rstd * kg2;
            const float pr = __shfl_xor(x2, 32);
            x2 = x2 * cs.x + sgn * pr * cs.y;
            bf16* ko = Kh + ((size_t)bh * SEQ + s) * QKH;
            ko[lane] = (bf16)f2bf(x0); ko[64 + lane] = (bf16)f2bf(x1); ko[128 + lane] = (bf16)f2bf(x2); }
    }
    {   bf16* vt = Vt + ((size_t)bh * 64 + tile) * 8192 + 16 * (ws >> 1) + 4 * (ws & 1);
        v2u a0, a1, c0, c1;
        a0.x = (unsigned)vx[0][0] | ((unsigned)vx[1][0] << 16); a0.y = (unsigned)vx[2][0] | ((unsigned)vx[3][0] << 16);
        a1.x = (unsigned)vx[4][0] | ((unsigned)vx[5][0] << 16); a1.y = (unsigned)vx[6][0] | ((unsigned)vx[7][0] << 16);
        c0.x = (unsigned)vx[0][1] | ((unsigned)vx[1][1] << 16); c0.y = (unsigned)vx[2][1] | ((unsigned)vx[3][1] << 16);
        c1.x = (unsigned)vx[4][1] | ((unsigned)vx[5][1] << 16); c1.y = (unsigned)vx[6][1] | ((unsigned)vx[7][1] << 16);
        *(GAS v2u*)(vt + lane * 64) = a0; *(GAS v2u*)(vt + lane * 64 + 8) = a1;
        *(GAS v2u*)(vt + (64 + lane) * 64) = c0; *(GAS v2u*)(vt + (64 + lane) * 64 + 8) = c1; }
}

namespace att {
constexpr int KROW = 400, VROW = 144, KT = 64 * KROW, VTB = 128 * VROW, BUFB = KT + VTB, WSF_OFF = 2 * BUFB;
static_assert(WSF_OFF + 8 * 32 * 4 <= RING_BYTES, "attention LDS");
static_assert(RING_OFF + pg8::STAGE_BYTES + 8 * 512 <= LDSCTL_OFF, "GEMM epilogue prefetch slots");
__device__ __forceinline__ int crow(int r, int hi) { return (r & 3) + 8 * (r >> 2) + 4 * hi; }
__device__ __forceinline__ bf16x8 pack8(const f32x16& p, int b0) {
    v4u w; w.x = pg8::cvt_pk_bf16(p[b0], p[b0 + 1]); w.y = pg8::cvt_pk_bf16(p[b0 + 2], p[b0 + 3]); w.z = pg8::cvt_pk_bf16(p[b0 + 4], p[b0 + 5]); w.w = pg8::cvt_pk_bf16(p[b0 + 6], p[b0 + 7]);
    return __builtin_bit_cast(bf16x8, w);
}
__device__ __forceinline__ void attn_unit(int bh, int qb, int part, const bf16* Qh, const bf16* Kh, const bf16* Vt, bf16* Odst, int opitch, f32x2* ST, LAS unsigned char* lds) {
    const int tid = threadIdx.x, lane = tid & 63, wid = __builtin_amdgcn_readfirstlane(tid >> 6), r32 = lane & 31, hi = lane >> 5;
    const int b = bh >> 3, h = bh & 7, NTP = 2 * (qb + 1);
    const char* Kg = (const char*)(Kh + (size_t)bh * SEQ * QKH);
    const char* Vg = (const char*)(Vt + (size_t)bh * 64 * 8192);
    const int q0 = qb * 256 + wid * 32;
    bf16x8 qf[12];
    {   const bf16* qp = Qh + ((size_t)bh * SEQ + q0 + r32) * QKH + hi * 8;
#pragma unroll
        for (int ks = 0; ks < 12; ++ks) qf[ks] = *(const GAS bf16x8*)(qp + ks * 16); }
    v4u kst[3], vst[2];
    int kdst[3], vdst[2];
#pragma unroll
    for (int i = 0; i < 3; ++i) { const int c = tid + 512 * i; kdst[i] = (c / 24) * KROW + (c % 24) * 16; }
#pragma unroll
    for (int i = 0; i < 2; ++i) { const int c = tid + 512 * i; vdst[i] = KT + (c >> 3) * VROW + (c & 7) * 16; }
#define ATT_LOAD(j) do { const char* kg = Kg + (size_t)(j) * (64 * QKH * 2); const char* vg = Vg + (size_t)(j) * 16384; \
        _Pragma("unroll") for (int i_ = 0; i_ < 3; ++i_) kst[i_] = *(const GAS v4u*)(kg + (tid + 512 * i_) * 16); \
        _Pragma("unroll") for (int i_ = 0; i_ < 2; ++i_) vst[i_] = *(const GAS v4u*)(vg + (tid + 512 * i_) * 16); } while (0)
#define ATT_STORE(buf) do { LAS unsigned char* bs = lds + (buf) * BUFB; \
        _Pragma("unroll") for (int i_ = 0; i_ < 3; ++i_) *(LAS v4u*)(bs + kdst[i_]) = kst[i_]; \
        _Pragma("unroll") for (int i_ = 0; i_ < 2; ++i_) *(LAS v4u*)(bs + vdst[i_]) = vst[i_]; } while (0)
    ATT_LOAD(part); ATT_STORE(0);
#pragma unroll
    for (int ks = 0; ks < 12; ++ks) asm volatile("" : "+v"(qf[ks]));
    __syncthreads();
    float m = -1e30f, l = 0.f;
    f32x16 o[4];
#pragma unroll
    for (int d = 0; d < 4; ++d)
#pragma unroll
        for (int r = 0; r < 16; ++r) o[d][r] = 0.f;
    LAS float* wsf = (LAS float*)(lds + WSF_OFF) + wid * 32;
    for (int it = 0; it < NTP; ++it) {
        const int j = 2 * it + part;
        if (it + 1 < NTP) ATT_LOAD(j + 2);
        const int k0 = j * 64;
        if (k0 <= q0) {
            const LAS unsigned char* kb = lds + (it & 1) * BUFB; const LAS unsigned char* vb = kb + KT;
            f32x16 p0, p1;
#pragma unroll
            for (int r = 0; r < 16; ++r) { p0[r] = 0.f; p1[r] = 0.f; }
            __builtin_amdgcn_s_setprio(1);
#pragma unroll
            for (int ks = 0; ks < 12; ++ks) {
                const bf16x8 a0 = *(const LAS bf16x8*)(kb + r32 * KROW + ks * 32 + hi * 16);
                const bf16x8 a1 = *(const LAS bf16x8*)(kb + (32 + r32) * KROW + ks * 32 + hi * 16);
                p0 = __builtin_amdgcn_mfma_f32_32x32x16_bf16(a0, qf[ks], p0, 0, 0, 0);
                p1 = __builtin_amdgcn_mfma_f32_32x32x16_bf16(a1, qf[ks], p1, 0, 0, 0);
            }
            __builtin_amdgcn_s_setprio(0);
            if (k0 + 63 > q0) {
                const int q = q0 + r32;
#pragma unroll
                for (int r = 0; r < 16; ++r) { const int key = k0 + crow(r, hi); if (key > q) p0[r] = -1e30f; if (key + 32 > q) p1[r] = -1e30f; }
            }
            float mx = fmaxf(p0[0], p1[0]);
#pragma unroll
            for (int r = 1; r < 16; ++r) mx = fmaxf(mx, fmaxf(p0[r], p1[r]));
            mx = fmaxf(mx, __shfl_xor(mx, 32));
            const float mn = fmaxf(m, mx);
            if (__any(mn > m)) {
                const float al = __builtin_amdgcn_exp2f(m - mn); l *= al; m = mn;
                if (hi == 0) wsf[r32] = al;
                LDS_WAIT();
#pragma unroll
                for (int g = 0; g < 4; ++g) { const f32x4 a4 = *(const LAS f32x4*)(wsf + 8 * g + 4 * hi);
#pragma unroll
                    for (int d = 0; d < 4; ++d)
#pragma unroll
                        for (int e = 0; e < 4; ++e) o[d][4 * g + e] *= a4[e]; }
            }
            float ps = 0.f;
#pragma unroll
            for (int r = 0; r < 16; ++r) { p0[r] = __builtin_amdgcn_exp2f(p0[r] - m); p1[r] = __builtin_amdgcn_exp2f(p1[r] - m); ps += p0[r] + p1[r]; }
            l += ps;
            bf16x8 pa[4]; pa[0] = pack8(p0, 0); pa[1] = pack8(p0, 8); pa[2] = pack8(p1, 0); pa[3] = pack8(p1, 8);
            __builtin_amdgcn_s_setprio(1);
#pragma unroll
            for (int d = 0; d < 4; ++d)
#pragma unroll
                for (int ks = 0; ks < 4; ++ks) {
                    const bf16x8 bv = *(const LAS bf16x8*)(vb + (32 * d + r32) * VROW + ks * 32 + hi * 16);
                    o[d] = __builtin_amdgcn_mfma_f32_32x32x16_bf16(pa[ks], bv, o[d], 0, 0, 0);
                }
            __builtin_amdgcn_s_setprio(0);
        }
        if (it + 1 < NTP) ATT_STORE((it + 1) & 1);
        __syncthreads();
    }
#undef ATT_LOAD
#undef ATT_STORE
    l += __shfl_xor(l, 32);
    const float inv = (l > 0.f) ? 1.0f / l : 0.f;
    if (hi == 0) { wsf[r32] = inv; ST[((size_t)(b * SEQ) + q0 + r32) * MLA_H + h] = (f32x2){m, l}; }
    LDS_WAIT();
    bf16* ob = Odst + ((size_t)(b * SEQ) + q0) * opitch + h * VH + r32;
#pragma unroll
    for (int g = 0; g < 4; ++g) { const f32x4 a4 = *(const LAS f32x4*)(wsf + 8 * g + 4 * hi);
#pragma unroll
        for (int e = 0; e < 4; ++e) { const int row = crow(4 * g + e, hi);
#pragma unroll
            for (int d = 0; d < 4; ++d) ob[(size_t)row * opitch + 32 * d] = (bf16)f2bf(o[d][4 * g + e] * a4[e]); } }
    LDS_WAIT();
}
__device__ __forceinline__ void attn_merge_item(int item, bf16* Omix, const bf16* OTMP, const f32x2* ST, int lane) {
    const int t = item >> 1, h = (item & 1) * 4 + (lane >> 4), dd = (lane & 15) * 8;
    const f32x2 s0 = ST[(size_t)t * MLA_H + h], s1 = ST[(size_t)(T + t) * MLA_H + h];
    const float M = fmaxf(s0.x, s1.x);
    float w0 = s0.y * __builtin_amdgcn_exp2f(s0.x - M), w1 = s1.y * __builtin_amdgcn_exp2f(s1.x - M);
    const float inv = __builtin_amdgcn_rcpf(w0 + w1); w0 *= inv; w1 *= inv;
    bf16* op = Omix + (size_t)t * 2048 + h * VH + dd;
    const v4u a = *(const GAS v4u*)op, bq = *(const GAS v4u*)(OTMP + (size_t)t * 1024 + h * VH + dd);
    v4u o; o.x = pk2(w0 * bflo(a.x) + w1 * bflo(bq.x), w0 * bfhi(a.x) + w1 * bfhi(bq.x)); o.y = pk2(w0 * bflo(a.y) + w1 * bflo(bq.y), w0 * bfhi(a.y) + w1 * bfhi(bq.y));
    o.z = pk2(w0 * bflo(a.z) + w1 * bflo(bq.z), w0 * bfhi(a.z) + w1 * bfhi(bq.z)); o.w = pk2(w0 * bflo(a.w) + w1 * bflo(bq.w), w0 * bfhi(a.w) + w1 * bfhi(bq.w));
    *(GAS v4u*)op = o;
}
}

namespace ck {
constexpr int CH = 32, NCH = SEQ / CH;
constexpr int PCK = 72, PKC = 32, PCC = 32;
constexpr int O_AT = 0, O_BT = 4608, O_KT = 9216, O_RT = 13824;
constexpr int O_P0 = 0, O_PT0 = 2048, O_P1 = 4096, O_PT1 = 6144, O_TT0 = 8192, O_TT1 = 10240, O_MAK = 12288, O_MBRT = 14336, O_G1 = 16384;
constexpr int O_AT2 = 0, O_VKT = 4096;
constexpr int O_ATT = 18432, O_RTT = 22528, O_BBT = 26624, O_KBT = 30720, O_VC = 34816, O_GC = 38912;
constexpr int UNIT_LDS = 39424, UNITS_PER_WG = 4;
static_assert(O_GC + 256 <= UNIT_LDS && UNITS_PER_WG * UNIT_LDS <= LDSCTL_OFF, "chunk_pre LDS");
typedef float ck_f32x2 __attribute__((ext_vector_type(2))); typedef __bf16 ck_bf16x2 __attribute__((ext_vector_type(2)));
__device__ __forceinline__ unsigned cvt2(float lo, float hi) { ck_f32x2 v = {lo, hi}; ck_bf16x2 b = __builtin_convertvector(v, ck_bf16x2); return __builtin_bit_cast(unsigned, b); }
__device__ __forceinline__ int crow(int r, int hi) { return (r & 3) + 8 * (r >> 2) + 4 * hi; }
__device__ __forceinline__ void zero16(f32x16& a) {
#pragma unroll
    for (int r = 0; r < 16; ++r) a[r] = 0.f; }
template <int KD> __device__ __forceinline__ void mm(f32x16& acc, const LAS unsigned char* X, int px, int xr0, const LAS unsigned char* YT, int py, int yr0, int r32, int hi) {
#pragma unroll
    for (int ks = 0; ks < KD / 16; ++ks) {
        const bf16x8 a = *(const LAS bf16x8*)(X + ((xr0 + r32) * px + ks * 16 + 8 * hi) * 2);
        const bf16x8 b = *(const LAS bf16x8*)(YT + ((yr0 + r32) * py + ks * 16 + 8 * hi) * 2);
        acc = __builtin_amdgcn_mfma_f32_32x32x16_bf16(a, b, acc, 0, 0, 0);
    }
}
__device__ __forceinline__ void storeT(const f32x16& acc, LAS unsigned char* dst, int pd, int r0, int c0, int r32, int hi) {
#pragma unroll
    for (int g = 0; g < 4; ++g) { v2u w; w.x = cvt2(acc[4 * g], acc[4 * g + 1]); w.y = cvt2(acc[4 * g + 2], acc[4 * g + 3]);
        *(LAS v2u*)(dst + ((r0 + r32) * pd + c0 + 8 * g + 4 * hi) * 2) = w; }
}
__device__ __forceinline__ void storeTg(const f32x16& acc, bf16* dst, int pd, int r0, int c0, int r32, int hi) {
#pragma unroll
    for (int g = 0; g < 4; ++g) { v2u w; w.x = cvt2(acc[4 * g], acc[4 * g + 1]); w.y = cvt2(acc[4 * g + 2], acc[4 * g + 3]);
        *(GAS v2u*)(dst + (size_t)(r0 + r32) * pd + c0 + 8 * g + 4 * hi) = w; }
}
__device__ __forceinline__ bf16x8 idfrag(int ks, int r32, int hi) {
    bf16x8 f;
#pragma unroll
    for (int j = 0; j < 8; ++j) f[j] = (ks * 16 + 8 * hi + j == r32) ? (short)0x3F80 : (short)0;
    return f;
}

struct Bat { unsigned short zr[8], zk[8], zv[8], lw[8], la[8]; };
#define CKA_LOAD(B, zp_, lp_, tb) do { _Pragma("unroll") for (int i = 0; i < 8; ++i) { const bf16* z1 = (zp_) + (size_t)((tb) + i) * ZW; B.zr[i] = z1[Z_R]; B.zk[i] = z1[Z_K]; B.zv[i] = z1[Z_V]; \
            B.lw[i] = (lp_)[(size_t)((tb) + i) * LW]; B.la[i] = (lp_)[(size_t)((tb) + i) * LW + 1024]; } } while (0)
__device__ __forceinline__ void preload(int unit, const bf16* Z, const bf16* L, Bat& B0, Bat& B1, unsigned short& qr, unsigned short& qk, unsigned short& qv, int lane) {
    const int chain = unit >> 7, c = unit & 127, b = chain >> 4, h = chain & 15, ch = h * 64 + lane, t0 = b * SEQ + c * CH;
    const bf16* zp = Z + (size_t)t0 * ZW + ch; const bf16* lp = L + (size_t)t0 * LW + ch;
    qr = 0; qk = 0; qv = 0;
    if (c > 0) { qr = zp[Z_R - ZW]; qk = zp[Z_K - ZW]; qv = zp[Z_V - ZW]; }
    CKA_LOAD(B0, zp, lp, 0); CKA_LOAD(B1, zp, lp, 8);
}
__device__ __forceinline__ void chunk_pre(int unit, const bf16* Z, const bf16* L, const float* mu, const float* w0, const float* a0, const float* k_k, const float* k_a, const float* r_k,
                                          float* BONUS, bf16* TRT, unsigned* SLOT, bf16* RRT, bf16* G2T, bf16* VCG, LAS unsigned char* lds, int lane,
                                          Bat& B0, Bat& B1, unsigned short& qr, unsigned short& qk, unsigned short& qv, int nxt) {
    const int chain = unit >> 7, c = unit & 127, b = chain >> 4, h = chain & 15, ch = h * 64 + lane, r32 = lane & 31, hi = lane >> 5;
    const int t0 = b * SEQ + c * CH;
    LAS bf16* At = (LAS bf16*)(lds + O_AT); LAS bf16* Bt = (LAS bf16*)(lds + O_BT); LAS bf16* Kt = (LAS bf16*)(lds + O_KT); LAS bf16* Rt = (LAS bf16*)(lds + O_RT);
    LAS bf16* AtT = (LAS bf16*)(lds + O_ATT); LAS bf16* RtT = (LAS bf16*)(lds + O_RTT); LAS bf16* BbT = (LAS bf16*)(lds + O_BBT); LAS bf16* KbT = (LAS bf16*)(lds + O_KBT);
    LAS bf16* Vc = (LAS bf16*)(lds + O_VC);
    {
        const float mu_r = mu[ch], mu_k = mu[1024 + ch], mu_v = mu[2048 + ch], w0c = w0[ch], a0c = a0[ch], kkc = k_k[ch], kac = k_a[ch], rkc = r_k[ch];
        const bf16* zp = Z + (size_t)t0 * ZW + ch; const bf16* lp = L + (size_t)t0 * LW + ch;
        float pr = bf2f(qr), pk = bf2f(qk), pv = bf2f(qv);
        float gam = 1.0f, mybon = 0.f;
        unsigned aRow = (unsigned)(size_t)(At + lane), aCol = (unsigned)(size_t)(AtT + lane * PKC);
        asm volatile("" : "+v"(aRow), "+v"(aCol));
#define CK_W16(base, off, v) (*(LAS bf16*)(size_t)((base) + (unsigned)(off)) = (v))
#define CKA_PROC(B, tb) do { unsigned short at8[8], rt8[8], vv8[8]; \
        _Pragma("unroll") for (int hf = 0; hf < 2; ++hf) { float r4[4], dec4[4], a4[4], kk4[4], kp4[4], n24[4], bo4[4]; \
        _Pragma("unroll") for (int j = 0; j < 4; ++j) { const int i = 4 * hf + j; \
            const float rc = bf2f(B.zr[i]), kc = bf2f(B.zk[i]), vc = bf2f(B.zv[i]); \
            r4[j] = rc + (pr - rc) * mu_r; const float k_ = kc + (pk - kc) * mu_k; vv8[i] = (unsigned short)(cvt2(vc + (pv - vc) * mu_v, 0.f) & 0xffffu); \
            pr = rc; pk = kc; pv = vc; \
            dec4[j] = __builtin_amdgcn_exp2f(-0.8750612633917001f * sigmoidf_(w0c + bf2f(B.lw[i]))); \
            a4[j] = sigmoidf_(a0c + bf2f(B.la[i])); \
            kk4[j] = k_ * kkc; n24[j] = kk4[j] * kk4[j]; \
            kp4[j] = k_ * (1.0f + (a4[j] - 1.0f) * kac); bo4[j] = r4[j] * kp4[j] * rkc; } \
        _Pragma("unroll") for (int j = 0; j < 4; ++j) { n24[j] = wave_sum_dpp(n24[j]); bo4[j] = wave_sum_dpp(bo4[j]); }     \
        _Pragma("unroll") for (int j = 0; j < 4; ++j) { const int i = 4 * hf + j, t = (tb) + i; \
            const float kk = kk4[j] * __builtin_amdgcn_rsqf(fmaxf(n24[j], 1e-24f)); \
            mybon = (lane == t) ? bo4[j] : mybon; \
            const float gprev = gam; gam *= dec4[j]; const float ig = __builtin_amdgcn_rcpf(gam); \
            const unsigned ar = cvt2(-gprev * kk, gam * r4[j]), bk = cvt2(kk * a4[j] * ig, kp4[j] * ig); \
            at8[i] = (unsigned short)(ar & 0xffffu); rt8[i] = (unsigned short)(ar >> 16); \
            CK_W16(aRow, t * PCK * 2, at8[i]); \
            CK_W16(aRow, (O_BT - O_AT) + t * PCK * 2, (bf16)(bk & 0xffffu)); CK_W16(aRow, (O_KT - O_AT) + t * PCK * 2, (bf16)(bk >> 16)); \
            CK_W16(aRow, (O_RT - O_AT) + t * PCK * 2, rt8[i]); } } \
          \
        { v4u q_; q_.x = at8[0] | ((unsigned)at8[1] << 16); q_.y = at8[2] | ((unsigned)at8[3] << 16); q_.z = at8[4] | ((unsigned)at8[5] << 16); q_.w = at8[6] | ((unsigned)at8[7] << 16); \
          *(LAS v4u*)(size_t)(aCol + (unsigned)((tb) * 2)) = q_; \
          q_.x = rt8[0] | ((unsigned)rt8[1] << 16); q_.y = rt8[2] | ((unsigned)rt8[3] << 16); q_.z = rt8[4] | ((unsigned)rt8[5] << 16); q_.w = rt8[6] | ((unsigned)rt8[7] << 16); \
          *(LAS v4u*)(size_t)(aCol + (unsigned)((O_RTT - O_ATT) + (tb) * 2)) = q_; \
          q_.x = vv8[0] | ((unsigned)vv8[1] << 16); q_.y = vv8[2] | ((unsigned)vv8[3] << 16); q_.z = vv8[4] | ((unsigned)vv8[5] << 16); q_.w = vv8[6] | ((unsigned)vv8[7] << 16); \
          *(LAS v4u*)(size_t)(aCol + (unsigned)((O_VC - O_ATT) + (tb) * 2)) = q_; } } while (0)
        CKA_PROC(B0, 0); asm volatile("" ::: "memory"); CKA_LOAD(B0, zp, lp, 16); asm volatile("" ::: "memory");
        CKA_PROC(B1, 8); asm volatile("" ::: "memory"); CKA_LOAD(B1, zp, lp, 24); asm volatile("" ::: "memory");
        CKA_PROC(B0, 16); asm volatile("" ::: "memory"); CKA_PROC(B1, 24); asm volatile("" ::: "memory");
#undef CKA_PROC
#undef CK_W16
        if (lane < CH) BONUS[(size_t)(t0 + lane) * RH + h] = mybon;
        const float gcr = bf2f((bf16)(cvt2(gam, 0.f) & 0xffffu));
        ((LAS float*)(lds + O_GC))[lane] = gcr;
#pragma unroll
        for (int t = 0; t < CH; t += 8) { v4u qb, qk;
            qb.x = cvt2(bf2f(Bt[t * PCK + lane]) * gam, bf2f(Bt[(t + 1) * PCK + lane]) * gam); qb.y = cvt2(bf2f(Bt[(t + 2) * PCK + lane]) * gam, bf2f(Bt[(t + 3) * PCK + lane]) * gam);
            qb.z = cvt2(bf2f(Bt[(t + 4) * PCK + lane]) * gam, bf2f(Bt[(t + 5) * PCK + lane]) * gam); qb.w = cvt2(bf2f(Bt[(t + 6) * PCK + lane]) * gam, bf2f(Bt[(t + 7) * PCK + lane]) * gam);
            qk.x = cvt2(bf2f(Kt[t * PCK + lane]) * gam, bf2f(Kt[(t + 1) * PCK + lane]) * gam); qk.y = cvt2(bf2f(Kt[(t + 2) * PCK + lane]) * gam, bf2f(Kt[(t + 3) * PCK + lane]) * gam);
            qk.z = cvt2(bf2f(Kt[(t + 4) * PCK + lane]) * gam, bf2f(Kt[(t + 5) * PCK + lane]) * gam); qk.w = cvt2(bf2f(Kt[(t + 6) * PCK + lane]) * gam, bf2f(Kt[(t + 7) * PCK + lane]) * gam);
            *(LAS v4u*)(BbT + lane * PKC + t) = qb; *(LAS v4u*)(KbT + lane * PKC + t) = qk; }
    }
    f32x16 accM, accMT, accG2, accT, accMakT, accMbr;
    zero16(accM); zero16(accMT); zero16(accMakT); zero16(accMbr); zero16(accG2);
    mm<64>(accM, lds + O_BT, PCK, 0, lds + O_AT, PCK, 0, r32, hi);
    mm<64>(accMT, lds + O_AT, PCK, 0, lds + O_BT, PCK, 0, r32, hi);
    mm<64>(accMakT, lds + O_AT, PCK, 0, lds + O_KT, PCK, 0, r32, hi);
    mm<64>(accMbr, lds + O_BT, PCK, 0, lds + O_RT, PCK, 0, r32, hi);
    mm<64>(accG2, lds + O_KT, PCK, 0, lds + O_RT, PCK, 0, r32, hi);
#pragma unroll
    for (int r = 0; r < 16; ++r) { const int row = crow(r, hi);
        accM[r] = (row < r32) ? accM[r] : 0.f; accMT[r] = (r32 < row) ? accMT[r] : 0.f; accMakT[r] = (r32 < row) ? accMakT[r] : 0.f;
        accMbr[r] = (row <= r32) ? accMbr[r] : 0.f; accG2[r] = (row <= r32) ? accG2[r] : 0.f; }
    asm volatile("" : "+v"(accM), "+v"(accMT), "+v"(accMakT), "+v"(accMbr), "+v"(accG2));
    storeT(accMT, lds + O_P0, PCC, 0, 0, r32, hi);
    storeT(accM, lds + O_PT0, PCC, 0, 0, r32, hi);
    storeT(accMakT, lds + O_MAK, PCC, 0, 0, r32, hi);
    storeT(accMbr, lds + O_MBRT, PCC, 0, 0, r32, hi);
    accT = accM;
#pragma unroll
    for (int r = 0; r < 16; ++r) if (crow(r, hi) == r32) accT[r] += 1.0f;
    storeT(accT, lds + O_TT0, PCC, 0, 0, r32, hi);
    if (nxt >= 0) preload(nxt, Z, L, B0, B1, qr, qk, qv, lane);
    {   f32x16 aP, aPT;
        zero16(aP); zero16(aPT);
        mm<32>(aP, lds + O_P0, PCC, 0, lds + O_PT0, PCC, 0, r32, hi); mm<32>(aPT, lds + O_PT0, PCC, 0, lds + O_P0, PCC, 0, r32, hi);
        storeT(aPT, lds + O_P1, PCC, 0, 0, r32, hi); storeT(aP, lds + O_PT1, PCC, 0, 0, r32, hi);
        mm<32>(accT, lds + O_P1, PCC, 0, lds + O_TT0, PCC, 0, r32, hi); storeT(accT, lds + O_TT1, PCC, 0, 0, r32, hi);
        zero16(aP); zero16(aPT);
        mm<32>(aP, lds + O_P1, PCC, 0, lds + O_PT1, PCC, 0, r32, hi); mm<32>(aPT, lds + O_PT1, PCC, 0, lds + O_P1, PCC, 0, r32, hi);
        storeT(aPT, lds + O_P0, PCC, 0, 0, r32, hi); storeT(aP, lds + O_PT0, PCC, 0, 0, r32, hi);
        mm<32>(accT, lds + O_P0, PCC, 0, lds + O_TT1, PCC, 0, r32, hi); storeT(accT, lds + O_TT0, PCC, 0, 0, r32, hi);
        zero16(aP); zero16(aPT);
        mm<32>(aP, lds + O_P0, PCC, 0, lds + O_PT0, PCC, 0, r32, hi); mm<32>(aPT, lds + O_PT0, PCC, 0, lds + O_P0, PCC, 0, r32, hi);
        storeT(aPT, lds + O_P1, PCC, 0, 0, r32, hi); storeT(aP, lds + O_PT1, PCC, 0, 0, r32, hi);
        mm<32>(accT, lds + O_P1, PCC, 0, lds + O_TT0, PCC, 0, r32, hi); storeT(accT, lds + O_TT1, PCC, 0, 0, r32, hi);
        zero16(aPT);
        mm<32>(aPT, lds + O_PT1, PCC, 0, lds + O_P1, PCC, 0, r32, hi);
        storeT(aPT, lds + O_P0, PCC, 0, 0, r32, hi);
        mm<32>(accT, lds + O_P0, PCC, 0, lds + O_TT1, PCC, 0, r32, hi); storeT(accT, lds + O_TT0, PCC, 0, 0, r32, hi);
    }
    {   f32x16 acc; zero16(acc);
        mm<32>(acc, lds + O_TT0, PCC, 0, lds + O_MAK, PCC, 0, r32, hi);
        storeT(acc, lds + O_G1, PCC, 0, 0, r32, hi);
#pragma unroll
        for (int kb = 0; kb < 2; ++kb) { zero16(acc);
            mm<32>(acc, lds + O_TT0, PCC, 0, lds + O_ATT, PKC, 32 * kb, r32, hi);
            storeT(acc, lds + O_AT2, PKC, 32 * kb, 0, r32, hi); }
        mm<32>(accG2, lds + O_G1, PCC, 0, lds + O_MBRT, PCC, 0, r32, hi);
        storeTg(accG2, G2T + (size_t)unit * 1024, 32, 0, 0, r32, hi);
        const bf16x8 id0 = idfrag(0, r32, hi), id1 = idfrag(1, r32, hi);
#pragma unroll
        for (int kb = 0; kb < 2; ++kb) { zero16(acc);
            mm<32>(acc, lds + O_AT2, PKC, 32 * kb, lds + O_MBRT, PCC, 0, r32, hi);
            acc = __builtin_amdgcn_mfma_f32_32x32x16_bf16(*(const LAS bf16x8*)(lds + O_RTT + ((32 * kb + r32) * PKC + 8 * hi) * 2), id0, acc, 0, 0, 0);
            acc = __builtin_amdgcn_mfma_f32_32x32x16_bf16(*(const LAS bf16x8*)(lds + O_RTT + ((32 * kb + r32) * PKC + 16 + 8 * hi) * 2), id1, acc, 0, 0, 0);
            storeTg(acc, RRT + (size_t)unit * 2048, 64, 0, 32 * kb, r32, hi); }
        const float gcv0 = ((const LAS float*)(lds + O_GC))[r32], gcv1 = ((const LAS float*)(lds + O_GC))[32 + r32];
#pragma unroll
        for (int rb = 0; rb < 2; ++rb)
#pragma unroll
            for (int cb = 0; cb < 2; ++cb) { zero16(acc);
                mm<32>(acc, lds + O_AT2, PKC, 32 * rb, lds + O_BBT, PKC, 32 * cb, r32, hi);
                if (rb == cb) { const float gv = cb ? gcv1 : gcv0;
#pragma unroll
                    for (int r = 0; r < 16; ++r) if (crow(r, hi) == r32) acc[r] += gv; }
                storeTg(acc, TRT + (size_t)unit * 4096, 64, 32 * cb, 32 * rb, r32, hi); }
#pragma unroll
        for (int cb = 0; cb < 2; ++cb) { zero16(acc);
            mm<32>(acc, lds + O_G1, PCC, 0, lds + O_BBT, PKC, 32 * cb, r32, hi);
            acc = __builtin_amdgcn_mfma_f32_32x32x16_bf16(id0, *(const LAS bf16x8*)(lds + O_KBT + ((32 * cb + r32) * PKC + 8 * hi) * 2), acc, 0, 0, 0);
            acc = __builtin_amdgcn_mfma_f32_32x32x16_bf16(id1, *(const LAS bf16x8*)(lds + O_KBT + ((32 * cb + r32) * PKC + 16 + 8 * hi) * 2), acc, 0, 0, 0);
            storeT(acc, lds + O_VKT, PKC, 32 * cb, 0, r32, hi); }
#pragma unroll
        for (int vb = 0; vb < 2; ++vb)
#pragma unroll
            for (int kb = 0; kb < 2; ++kb) { zero16(acc);
                mm<32>(acc, lds + O_VKT, PKC, 32 * kb, lds + O_VC, PKC, 32 * vb, r32, hi);
                v4u q0, q1; q0.x = cvt2(acc[0], acc[1]); q0.y = cvt2(acc[2], acc[3]); q0.z = cvt2(acc[4], acc[5]); q0.w = cvt2(acc[6], acc[7]);
                q1.x = cvt2(acc[8], acc[9]); q1.y = cvt2(acc[10], acc[11]); q1.z = cvt2(acc[12], acc[13]); q1.w = cvt2(acc[14], acc[15]);
                GAS v4u* sl = (GAS v4u*)(SLOT + (size_t)unit * 2048 + ((vb * 2 + kb) * 64 + lane) * 8);
                sl[0] = q0; sl[1] = q1; }
        {   const LAS v4u* vs = (const LAS v4u*)(lds + O_VC + lane * PKC * 2);
            GAS v4u* vd = (GAS v4u*)(VCG + (size_t)unit * 2048 + lane * 32);
            vd[0] = vs[0]; vd[1] = vs[1]; vd[2] = vs[2]; vd[3] = vs[3]; }
    }
}

constexpr int CHN_SLOT = 17408, CHN_S = 2 * CHN_SLOT, CHN_PT = 72;
#define CHN_BAR() do { asm volatile("s_waitcnt lgkmcnt(0)" ::: "memory"); __builtin_amdgcn_s_barrier(); asm volatile("" ::: "memory"); } while (0)
__device__ __forceinline__ void rwkv_chain(int chain, const bf16* TRT, unsigned* SLOT, LAS unsigned char* lds, int tid) {
    const int lane = tid & 63, wv = __builtin_amdgcn_readfirstlane(tid >> 6), r32 = lane & 31, hi = lane >> 5;
    constexpr int NIT = NCH - 1;
    if (wv >= 2 && wv < 6) {
        const int lt = tid - 128;
        const unsigned char* gT = (const unsigned char*)(TRT + (size_t)chain * NCH * 4096);
        const unsigned char* gS = (const unsigned char*)(SLOT + (size_t)chain * NCH * 2048);
        const bool isT = lt < 128;
        const unsigned char* gsrc = isT ? gT + lt * 64 : gS + (lt - 128) * 64;
        const int ldst = isT ? ((lt >> 1) * (CHN_PT * 2) + (lt & 1) * 64) : (64 * CHN_PT * 2 + (lt - 128) * 64);
        struct Set { v4u q[4]; };
        Set R0, R1, R2, R3, R4, R5, R6, R7;
#define CH_RAW(R, c_) do { const int cc_ = ((c_) < NIT) ? (c_) : NIT - 1; const unsigned char* p_ = gsrc + (size_t)cc_ * 8192; \
        _Pragma("unroll") for (int i_ = 0; i_ < 4; ++i_) R.q[i_] = *(const GAS v4u*)(p_ + 16 * i_); } while (0)
#define CH_PUT(R, buf) do { LAS unsigned char* d_ = lds + (buf) * CHN_SLOT + ldst; \
        _Pragma("unroll") for (int i_ = 0; i_ < 4; ++i_) *(LAS v4u*)(d_ + 16 * i_) = R.q[i_]; } while (0)
#define CH_ITER(R, c_) do { CH_PUT(R, ((c_) + 1) & 1); CH_RAW(R, (c_) + 9); CHN_BAR(); } while (0)
        CH_RAW(R0, 0); CH_RAW(R1, 1); CH_RAW(R2, 2); CH_RAW(R3, 3); CH_RAW(R4, 4); CH_RAW(R5, 5); CH_RAW(R6, 6); CH_RAW(R7, 7);
        CH_PUT(R0, 0); CH_RAW(R0, 8);
        CHN_BAR();
        for (int c = 0; c + 7 < NIT; c += 8) { CH_ITER(R1, c); CH_ITER(R2, c + 1); CH_ITER(R3, c + 2); CH_ITER(R4, c + 3); CH_ITER(R5, c + 4); CH_ITER(R6, c + 5); CH_ITER(R7, c + 6); CH_ITER(R0, c + 7); }
        CH_ITER(R1, 120); CH_ITER(R2, 121); CH_ITER(R3, 122); CH_ITER(R4, 123); CH_ITER(R5, 124); CH_ITER(R6, 125); CH_ITER(R7, 126);
#undef CH_RAW
#undef CH_PUT
#undef CH_ITER
    } else if (wv < 2) {
        const int vb = wv;
        LAS unsigned char* sl = lds + CHN_S + vb * (32 * CHN_PT * 2);
        for (int i = lane; i < 32 * CHN_PT / 2; i += 64) ((LAS unsigned*)sl)[i] = 0u;
        CHN_BAR();
        for (int c = 0; c < NIT; ++c) {
            const LAS unsigned char* bs = lds + (c & 1) * CHN_SLOT;
            bf16x8 sfr[4];
#pragma unroll
            for (int ks = 0; ks < 4; ++ks) sfr[ks] = *(const LAS bf16x8*)(sl + (r32 * CHN_PT + 16 * ks + 8 * hi) * 2);
            bf16* sg = (bf16*)(SLOT + ((size_t)chain * NCH + c) * 2048 + vb * 1024);
            f32x16 acc[2]; bf16x8 tr[2][4];
#pragma unroll
            for (int kb = 0; kb < 2; ++kb) {
                const LAS v4u* wp = (const LAS v4u*)(bs + 64 * CHN_PT * 2 + ((vb * 2 + kb) * 64 + lane) * 32);
                const v4u w0 = wp[0], w1 = wp[1];
                acc[kb][0] = bflo(w0.x); acc[kb][1] = bfhi(w0.x); acc[kb][2] = bflo(w0.y); acc[kb][3] = bfhi(w0.y); acc[kb][4] = bflo(w0.z); acc[kb][5] = bfhi(w0.z); acc[kb][6] = bflo(w0.w); acc[kb][7] = bfhi(w0.w);
                acc[kb][8] = bflo(w1.x); acc[kb][9] = bfhi(w1.x); acc[kb][10] = bflo(w1.y); acc[kb][11] = bfhi(w1.y); acc[kb][12] = bflo(w1.z); acc[kb][13] = bfhi(w1.z); acc[kb][14] = bflo(w1.w); acc[kb][15] = bfhi(w1.w);
#pragma unroll
                for (int ks = 0; ks < 4; ++ks) tr[kb][ks] = *(const LAS bf16x8*)(bs + ((32 * kb + r32) * CHN_PT + 16 * ks + 8 * hi) * 2);
            }
#pragma unroll
            for (int ks = 0; ks < 4; ++ks) {
                acc[0] = __builtin_amdgcn_mfma_f32_32x32x16_bf16(tr[0][ks], sfr[ks], acc[0], 0, 0, 0);
                acc[1] = __builtin_amdgcn_mfma_f32_32x32x16_bf16(tr[1][ks], sfr[ks], acc[1], 0, 0, 0); }
#pragma unroll
            for (int kb = 0; kb < 2; ++kb) { storeT(acc[kb], sl, CHN_PT, 0, 32 * kb, r32, hi); storeTg(acc[kb], sg, 64, 0, 32 * kb, r32, hi); }
            CHN_BAR();
        }
    } else {
        for (int c = 0; c < NIT + 1; ++c) CHN_BAR();
    }
}

#undef CHN_BAR
__device__ __forceinline__ void rwkv_out_item(int unit, const unsigned* SLOT, const bf16* RRT, const bf16* G2T, const bf16* VCG, const float* BONUS, const bf16* Z, const bf16* L,
                                              const float* mu, const float* lnw, const float* lnb, bf16* Omix, int lane) {
    const int chain = unit >> 7, c = unit & 127, b = chain >> 4, h = chain & 15, r32 = lane & 31, hi = lane >> 5;
    const int t = b * SEQ + c * CH + r32;
    f32x16 o[2]; zero16(o[0]); zero16(o[1]);
    if (c > 0) {
        bf16x8 rr[4];
#pragma unroll
        for (int ks = 0; ks < 4; ++ks) rr[ks] = *(const GAS bf16x8*)(RRT + (size_t)unit * 2048 + r32 * 64 + 16 * ks + 8 * hi);
#pragma unroll
        for (int vb = 0; vb < 2; ++vb) { const bf16* sg = (const bf16*)(SLOT + (size_t)(unit - 1) * 2048 + vb * 1024);
#pragma unroll
            for (int ks = 0; ks < 4; ++ks) o[vb] = __builtin_amdgcn_mfma_f32_32x32x16_bf16(*(const GAS bf16x8*)(sg + r32 * 64 + 16 * ks + 8 * hi), rr[ks], o[vb], 0, 0, 0); }
    }
    {   bf16x8 g2[2];
#pragma unroll
        for (int ks = 0; ks < 2; ++ks) g2[ks] = *(const GAS bf16x8*)(G2T + (size_t)unit * 1024 + r32 * 32 + 16 * ks + 8 * hi);
#pragma unroll
        for (int vb = 0; vb < 2; ++vb)
#pragma unroll
            for (int ks = 0; ks < 2; ++ks) o[vb] = __builtin_amdgcn_mfma_f32_32x32x16_bf16(*(const GAS bf16x8*)(VCG + (size_t)unit * 2048 + (32 * vb + r32) * 32 + 16 * ks + 8 * hi), g2[ks], o[vb], 0, 0, 0);
    }
    float s = 0.f;
#pragma unroll
    for (int r = 0; r < 16; ++r) s += o[0][r] + o[1][r];
    s += __shfl_xor(s, 32);
    const float mean = s * (1.f / 64.f); float q = 0.f;
#pragma unroll
    for (int r = 0; r < 16; ++r) { o[0][r] -= mean; o[1][r] -= mean; q += o[0][r] * o[0][r] + o[1][r] * o[1][r]; }
    q += __shfl_xor(q, 32);
    const float rstd = __builtin_amdgcn_rsqf(q * (1.f / 64.f) + GN_EPS);
    const float bon = BONUS[(size_t)t * RH + h];
    const bool first = (t % SEQ) == 0;
#pragma unroll
    for (int vb = 0; vb < 2; ++vb)
#pragma unroll
        for (int g = 0; g < 4; ++g) { const int c4 = h * 64 + 32 * vb + 8 * g + 4 * hi;
            const f32x4 lw4 = *(const GAS f32x4*)(lnw + c4), lb4 = *(const GAS f32x4*)(lnb + c4), mu4 = *(const GAS f32x4*)(mu + 2048 + c4);
            const v2u vcw = *(const GAS v2u*)(Z + (size_t)t * ZW + Z_V + c4);
            v2u vpw = {0u, 0u}; if (!first) vpw = *(const GAS v2u*)(Z + (size_t)t * ZW - ZW + Z_V + c4);
            const v2u gw = *(const GAS v2u*)(L + (size_t)t * LW + 2048 + c4);
            const float vc[4] = {bflo(vcw.x), bfhi(vcw.x), bflo(vcw.y), bfhi(vcw.y)}, vp[4] = {bflo(vpw.x), bfhi(vpw.x), bflo(vpw.y), bfhi(vpw.y)}, gg[4] = {bflo(gw.x), bfhi(gw.x), bflo(gw.y), bfhi(gw.y)};
            float y[4];
#pragma unroll
            for (int e = 0; e < 4; ++e) { const float v = vc[e] + (vp[e] - vc[e]) * mu4[e]; y[e] = (o[vb][4 * g + e] * rstd * lw4[e] + lb4[e] + bon * v) * gg[e]; }
            v2u ow; ow.x = pk2(y[0], y[1]); ow.y = pk2(y[2], y[3]);
            *(GAS v2u*)(Omix + (size_t)t * 2048 + 1024 + c4) = ow; }
}
}


#define WIN ((bf16*)(ws + WS_WIN))
#define WKPE ((bf16*)(ws + WS_WKPE))
#define KPEP ((float*)(ws + WS_KPEP))
#define WQB ((bf16*)(ws + WS_WQB))
#define WKVB ((bf16*)(ws + WS_WKVB))
#define WLORA ((bf16*)(ws + WS_WLORA))
#define WOUT ((bf16*)(ws + WS_WOUT))
#define WPG ((bf16*)(ws + WS_WPG))
#define WPP ((bf16*)(ws + WS_WPP))
#define WGU ((bf16*)(ws + WS_WGU))
#define WD ((bf16*)(ws + WS_WD))
#define WD2 ((bf16*)(ws + WS_WD2))
#define H ((bf16*)(ws + WS_H))
#define U ((bf16*)(ws + WS_U))
#define Zb ((bf16*)(ws + WS_Z))
#define AQ ((bf16*)(ws + WS_AQ))
#define AKV ((bf16*)(ws + WS_AKV))
#define AL ((bf16*)(ws + WS_AL))
#define QRAW ((bf16*)(ws + WS_QRAW))
#define KVRAW ((bf16*)(ws + WS_KVRAW))
#define LORA ((bf16*)(ws + WS_LORA))
#define QH ((bf16*)(ws + WS_QH))
#define KH ((bf16*)(ws + WS_KH))
#define VT ((bf16*)(ws + WS_VT))
#define OMIX ((bf16*)(ws + WS_OMIX))
#define TRT ((bf16*)(ws + WS_TRT))
#define OTMP ((bf16*)(ws + WS_OTMP))
#define AST ((f32x2*)(ws + WS_AST))
#define SLOT ((unsigned*)(ws + WS_SLOT))
#define RRT ((bf16*)out)
#define G2T ((bf16*)out + (size_t)8 * 1024 * 1024)
#define VCG ((bf16*)(ws + WS_VCG))
#define BONUS ((float*)(ws + WS_BONUS))
#define PB ((bf16*)(ws + WS_PB))
#define PPLE ((float*)(ws + WS_PPLE))
#define ROPE ((f32x2*)(ws + WS_ROPE))
#define SS0 ((float*)(ws + WS_CTL) + CW_SS)
#define SS1 (SS0 + T)
#define SS2 (SS0 + 2 * T)
#define SS3 (SS0 + 3 * T)
__global__ void __launch_bounds__(NTHR, 2) mk_fwd(Args args) {
    extern __shared__ __attribute__((aligned(16))) unsigned char lds_raw[];
    LAS unsigned char* lds = (LAS unsigned char*)lds_raw;
    volatile LAS unsigned* MISC = (volatile LAS unsigned*)(lds + MISC_OFF);
    const int tid = threadIdx.x, lane = tid & 63, wave = __builtin_amdgcn_readfirstlane(tid >> 6);
    const int G = gridDim.x, bx = blockIdx.x, vcu = (G % 8 == 0) ? (bx % 8) * (G / 8) + bx / 8 : bx;
    unsigned char* ws = args.ws;
    gu32* ctl = (gu32*)(ws + WS_CTL);
    for (int u = tid; u < (LDS_BYTES - LDSCTL_OFF) / 4; u += NTHR) ((LAS unsigned*)(lds + LDSCTL_OFF))[u] = 0u;
    __syncthreads();
    XcdBarrier bar; bar.bar = (unsigned*)(ctl + CW_BAR); bar.x = 0; bar.st = nullptr;
    if (N_LAUNCHES == 1) bar = xcd_barrier_post((unsigned*)(ctl + CW_BAR), MISC + 8);
#define GRID_BAR() do { if (N_LAUNCHES == 1) xcd_barrier(bar); } while (0)
    const int lo = args.ph_lo, hi = args.ph_hi;
#define IN(k) (lo <= (k) && (k) < hi)
#define BOTH(k) (IN(k) && IN((k) + 1))
    const int gw = vcu * NWAVES + wave, NGW = G * NWAVES;
    const float* x = args.in[0]; float* out = args.out;
    LAS float* scr = (LAS float*)(lds + RING_OFF + wave * 16384);

    if (IN(0)) {
        int base = 0;
        run_job(mk_job(args.in[3], args.in[4], args.in[2], WGU, DM, FF, 2 * FF, DM, 0, 1), gw, NGW, base, scr, lane);
        run_job(mk_job(args.in[7], nullptr, args.in[6], WIN, DM, ZW, ZW, DM, 0, 0, 4160, 0, 768, 64), gw, NGW, base, scr, lane);
        run_job(mk_job(args.in[7], nullptr, args.in[6], WKPE, DM, 64, 256, DM, 0, 0, 4160, 768), gw, NGW, base, scr, lane);
        run_job(mk_job(args.in[5], nullptr, nullptr, WD, FF, DM, DM, FF, 0, 0), gw, NGW, base, scr, lane);
        for (int e = gw * 64 + lane; e < SEQ * 32; e += NGW * 64) { const int s = e >> 5, i = e & 31;
            const float inv_freq = __builtin_amdgcn_exp2f(-(float)i * (13.287712379549449f / 32.0f));
            float rev = ((float)s * inv_freq) * 0.15915494309189535f; rev -= floorf(rev);
            f32x2 cs; cs.x = __builtin_amdgcn_cosf(rev); cs.y = __builtin_amdgcn_sinf(rev); ROPE[e] = cs; }
        xb_pass(x, H, SS0, gw, NGW, lane);
        if (BOTH(0)) GRID_BAR();
    }
    if (IN(1)) {
        pg8::Gemm g{H, WGU, T, 2 * FF, DM}; pg8::StaticOrder S; S.init(T, 2 * FF, G, bx);
        pg8::EpiSwiGLU E{U, FF, SS0};
        pg8::gemm_phase<pg8::EpiSwiGLU, pg8::StaticOrder, true, true>(lds + RING_OFF, g, S, E);
        if (bx >= (G >> 1)) { int base = 0;
            const int gw2 = (bx - (G >> 1)) * NWAVES + wave, ngw2 = (G - (G >> 1)) * NWAVES;
            run_job(mk_job(args.in[25], nullptr, nullptr, WOUT, DM, DM, DM, DM, 0, 0), gw2, ngw2, base, scr, lane);
            run_job(mk_job(args.in[31], nullptr, args.in[30], WPG, DM, DM, DM, DM, 0, 0), gw2, ngw2, base, scr, lane);
            run_job(mk_job(args.in[9], nullptr, args.in[8], WQB, QL, 1536, 1536, QL, 0, 0), gw2, ngw2, base, scr, lane);
            run_job(mk_job(args.in[11], nullptr, args.in[10], WKVB, KVL, 2048, 2048, KVL, 0, 0), gw2, ngw2, base, scr, lane);
            run_job(mk_job(args.in[16], nullptr, nullptr, WLORA, 64, 1024, 1024, 256, 0, 0), gw2, ngw2, base, scr, lane);
            run_job(mk_job(args.in[18], nullptr, nullptr, WLORA + (size_t)1024 * 256, 64, 1024, 1024, 256, 64, 0), gw2, ngw2, base, scr, lane);
            run_job(mk_job(args.in[19], nullptr, nullptr, WLORA + (size_t)2048 * 256, 128, 1024, 1024, 256, 128, 0), gw2, ngw2, base, scr, lane);
            run_job(mk_job(args.in[32], nullptr, nullptr, WPP, PLE, DM, DM, PLE, 0, 0), gw2, ngw2, base, scr, lane);
            { const float* p = args.in[1];
              for (int e = gw2 * 64 + lane; e < T * PLE / 4; e += ngw2 * 64) { const f32x4 v = *(const GAS f32x4*)(p + (size_t)e * 4); v2u o; o.x = pk2(v.x, v.y); o.y = pk2(v.z, v.w); *(GAS v2u*)(PB + (size_t)e * 4) = o; } }
 }
        if (BOTH(1)) GRID_BAR();
    }
    if (IN(2)) {
        pg8::Gemm g{U, WD, T, DM, FF}; pg8::StaticOrder S; S.init(T, DM, G, bx);
        pg8::EpiRes<false> E{x, DM, 0.5f, H, SS1};
        pg8::gemm_phase<pg8::EpiRes<false>, pg8::StaticOrder, false, true>(lds + RING_OFF, g, S, E);
        if (IN(2) && IN(4)) GRID_BAR();
    }
    if (IN(4)) {
        pg8::Gemm g{H, WIN, T, ZW, DM}; pg8::StaticOrder S; S.init(T, ZW, G, bx);
        pg8::EpiBf16 E{Zb, ZW, SS1};
        pg8::gemm_phase<pg8::EpiBf16, pg8::StaticOrder, true, true>(lds + RING_OFF, g, S, E);
        if (BOTH(4)) GRID_BAR();
    }
    if (IN(5)) {
        for (int t = gw; t < T; t += NGW) prep_a_row(t, Zb, args.in[14], AQ, AKV, AL, lane);
        if (BOTH(5)) GRID_BAR();
    }
    if (IN(6)) {
        {   pg8::Gemm g{AQ, WQB, T, 1536, QL}; pg8::StaticOrder S; S.init(T, 1536, G, bx); pg8::EpiBf16 E{QRAW, 1536, nullptr};
            pg8::gemm_phase<pg8::EpiBf16, pg8::StaticOrder, true, true>(lds + RING_OFF, g, S, E); }
        {   pg8::Gemm g{AKV, WKVB, T, 2048, KVL}; pg8::StaticOrder S; S.init(T, 2048, G, (bx + 192) % G); pg8::EpiBf16 E{KVRAW, 2048, nullptr};
            pg8::gemm_phase<pg8::EpiBf16, pg8::StaticOrder, true, true>(lds + RING_OFF, g, S, E); }
        {   pg8::Gemm g{AL, WLORA, T, LW, 256}; pg8::StaticOrder S; S.init(T, LW, G, (bx + 64) % G); pg8::EpiBf16 E{LORA, LW, nullptr};
            pg8::gemm_phase<pg8::EpiBf16, pg8::StaticOrder, true, true>(lds + RING_OFF, g, S, E); }
        __syncthreads();
        for (int task = (vcu + 64) % G; task < T / 32; task += G) kpe_task(task, H, WKPE, SS1, KPEP, lds, tid);
        if (BOTH(6)) GRID_BAR();
    }
    if (IN(7)) {
        if (wave < ck::UNITS_PER_WG) {
            ck::Bat B0, B1; unsigned short qr, qk, qv; const int NU = 32 * ck::NCH, st = ck::UNITS_PER_WG * G; int u = vcu * ck::UNITS_PER_WG + wave;
            if (u < NU) ck::preload(u, Zb, LORA, B0, B1, qr, qk, qv, lane);
            for (; u < NU; u += st)
                ck::chunk_pre(u, Zb, LORA, args.in[14], args.in[15], args.in[17], args.in[20], args.in[21], args.in[22], BONUS, TRT, SLOT, RRT, G2T, VCG, lds + wave * ck::UNIT_LDS, lane,
                              B0, B1, qr, qk, qv, (u + st < NU) ? u + st : -1);
        } else {
            const int nmw = NWAVES - ck::UNITS_PER_WG;
            for (int task = vcu * nmw + (wave - ck::UNITS_PER_WG); task < 16 * 64 * 8; task += G * nmw)
                mla_prep_task(task, QRAW, KVRAW, args.in[12], args.in[13], ROPE, QH, KH, VT, lane, KPEP);
        }
        if (BOTH(7)) GRID_BAR();
    }
    if (IN(8)) {
        for (int rep = 0; rep < REP(8); ++rep) {
        if (vcu < 32) { ck::rwkv_chain(vcu, TRT, SLOT, lds, tid); __syncthreads(); }
        for (;;) {
            if (tid == 0) MISC[16] = __hip_atomic_fetch_add(ctl + CW_QUEUE + 64 * rep, 1u, RLX_AGENT);
            __syncthreads();
            const unsigned idx = MISC[16];
            __syncthreads();
            if (idx >= 512u) break;
            { const int part = (int)((idx >> 4) & 1u);
              att::attn_unit((int)(idx & 15u), 15 - (int)(idx >> 5), part, QH, KH, VT, part ? OTMP : OMIX, part ? 1024 : 2048, AST + (size_t)part * T * MLA_H, lds); }
        }
        }
        if (BOTH(8)) GRID_BAR();
    }
    if (IN(9)) {
        { int base = 0;
          run_job(mk_job(args.in[27], args.in[28], args.in[26], WGU, DM, FF, 8192, DM, 0, 1, 0, 0, 1 << 30, 0, 0), gw, NGW, base, scr, lane); }
        for (int it = gw; it < T * 2; it += NGW) att::attn_merge_item(it, OMIX, OTMP, AST, lane);
        for (int u = gw; u < 32 * ck::NCH; u += NGW) ck::rwkv_out_item(u, SLOT, RRT, G2T, VCG, BONUS, Zb, LORA, args.in[14], args.in[23], args.in[24], OMIX, lane);
        if (BOTH(9)) GRID_BAR();
    }
    if (IN(10)) {
        { int base = 0;
          run_job(mk_job(args.in[27], args.in[28], args.in[26], WGU, DM, FF, 2 * FF - 8192, DM, 0, 1, 0, 0, 1 << 30, 0, 8192), gw, NGW, base, scr, lane);
          run_job(mk_job(args.in[29], nullptr, nullptr, WD2, FF, DM, 1024, FF, 0, 0, 0, 0, 1 << 30, 0, 0), gw, NGW, base, scr, lane); }
        __syncthreads();
        pg8::Gemm g{OMIX, WOUT, T, DM, DM}; pg8::StaticOrder S; S.init(T, DM, G, bx);
        pg8::EpiRes<true> E{nullptr, DM, 1.0f, H, SS2};
        pg8::gemm_phase<pg8::EpiRes<true>, pg8::StaticOrder, false, true>(lds + RING_OFF, g, S, E);
        if (IN(10) && IN(12)) GRID_BAR();
    }
    if (IN(12)) {
        pg8::Gemm g{H, WGU, T, 2 * FF, DM}; pg8::StaticOrder S; S.init(T, 2 * FF, G, bx);
        pg8::EpiSwiGLU E{U, FF, SS2};
        pg8::gemm_phase<pg8::EpiSwiGLU, pg8::StaticOrder, true, true>(lds + RING_OFF, g, S, E);
        if (bx >= (G >> 1)) { int base = 0; const int hg = G >> 1;
            run_job(mk_job(args.in[29], nullptr, nullptr, WD2, FF, DM, 1024, FF, 0, 0, 0, 0, 1 << 30, 0, 1024), (bx - hg) * NWAVES + wave, (G - hg) * NWAVES, base, scr, lane);
            __syncthreads();
            pg8::Gemm g2{PB, WPP, T, DM, PLE}; pg8::StaticOrder S2; S2.init(T, DM, G - hg, bx - hg); pg8::EpiBf16NP E2{(pg8::bf16_t*)PPLE, DM};
            pg8::gemm_phase<pg8::EpiBf16NP, pg8::StaticOrder, true, true>(lds + RING_OFF, g2, S2, E2); }
        if (BOTH(12)) GRID_BAR();
    }
    if (IN(13)) {
        pg8::Gemm g{U, WD2, T, DM, FF}; pg8::StaticOrder S; S.init(T, DM, G, bx);
        pg8::EpiRes<true> E{nullptr, DM, 0.5f, H, SS3};
        pg8::gemm_phase<pg8::EpiRes<true>, pg8::StaticOrder, false, true>(lds + RING_OFF, g, S, E);
        if (IN(13) && IN(15)) GRID_BAR();
    }
    if (IN(15)) {
        {   pg8::Gemm g{H, WPG, T, DM, DM}; pg8::StaticOrder S; S.init(T, DM, G, bx); pg8::EpiPle E{H, (const pg8::bf16_t*)PPLE, out, DM, SS3};
            pg8::gemm_phase<pg8::EpiPle, pg8::StaticOrder, false, true>(lds + RING_OFF, g, S, E); }
    }
#undef IN
#undef BOTH
#undef GRID_BAR
}

extern "C" void kernel_launch(void* const* d_in, const int* in_sizes, int n_in, void* d_out, int out_size, void* d_ws, size_t ws_size, hipStream_t stream) {
    static int grid = 0;
    if (grid == 0) {
        if (n_in != 33 || out_size != T * DM || ws_size < WS_END) { fprintf(stderr, "kernel_launch: unexpected shapes (n_in %d, out %d, ws %zu, need %zu)\n", n_in, out_size, ws_size, (size_t)WS_END); grid = -1; return; }
        int dev = 0, cus = 0, per_cu = 0;
        if (hipGetDevice(&dev) != hipSuccess || hipDeviceGetAttribute(&cus, hipDeviceAttributeMultiprocessorCount, dev) != hipSuccess) { grid = -1; return; }
        if (hipFuncSetAttribute((const void*)mk_fwd, hipFuncAttributeMaxDynamicSharedMemorySize, LDS_BYTES) != hipSuccess) { fprintf(stderr, "kernel_launch: hipFuncSetAttribute failed\n"); grid = -1; return; }
        if (hipOccupancyMaxActiveBlocksPerMultiprocessor(&per_cu, (const void*)mk_fwd, NTHR, LDS_BYTES) != hipSuccess || per_cu < 1) { fprintf(stderr, "kernel_launch: occupancy query says %d blocks per CU\n", per_cu); (void)hipGetLastError(); grid = -1; return; }
        grid = cus;
        fprintf(stderr, "kernel_launch: grid %d, per_cu %d, ws %zu\n", grid, per_cu, ws_size);
    }
    if (grid < 0) return;
    (void)hipMemsetAsync((char*)d_ws + WS_CTL, 0, CTL_ZERO_BYTES, stream);
    Args a{};
    for (int i = 0; i < 33; ++i) a.in[i] = (const float*)d_in[i];
    a.out = (float*)d_out; a.ws = (unsigned char*)d_ws;
    for (int li = 0; li < N_LAUNCHES; ++li) {
        a.ph_lo = (N_LAUNCHES == 1) ? 0 : li; a.ph_hi = (N_LAUNCHES == 1) ? NPH : li + 1;
        hipLaunchKernelGGL(mk_fwd, dim3(grid), dim3(NTHR), LDS_BYTES, stream, a);
    }
}
```

```cpp
#include <hip/hip_runtime.h>
#include <cstdio>
#include <cstdint>
namespace pg8 {
#define PG8_LAS __attribute__((address_space(3)))
typedef unsigned short bf16_t;
typedef short bf16x8 __attribute__((ext_vector_type(8)));
typedef float f32x4 __attribute__((ext_vector_type(4)));
typedef unsigned u32x4 __attribute__((ext_vector_type(4)));
typedef unsigned u32x2 __attribute__((ext_vector_type(2)));
constexpr int BM = 256, BK = 64, HALF = 128, HTB = HALF * BK * 2  , STAGE_BYTES = 8 * HTB, NXCD = 8, WGM = 8;

__host__ __device__ __forceinline__ int lds_byte(int r, int c) { const int st = (r >> 4) * 2 + (c >> 5), rr = r & 15, cc = c & 31, ob = rr * 64 + cc * 2; return st * 1024 + (ob ^ (((ob >> 9) & 1) << 5)); }
__host__ __device__ __forceinline__ void stage_rc(int b, int& R, int& C) { const int st = b / 1024, sb = b % 1024, swz = sb ^ (((sb >> 9) & 1) << 5); R = (st >> 1) * 16 + swz / 64; C = (st & 1) * 32 + (swz % 64) / 2; }
__host__ __device__ __forceinline__ int perm32(int rho) { const int n = rho >> 4, i = rho & 15; return 8 * (i >> 2) + 4 * n + (i & 3); }

struct Unit { int pm, pn; };
struct Gemm { const bf16_t* A; const bf16_t* Bt; int M, N, K; int ld; size_t kofs; };

struct StaticOrder {
    int nM, nN, nwg, G, c;
    __host__ __device__ void init(int M, int N, int G_, int c_) { nM = M / BM; nN = N / BM; nwg = nM * nN; G = G_; c = c_; }
    __host__ __device__ bool next(int i, Unit& u) const {
        const long L = (long)i * G + c; if (L >= nwg) return false;
        int wgid = (int)L; { const int q = nwg / NXCD, r = nwg % NXCD, xcd = wgid % NXCD, off = wgid / NXCD; wgid = (xcd < r ? xcd * (q + 1) : r * (q + 1) + (xcd - r) * q) + off; }
        const int nig = WGM * nN, gid = wgid / nig, fm = gid * WGM, gsz = (nM - fm) < WGM ? (nM - fm) : WGM;
        u.pm = fm + ((wgid % nig) % gsz); u.pn = (wgid % nig) / gsz; return true;
    }
    __device__ __forceinline__ void a_ready(const Unit&) const {}
    __device__ __forceinline__ void done(const Unit&) const {}
};


__device__ __forceinline__ unsigned cvt_pk_bf16(float lo, float hi) { unsigned r; asm volatile("v_cvt_pk_bf16_f32 %0, %1, %2" : "=v"(r) : "v"(lo), "v"(hi)); return r; }
__device__ __forceinline__ float fast_sigmoid(float x) { return __builtin_amdgcn_rcpf(1.0f + __builtin_amdgcn_exp2f(-1.4426950408889634f * x)); }

__device__ __forceinline__ float row_rstd(const float* ss, int row) { return ss ? __builtin_amdgcn_rsqf(ss[row] * (1.0f / 2048.0f) + 1e-6f) : 1.0f; }
__device__ __forceinline__ void pf_rows_lds(PG8_LAS unsigned char* slot, const float* ss, int rowbase, int lane) {
    if (ss) { const float* src = ss + rowbase + lane;
        __builtin_amdgcn_global_load_lds((const unsigned*)src, (PG8_LAS unsigned*)slot, 4, 0, 0);
        __builtin_amdgcn_global_load_lds((const unsigned*)(src + HALF), (PG8_LAS unsigned*)(slot + 256), 4, 0, 0); }
}
__device__ __forceinline__ void rstd8_lds(float (&rs8)[2][4], const PG8_LAS unsigned char* slot, const float* ss, int fr) {
    if (ss) {
#pragma unroll
        for (int ai = 0; ai < 2; ++ai)
#pragma unroll
            for (int m = 0; m < 4; ++m) rs8[ai][m] = *(const PG8_LAS float*)(slot + ai * 256 + (m * 16 + fr) * 4);
#pragma unroll
        for (int ai = 0; ai < 2; ++ai)
#pragma unroll
            for (int m = 0; m < 4; ++m) rs8[ai][m] = __builtin_amdgcn_rsqf(rs8[ai][m] * (1.0f / 2048.0f) + 1e-6f);
    } else {
#pragma unroll
        for (int ai = 0; ai < 2; ++ai)
#pragma unroll
            for (int m = 0; m < 4; ++m) rs8[ai][m] = 1.0f;
    }
}
__device__ __forceinline__ void load_rstd8(float (&rs8)[2][4], const float* ss, int row0) {
    if (ss) {
#pragma unroll
        for (int ai = 0; ai < 2; ++ai)
#pragma unroll
            for (int m = 0; m < 4; ++m) rs8[ai][m] = ss[row0 + ai * HALF + m * 16];
#pragma unroll
        for (int ai = 0; ai < 2; ++ai)
#pragma unroll
            for (int m = 0; m < 4; ++m) rs8[ai][m] = __builtin_amdgcn_rsqf(rs8[ai][m] * (1.0f / 2048.0f) + 1e-6f);
    } else {
#pragma unroll
        for (int ai = 0; ai < 2; ++ai)
#pragma unroll
            for (int m = 0; m < 4; ++m) rs8[ai][m] = 1.0f;
    }
}
struct EpiBf16 {
    static constexpr bool PERM = true, AFTER_DRAIN = false, PF = true;
    bf16_t* O; int ldc; const float* ss;
    __device__ __forceinline__ void prefetch(PG8_LAS unsigned char* slot, const Unit& u, int wr, int lane) const { pf_rows_lds(slot, ss, u.pm * BM + wr * 64, lane); }
    __device__ __forceinline__ void operator()(const f32x4 (&acc)[2][2][4][2], const Unit& u, int wr, int wc, int fr, int fq, const PG8_LAS unsigned char* slot) const {
        const int row0 = u.pm * BM + wr * 64 + fr, col0 = u.pn * BM + wc * 32 + 8 * fq;
        float rs8[2][4];
        rstd8_lds(rs8, slot, ss, fr);
#pragma unroll
        for (int ai = 0; ai < 2; ++ai)
#pragma unroll
            for (int m = 0; m < 4; ++m) { const int row = row0 + ai * HALF + m * 16; const float rs = rs8[ai][m]; bf16_t* rowp = O + (size_t)row * ldc + col0;
#pragma unroll
                for (int bj = 0; bj < 2; ++bj) { const f32x4 v0 = acc[ai][bj][m][0] * rs, v1 = acc[ai][bj][m][1] * rs;
                    u32x4 w; w.x = cvt_pk_bf16(v0[0], v0[1]); w.y = cvt_pk_bf16(v0[2], v0[3]); w.z = cvt_pk_bf16(v1[0], v1[1]); w.w = cvt_pk_bf16(v1[2], v1[3]);
                    *(u32x4*)(rowp + bj * HALF) = w; } }
    }
};
struct EpiSwiGLU {
    static constexpr bool PERM = true, AFTER_DRAIN = false, PF = true;
    bf16_t* O; int ldc; const float* ss;
    __device__ __forceinline__ void prefetch(PG8_LAS unsigned char* slot, const Unit& u, int wr, int lane) const { pf_rows_lds(slot, ss, u.pm * BM + wr * 64, lane); }
    __device__ __forceinline__ void operator()(const f32x4 (&acc)[2][2][4][2], const Unit& u, int wr, int wc, int fr, int fq, const PG8_LAS unsigned char* slot) const {
        const int row0 = u.pm * BM + wr * 64 + fr, hid0 = u.pn * 128 + wc * 16 + 4 * fq;
        float rs8[2][4];
        rstd8_lds(rs8, slot, ss, fr);
#pragma unroll
        for (int ai = 0; ai < 2; ++ai)
#pragma unroll
            for (int m = 0; m < 4; ++m) { const int row = row0 + ai * HALF + m * 16; const float rs = rs8[ai][m]; bf16_t* rowp = O + (size_t)row * ldc + hid0;
#pragma unroll
                for (int bj = 0; bj < 2; ++bj) { const f32x4 g = acc[ai][bj][m][0] * rs, up = acc[ai][bj][m][1] * rs; float o[4];
#pragma unroll
                    for (int e = 0; e < 4; ++e) o[e] = g[e] * up[e] * fast_sigmoid(g[e]);
                    u32x2 w; w.x = cvt_pk_bf16(o[0], o[1]); w.y = cvt_pk_bf16(o[2], o[3]);
                    *(u32x2*)(rowp + bj * 64) = w; } }
    }
};
__device__ __forceinline__ f32x4 bf4_to_f32(const u32x2 w) { f32x4 r; r[0] = __builtin_bit_cast(float, w.x << 16); r[1] = __builtin_bit_cast(float, w.x & 0xffff0000u); r[2] = __builtin_bit_cast(float, w.y << 16); r[3] = __builtin_bit_cast(float, w.y & 0xffff0000u); return r; }
template <bool RB>
struct EpiRes {
    static constexpr bool PERM = false, AFTER_DRAIN = false, PF = false;
    const float* resid; int ldc; float scale; bf16_t* xb; float* ss_out;
    __device__ __forceinline__ void operator()(const f32x4 (&acc)[2][2][4][2], const Unit& u, int wr, int wc, int fr, int fq) const {
        const int row0 = u.pm * BM + wr * 64 + fr, col0 = u.pn * BM + wc * 32 + 4 * fq;
        const float* const resid_ = resid; bf16_t* const xb_ = xb; float* const ss_ = ss_out; const float scale_ = scale; const int ldc_ = ldc;
        f32x4 rs[2][2][2]; u32x2 rb[2][2][2];
#pragma unroll
        for (int bj = 0; bj < 2; ++bj)
#pragma unroll
            for (int n = 0; n < 2; ++n) { const size_t o0 = (size_t)row0 * ldc_ + col0 + bj * HALF + n * 16;
                if constexpr (RB) rb[0][bj][n] = *(const u32x2*)(xb_ + o0); else rs[0][bj][n] = *(const f32x4*)(resid_ + o0); }
#pragma unroll
        for (int gi = 0; gi < 8; ++gi) { const int ai = gi >> 2, m = gi & 3; const int row = row0 + ai * HALF + m * 16; const size_t off = (size_t)row * ldc_ + col0;
            if (gi < 7) { const size_t offn = (size_t)(row0 + ((gi + 1) >> 2) * HALF + ((gi + 1) & 3) * 16) * ldc_ + col0;
#pragma unroll
                for (int bj = 0; bj < 2; ++bj)
#pragma unroll
                    for (int n = 0; n < 2; ++n) { if constexpr (RB) rb[(gi + 1) & 1][bj][n] = *(const u32x2*)(xb_ + offn + bj * HALF + n * 16); else rs[(gi + 1) & 1][bj][n] = *(const f32x4*)(resid_ + offn + bj * HALF + n * 16); } }
            float q = 0.f;
#pragma unroll
            for (int bj = 0; bj < 2; ++bj)
#pragma unroll
                for (int n = 0; n < 2; ++n) { f32x4 r; if constexpr (RB) r = bf4_to_f32(rb[gi & 1][bj][n]); else r = rs[gi & 1][bj][n];
                    const f32x4 o = r + acc[ai][bj][m][n] * scale_;
                    u32x2 w; w.x = cvt_pk_bf16(o[0], o[1]); w.y = cvt_pk_bf16(o[2], o[3]);
                    *(u32x2*)(xb_ + off + bj * HALF + n * 16) = w;
                    q += (o[0] * o[0] + o[1] * o[1]) + (o[2] * o[2] + o[3] * o[3]); }
            q += __shfl_xor(q, 16); q += __shfl_xor(q, 32);
            if (fq == 0) __hip_atomic_fetch_add((__attribute__((address_space(1))) float*)(ss_ + row), q, __ATOMIC_RELAXED, __HIP_MEMORY_SCOPE_AGENT);
            asm volatile("" ::: "memory"); }
    }
};
struct EpiKpe {
    static constexpr bool PERM = true, AFTER_DRAIN = false, PF = false;
    float* P; int Mrows; const float* ss;
    __device__ __forceinline__ void operator()(const f32x4 (&acc)[2][2][4][2], const Unit& u, int wr, int wc, int fr, int fq) const {
        if (wc >= 2) return;
        const int row0 = u.pm * BM + wr * 64 + fr, col0 = wc * 32 + 8 * fq;
#pragma unroll
        for (int ai = 0; ai < 2; ++ai)
#pragma unroll
            for (int m = 0; m < 4; ++m) { const int row = row0 + ai * HALF + m * 16; const float rs = row_rstd(ss, row); float* dst = P + ((size_t)u.pn * Mrows + row) * 64 + col0;
                *(f32x4*)dst = acc[ai][0][m][0] * rs; *(f32x4*)(dst + 4) = acc[ai][0][m][1] * rs; }
    }
};
struct EpiF32 {
    static constexpr bool PERM = false, AFTER_DRAIN = false, PF = false;
    float* C; int ldc;
    __device__ __forceinline__ void operator()(const f32x4 (&acc)[2][2][4][2], const Unit& u, int wr, int wc, int fr, int fq) const {
        const int row0 = u.pm * BM + wr * 64 + fr, col0 = u.pn * BM + wc * 32 + 4 * fq;
#pragma unroll
        for (int ai = 0; ai < 2; ++ai)
#pragma unroll
            for (int m = 0; m < 4; ++m) { float* rowp = C + (size_t)(row0 + ai * HALF + m * 16) * ldc + col0;
#pragma unroll
                for (int bj = 0; bj < 2; ++bj)
#pragma unroll
                    for (int n = 0; n < 2; ++n) *(f32x4*)(rowp + bj * HALF + n * 16) = acc[ai][bj][m][n]; }
    }
};
struct EpiBf16NP {
    static constexpr bool PERM = false, AFTER_DRAIN = false, PF = false;
    bf16_t* C; int ldc;
    __device__ __forceinline__ void operator()(const f32x4 (&acc)[2][2][4][2], const Unit& u, int wr, int wc, int fr, int fq) const {
        const int row0 = u.pm * BM + wr * 64 + fr, col0 = u.pn * BM + wc * 32 + 4 * fq;
#pragma unroll
        for (int ai = 0; ai < 2; ++ai)
#pragma unroll
            for (int m = 0; m < 4; ++m) { bf16_t* rowp = C + (size_t)(row0 + ai * HALF + m * 16) * ldc + col0;
#pragma unroll
                for (int bj = 0; bj < 2; ++bj)
#pragma unroll
                    for (int n = 0; n < 2; ++n) { const f32x4 v = acc[ai][bj][m][n]; u32x2 w; w.x = cvt_pk_bf16(v[0], v[1]); w.y = cvt_pk_bf16(v[2], v[3]); *(u32x2*)(rowp + bj * HALF + n * 16) = w; } }
    }
};
struct EpiPle {
    static constexpr bool PERM = false, AFTER_DRAIN = false, PF = false;
    const bf16_t* x; const bf16_t* P; float* out; int ldc; const float* ss;
    __device__ __forceinline__ void operator()(const f32x4 (&acc)[2][2][4][2], const Unit& u, int wr, int wc, int fr, int fq) const {
        const int row0 = u.pm * BM + wr * 64 + fr, col0 = u.pn * BM + wc * 32 + 4 * fq;
        const bf16_t* const x_ = x; const bf16_t* const P_ = P; float* const out_ = out; const int ldc_ = ldc;
        float rs8[2][4];
        load_rstd8(rs8, ss, row0);
        u32x2 xs[2][2], ps[2][2];
#pragma unroll
        for (int n = 0; n < 2; ++n) { xs[0][n] = *(const u32x2*)(x_ + (size_t)row0 * ldc_ + col0 + n * 16); ps[0][n] = *(const u32x2*)(P_ + (size_t)row0 * ldc_ + col0 + n * 16); }
#pragma unroll
        for (int st = 0; st < 16; ++st) { const int ai = st >> 3, m = (st >> 1) & 3, bj = st & 1; const size_t off = (size_t)(row0 + ai * HALF + m * 16) * ldc_ + col0 + bj * HALF; const float rsd = rs8[ai][m];
            if (st < 15) { const int s2 = st + 1; const size_t offn = (size_t)(row0 + (s2 >> 3) * HALF + ((s2 >> 1) & 3) * 16) * ldc_ + col0 + (s2 & 1) * HALF;
#pragma unroll
                for (int n = 0; n < 2; ++n) { xs[s2 & 1][n] = *(const u32x2*)(x_ + offn + n * 16); ps[s2 & 1][n] = *(const u32x2*)(P_ + offn + n * 16); } }
#pragma unroll
            for (int n = 0; n < 2; ++n) { const f32x4 xv = bf4_to_f32(xs[st & 1][n]), pv = bf4_to_f32(ps[st & 1][n]); f32x4 o;
#pragma unroll
                for (int e = 0; e < 4; ++e) o[e] = xv[e] + fast_sigmoid(acc[ai][bj][m][n][e] * rsd) * pv[e];
                *(f32x4*)(out_ + off + n * 16) = o; }
            asm volatile("" ::: "memory"); }
    }
};

template <class Epi, class Sched, bool ALIGN_EPI = false, bool SP2 = false>
__device__ __forceinline__ void gemm_phase(PG8_LAS unsigned char* lds, const Gemm g, const Sched S, const Epi E) {
    const int tid = threadIdx.x, wid = __builtin_amdgcn_readfirstlane(tid >> 6), lane = tid & 63, wr = wid >> 2, wc = wid & 3, fr = lane & 15, fq = lane >> 4;
    const int K = g.K, nt = K / BK, LD = g.ld ? g.ld : K;
    unsigned voffA[2], voffB[2];
#pragma unroll
    for (int i = 0; i < 2; ++i) { int R, C; stage_rc(tid * 16 + i * 8192, R, C); const int Rb = Epi::PERM ? ((R & ~31) + perm32(R & 31)) : R;
        voffA[i] = (unsigned)(R * LD + C) * 2u; voffB[i] = (unsigned)(Rb * LD + C) * 2u; }
    const size_t kstep = (size_t)(BK * 2);
    const size_t hstep = (size_t)HALF * LD * 2;
    const size_t tstep = 2 * hstep;
    const unsigned ldsw = (unsigned)wid * 1024u;
    const int aoff = lds_byte(wr * 64 + fr, fq * 8), boff = lds_byte(wc * 32 + fr, fq * 8);
#define PG8_SA(b, h) (((b) * 2 + (h)) * HTB)
#define PG8_SB(b, h) ((4 + (b) * 2 + (h)) * HTB)
#define PG8_STAGE(bufoff, gbase, voff) do { _Pragma("unroll") for (int _i = 0; _i < 2; ++_i) \
        __builtin_amdgcn_global_load_lds((const unsigned*)((const char*)(gbase) + (voff)[_i]), (PG8_LAS unsigned*)(lds + (bufoff) + ldsw + _i * 8192), 16, 0, 0); } while (0)
#define PG8_LDA(dst, b, h) do { _Pragma("unroll") for (int m = 0; m < 4; ++m) _Pragma("unroll") for (int k = 0; k < 2; ++k) dst[m][k] = *(const PG8_LAS bf16x8*)(lds + PG8_SA(b, h) + aoff + m * 2048 + k * 1024); } while (0)
#define PG8_LDB(dst, b, h) do { _Pragma("unroll") for (int n = 0; n < 2; ++n) _Pragma("unroll") for (int k = 0; k < 2; ++k) dst[n][k] = *(const PG8_LAS bf16x8*)(lds + PG8_SB(b, h) + boff + n * 2048 + k * 1024); } while (0)
#define PG8_MMA(ai, bj, At, Bt) do { __builtin_amdgcn_s_setprio(1); _Pragma("unroll") for (int m = 0; m < 4; ++m) _Pragma("unroll") for (int n = 0; n < 2; ++n) _Pragma("unroll") for (int k = 0; k < 2; ++k) \
        acc[ai][bj][m][n] = __builtin_amdgcn_mfma_f32_16x16x32_bf16(Bt[n][k], At[m][k], acc[ai][bj][m][n], 0, 0, 0); __builtin_amdgcn_s_setprio(0); } while (0)
#define PG8_WAIT_V(n) asm volatile("s_waitcnt vmcnt(" #n ")" ::: "memory")
#define PG8_WAIT_L(n) asm volatile("s_waitcnt lgkmcnt(" #n ")" ::: "memory")
#define PG8_BAR __builtin_amdgcn_s_barrier()
#define PG8_SCHED __builtin_amdgcn_sched_barrier(0)
    Unit cur, nxt; int ui = 0;
    if (!S.next(0, cur)) return;
    f32x4 acc[2][2][4][2];
#pragma unroll
    for (int a = 0; a < 2; ++a)
#pragma unroll
        for (int b = 0; b < 2; ++b)
#pragma unroll
            for (int m = 0; m < 4; ++m)
#pragma unroll
                for (int n = 0; n < 2; ++n) acc[a][b][m][n] = (f32x4){0.f, 0.f, 0.f, 0.f};
    bf16x8 At[4][2], B0[2][2], B1[2][2];
    const size_t bstep = g.kofs ? g.kofs : tstep;
    const char* cA = (const char*)g.A + (size_t)cur.pm * tstep + (size_t)cur.pn * g.kofs; const char* cB = (const char*)g.Bt + (size_t)cur.pn * bstep;
    S.a_ready(cur);
    if constexpr (SP2) {
        PG8_STAGE(PG8_SB(0, 0), cB, voffB); PG8_STAGE(PG8_SB(0, 1), cB + hstep, voffB); PG8_STAGE(PG8_SA(0, 0), cA, voffA); PG8_STAGE(PG8_SA(0, 1), cA + hstep, voffA);
        if (wr == 1) PG8_BAR;
        PG8_WAIT_V(2); PG8_BAR;
        PG8_STAGE(PG8_SB(1, 0), cB + kstep, voffB); PG8_STAGE(PG8_SA(1, 0), cA + kstep, voffA); PG8_STAGE(PG8_SB(1, 1), cB + hstep + kstep, voffB);
        PG8_WAIT_V(6); PG8_BAR;
    } else {
        PG8_STAGE(PG8_SB(0, 0), cB, voffB); PG8_STAGE(PG8_SA(0, 0), cA, voffA); PG8_STAGE(PG8_SB(0, 1), cB + hstep, voffB); PG8_STAGE(PG8_SA(0, 1), cA + hstep, voffA);
        if (wr == 1) PG8_BAR;
        PG8_WAIT_V(4); PG8_BAR;
        PG8_STAGE(PG8_SB(1, 0), cB + kstep, voffB); PG8_STAGE(PG8_SA(1, 0), cA + kstep, voffA); PG8_STAGE(PG8_SB(1, 1), cB + hstep + kstep, voffB);
        PG8_WAIT_V(6); PG8_BAR;
    }
    for (;;) {
        const bool has_next = S.next(ui + 1, nxt);
        const char* nA = has_next ? (const char*)g.A + (size_t)nxt.pm * tstep + (size_t)nxt.pn * g.kofs : cA; const char* nB = has_next ? (const char*)g.Bt + (size_t)nxt.pn * bstep : cB;
        for (int t = 0; t < nt; t += 2) {
            const bool last = (t == nt - 2);
            const char* a1 = cA + (size_t)(t + 1) * kstep;
            const char* a2 = last ? nA : cA + (size_t)(t + 2) * kstep; const char* b2 = last ? nB : cB + (size_t)(t + 2) * kstep;
            const char* a3 = a2 + kstep; const char* b3 = b2 + kstep;
            if (last && has_next) S.a_ready(nxt);
            if constexpr (Epi::PF) { if (last) E.prefetch(lds + STAGE_BYTES + wid * 512, cur, wr, lane); }
            if constexpr (SP2) {
            PG8_LDB(B0, 0, 0); PG8_LDB(B1, 0, 1); PG8_SCHED; PG8_LDA(At, 0, 0); PG8_STAGE(PG8_SA(1, 1), a1 + hstep, voffA);
            PG8_WAIT_V(8); PG8_WAIT_L(0); PG8_BAR; PG8_MMA(0, 0, At, B0); PG8_MMA(0, 1, At, B1); PG8_BAR; PG8_SCHED;
            PG8_LDA(At, 0, 1); PG8_STAGE(PG8_SB(0, 0), b2, voffB); PG8_STAGE(PG8_SB(0, 1), b2 + hstep, voffB); PG8_STAGE(PG8_SA(0, 0), a2, voffA);
            PG8_WAIT_V(8); PG8_WAIT_L(0); PG8_BAR; PG8_MMA(1, 0, At, B0); PG8_MMA(1, 1, At, B1); PG8_BAR; PG8_SCHED;
            PG8_LDB(B0, 1, 0); PG8_LDB(B1, 1, 1); PG8_SCHED; PG8_LDA(At, 1, 0); PG8_STAGE(PG8_SA(0, 1), a2 + hstep, voffA);
            PG8_WAIT_V(8); PG8_WAIT_L(0); PG8_BAR; PG8_MMA(0, 0, At, B0); PG8_MMA(0, 1, At, B1); PG8_BAR; PG8_SCHED;
            PG8_LDA(At, 1, 1); PG8_STAGE(PG8_SB(1, 0), b3, voffB); PG8_STAGE(PG8_SB(1, 1), b3 + hstep, voffB); PG8_STAGE(PG8_SA(1, 0), a3, voffA);
            PG8_WAIT_V(8); PG8_WAIT_L(0); PG8_BAR; PG8_MMA(1, 0, At, B0); PG8_MMA(1, 1, At, B1); PG8_BAR; PG8_SCHED;
            } else {
            PG8_LDB(B0, 0, 0); PG8_SCHED; PG8_LDA(At, 0, 0); PG8_STAGE(PG8_SA(1, 1), a1 + hstep, voffA);
            PG8_WAIT_L(8); PG8_BAR; PG8_WAIT_L(0); PG8_MMA(0, 0, At, B0); PG8_BAR; PG8_SCHED;
            PG8_LDB(B1, 0, 1); PG8_STAGE(PG8_SB(0, 0), b2, voffB);
            PG8_BAR; PG8_WAIT_L(0); PG8_MMA(0, 1, At, B1); PG8_BAR;
            PG8_LDA(At, 0, 1); PG8_STAGE(PG8_SA(0, 0), a2, voffA);
            PG8_BAR; PG8_WAIT_L(0); PG8_MMA(1, 0, At, B0); PG8_BAR; PG8_SCHED;
            PG8_STAGE(PG8_SB(0, 1), b2 + hstep, voffB);
            PG8_WAIT_V(6); PG8_BAR; PG8_MMA(1, 1, At, B1); PG8_BAR;
            PG8_LDB(B0, 1, 0); PG8_SCHED; PG8_LDA(At, 1, 0); PG8_STAGE(PG8_SA(0, 1), a2 + hstep, voffA);
            PG8_WAIT_L(8); PG8_BAR; PG8_WAIT_L(0); PG8_MMA(0, 0, At, B0); PG8_BAR; PG8_SCHED;
            PG8_LDB(B1, 1, 1); PG8_STAGE(PG8_SB(1, 0), b3, voffB);
            PG8_BAR; PG8_WAIT_L(0); PG8_MMA(0, 1, At, B1); PG8_BAR;
            PG8_LDA(At, 1, 1); PG8_STAGE(PG8_SA(1, 0), a3, voffA);
            PG8_BAR; PG8_WAIT_L(0); PG8_MMA(1, 0, At, B0); PG8_BAR; PG8_SCHED;
            PG8_STAGE(PG8_SB(1, 1), b3 + hstep, voffB);
            PG8_WAIT_V(6); PG8_BAR; PG8_MMA(1, 1, At, B1); PG8_BAR;
            }
        }
        if constexpr (ALIGN_EPI) { if (wr == 0) PG8_BAR; }
        if constexpr (!Epi::AFTER_DRAIN) { if constexpr (Epi::PF) E(acc, cur, wr, wc, fr, fq, lds + STAGE_BYTES + wid * 512); else E(acc, cur, wr, wc, fr, fq); S.done(cur); }
        if (!has_next) break;
#pragma unroll
        for (int a = 0; a < 2; ++a)
#pragma unroll
            for (int b = 0; b < 2; ++b)
#pragma unroll
                for (int m = 0; m < 4; ++m)
#pragma unroll
                    for (int n = 0; n < 2; ++n) acc[a][b][m][n] = (f32x4){0.f, 0.f, 0.f, 0.f};
        cur = nxt; cA = nA; cB = nB; ++ui;
        if constexpr (ALIGN_EPI) { if (wr == 1) PG8_BAR; }
    }
    PG8_WAIT_V(0);
    if constexpr (!ALIGN_EPI) { if (wr == 0) PG8_BAR; }
    PG8_BAR;
    if constexpr (Epi::AFTER_DRAIN) { E.fused(acc, cur, wr, wc, fr, fq, lds, wid, lane); S.done(cur); }
#undef PG8_SA
#undef PG8_SB
#undef PG8_STAGE
#undef PG8_LDA
#undef PG8_LDB
#undef PG8_MMA
#undef PG8_WAIT_V
#undef PG8_WAIT_L
#undef PG8_BAR
#undef PG8_SCHED
}
}

#ifndef MK_N_LAUNCHES
#define MK_N_LAUNCHES 1
#endif
#ifndef PROBE_PHASE
#define PROBE_PHASE -1
#endif
#define REP(k) (((k) == PROBE_PHASE) ? 2 : 1)
constexpr int NPH = 16;
constexpr int N_LAUNCHES = MK_N_LAUNCHES;
constexpr int NWAVES = 8, NTHR = 512;
constexpr int BATCH = 2, SEQ = 4096, T = BATCH * SEQ, DM = 2048, FF = 5632, PLE = 256;
constexpr int MLA_H = 8, QKH = 192, VH = 128, QL = 512, KVL = 256;
constexpr int RH = 16, RD = 1024;
constexpr int ZW = 4096;
constexpr int Z_R = 768, Z_K = 1792, Z_V = 2816, Z_LORA = 3840;
constexpr int LW = 3072;
constexpr float EPS = 1e-6f, GN_EPS = 64e-5f;
constexpr float QSCALE = 1.4426950408889634f * 0.07216878364870322f;

constexpr size_t MiB = 1u << 20;
constexpr size_t WS_CTL = 0, CTL_ZERO_BYTES = 1 * MiB;
constexpr size_t WS_ROPE = 1 * MiB;
constexpr size_t WS_BONUS = 2 * MiB;
constexpr size_t WS_WIN = 3 * MiB;
constexpr size_t WS_WQB = 20 * MiB;
constexpr size_t WS_WKVB = WS_WQB + 1536 * 512 * 2;
constexpr size_t WS_WLORA = WS_WKVB + 2048 * 256 * 2;
constexpr size_t WS_WOUT = 25 * MiB;
constexpr size_t WS_WPG = 33 * MiB;
constexpr size_t WS_WPP = 41 * MiB;
constexpr size_t WS_WGU = 42 * MiB;
constexpr size_t WS_WD = 86 * MiB;
constexpr size_t WS_WD2 = 3 * MiB;
static_assert(WS_WD2 + (size_t)2048 * 5632 * 2 <= WS_WOUT && WS_WPP + 2048 * 256 * 2 <= WS_WGU, "ws map 2");
constexpr size_t WS_H = 108 * MiB;
constexpr size_t WS_U = 140 * MiB;
constexpr size_t WS_X = 228 * MiB;
constexpr size_t WS_END = 408 * MiB;
constexpr size_t WS_Z = WS_U, WS_AQ = WS_U + 64 * MiB, WS_AKV = WS_AQ + 8 * MiB, WS_AL = WS_AKV + 4 * MiB, WS_KPEP = WS_AL + 4 * MiB;
constexpr size_t WS_WKPE = WS_WIN + 16 * MiB;
constexpr size_t WS_QRAW = WS_X, WS_KVRAW = WS_X + 24 * MiB, WS_LORA = WS_X + 56 * MiB;
constexpr size_t WS_QH = WS_X + 104 * MiB, WS_KH = WS_X + 128 * MiB, WS_VT = WS_X + 152 * MiB;
constexpr size_t WS_OMIX = WS_X;
constexpr size_t WS_TRT = WS_WGU;
constexpr size_t WS_SLOT = WS_TRT + 32 * MiB;
constexpr size_t WS_RRT = WS_SLOT + 32 * MiB;
constexpr size_t WS_G2T = WS_RRT + 16 * MiB;
constexpr size_t WS_VCG = WS_AQ;
static_assert(WS_G2T + 8 * MiB <= WS_U && WS_VCG + 16 * MiB <= WS_X, "chunk matrices");
constexpr size_t WS_OTMP = WS_X + 32 * MiB;
constexpr size_t WS_AST = WS_X + 172 * MiB;
constexpr size_t WS_PB = WS_X + 168 * MiB, WS_PPLE = WS_X + 8 * MiB;
static_assert(WS_WLORA + 3072 * 256 * 2 <= WS_WOUT && WS_VT + 16 * MiB <= WS_END && WS_AL + 4 * MiB <= WS_X, "ws map");
constexpr int CW_BAR = 4096, CW_QUEUE = 64, CW_SS = 32768;

constexpr int RING_OFF = 0, RING_BYTES = 131072;
constexpr int LDSCTL_OFF = 157696, MISC_OFF = LDSCTL_OFF + 320;
constexpr int LDS_BYTES = 159744;

#define GAS __attribute__((address_space(1)))
#define LAS __attribute__((address_space(3)))
typedef unsigned short bf16;
typedef unsigned v4u __attribute__((ext_vector_type(4)));
typedef unsigned v2u __attribute__((ext_vector_type(2)));
typedef float f32x4 __attribute__((ext_vector_type(4)));
typedef float f32x2 __attribute__((ext_vector_type(2)));
typedef float f32x16 __attribute__((ext_vector_type(16)));
typedef short bf16x8 __attribute__((ext_vector_type(8)));
typedef GAS unsigned gu32;
#define RLX_AGENT __ATOMIC_RELAXED, __HIP_MEMORY_SCOPE_AGENT
#define LDS_WAIT() asm volatile("s_waitcnt lgkmcnt(0)" ::: "memory")
#define VM_WAIT() asm volatile("s_waitcnt vmcnt(0)" ::: "memory")
__device__ __forceinline__ unsigned f2bf(float f) { unsigned u = __builtin_bit_cast(unsigned, f); return (u + 0x7fffu + ((u >> 16) & 1u)) >> 16; }
__device__ __forceinline__ unsigned pk2(float lo, float hi) { return f2bf(lo) | (f2bf(hi) << 16); }
__device__ __forceinline__ float bf2f(unsigned short h) { return __builtin_bit_cast(float, (unsigned)h << 16); }
__device__ __forceinline__ float bflo(unsigned w) { return __builtin_bit_cast(float, w << 16); }
__device__ __forceinline__ float bfhi(unsigned w) { return __builtin_bit_cast(float, w & 0xffff0000u); }
__device__ __forceinline__ float sigmoidf_(float x) { return __builtin_amdgcn_rcpf(1.0f + __builtin_amdgcn_exp2f(-1.4426950408889634f * x)); }
__device__ __forceinline__ float wave_sum(float v) {
#pragma unroll
    for (int o = 1; o < 64; o <<= 1) v += __shfl_xor(v, o);
    return v;
}

#define XB_TMO      128
#define XB_XCNT(j)  (256  + 64 * (j))
#define XB_XSUB(j)  (1280 + 64 * (j))
#define XB_XGEN(j)  (2304 + 64 * (j))
#define XB_TOP      3328
#define XB_TOPGEN   3392
#define XCD_BAR_WORDS 3456
#define XB_SPIN_CAP (1u << 18)

__device__ __forceinline__ unsigned xb_ld(unsigned* p)              { return __hip_atomic_load(p, __ATOMIC_RELAXED, __HIP_MEMORY_SCOPE_AGENT); }
__device__ __forceinline__ unsigned xb_add(unsigned* p, unsigned v) { return __hip_atomic_fetch_add(p, v, __ATOMIC_RELAXED, __HIP_MEMORY_SCOPE_AGENT); }
__device__ __forceinline__ unsigned xb_xcc_id() { return (unsigned)__builtin_amdgcn_s_getreg((3 << 11) | 20) & 0xFu; }
#define XB_SPIN(cond, bar) do { unsigned _sp = 0; while (cond) { __builtin_amdgcn_s_sleep(1); \
    if ((++_sp & 255u) == 0u) { if (xb_ld(&(bar)[XB_TMO])) break; if (_sp > XB_SPIN_CAP) { atomicAdd(&(bar)[XB_TMO], 1u); break; } } } } while (0)

struct XcdBarrier {
    unsigned* bar; unsigned x;
    volatile LAS unsigned* st;
};

__device__ __forceinline__ XcdBarrier xcd_barrier_post(unsigned* bar, volatile LAS unsigned* st) {
    XcdBarrier b; b.bar = bar; b.x = xb_xcc_id(); b.st = st;
    if (threadIdx.x == 0) (void)xb_add(&bar[XB_XCNT(b.x)], 1u);
    return b;
}
__device__ __forceinline__ void xcd_barrier_complete(unsigned* bar, unsigned x, unsigned& nloc, unsigned& nx) {
    const unsigned G = gridDim.x * gridDim.y * gridDim.z;
    unsigned sum, cnt, mine, sp = 0u;
    for (;;) {
        sum = 0u; cnt = 0u; mine = 0u;
#pragma unroll
        for (unsigned j = 0; j < 16; ++j) { const unsigned c = xb_ld(&bar[XB_XCNT(j)]); sum += c; cnt += (c > 0u) ? 1u : 0u; mine = (j == x) ? c : mine; }
        if (sum == G) break;
        __builtin_amdgcn_s_sleep(1);
        if ((++sp & 255u) == 0u) { if (xb_ld(&bar[XB_TMO])) break; if (sp > XB_SPIN_CAP) { atomicAdd(&bar[XB_TMO], 1u); break; } }
    }
    nloc = mine > 0u ? mine : 1u; nx = cnt > 0u ? cnt : 1u;
}

__device__ __forceinline__ void xcd_barrier(const XcdBarrier& b) {
    asm volatile("s_waitcnt vmcnt(0)" ::: "memory");
    __syncthreads();
    if (threadIdx.x == 0) {
        unsigned* bar = b.bar;
        __builtin_amdgcn_s_waitcnt(0);
        unsigned nloc = b.st[0], nx = b.st[1];
        if (nloc == 0u) { xcd_barrier_complete(bar, b.x, nloc, nx); b.st[0] = nloc; b.st[1] = nx; }
        const unsigned old = xb_add(&bar[XB_XSUB(b.x)], 1u);
        const unsigned gen = old / nloc;
        if (old + 1u == (gen + 1u) * nloc) {
            __builtin_amdgcn_fence(__ATOMIC_RELEASE, "agent");
            asm volatile("s_waitcnt vmcnt(0)" ::: "memory");
            const unsigned og = xb_add(&bar[XB_TOP], 1u);
            const unsigned tg = og / nx;
            if (og + 1u == (tg + 1u) * nx) xb_add(&bar[XB_TOPGEN], 1u);
            else XB_SPIN(xb_ld(&bar[XB_TOPGEN]) == tg, bar);
            __builtin_amdgcn_fence(__ATOMIC_ACQUIRE, "agent");
            xb_add(&bar[XB_XGEN(b.x)], 1u);
            asm volatile("s_waitcnt vmcnt(0)" ::: "memory");
        } else {
            XB_SPIN(xb_ld(&bar[XB_XGEN(b.x)]) == gen, bar);
            __builtin_amdgcn_fence(__ATOMIC_ACQUIRE, "agent");
            asm volatile("s_waitcnt vmcnt(0)" ::: "memory");
        }
    }
    __syncthreads();
}


struct Args { const float* in[33]; float* out; unsigned char* ws; int ph_lo, ph_hi; };

struct WJob { const float* W0; const float* W1; const float* gain; bf16* dst; int K, N, NP, KD, koff, mode, LDN, coff, skip_at, skip_by, nlo; };
__device__ __forceinline__ int job_items(const WJob& j) { return (j.KD / 64) * (j.NP / 32); }
__device__ __forceinline__ bf16* tr_load(const WJob& j, int item, int lane, f32x4 (&v)[8]) {
    const int nblk = j.NP / 32, kb = item / nblk, nb = item % nblk, k0 = 64 * kb, n0 = j.nlo + 32 * nb;
    const int g = lane & 7, kc = lane >> 3, np = n0 + 4 * g, kk = k0 + 8 * kc;
    const float* W = j.W0; int col = np + j.coff + (np >= j.skip_at ? j.skip_by : 0); bool nvalid = np < j.N;
    if (j.mode == 1) { const int i = np & 7, jj = np >> 3; const ptrdiff_t dW = j.W1 - j.W0; W = j.W0 + ((i < 4) ? (ptrdiff_t)0 : dW); col = 4 * jj; nvalid = true; }
#pragma unroll
    for (int i = 0; i < 8; ++i) {
        const int k = kk + i - j.koff;
        const bool ok = nvalid && k >= 0 && k < j.K;
        v[i] = (f32x4){0.f, 0.f, 0.f, 0.f};
        if (ok) { v[i] = __builtin_nontemporal_load((const GAS f32x4*)(W + (size_t)k * j.LDN + col)); if (j.gain) v[i] = v[i] * j.gain[k]; }
    }
    return j.dst + (size_t)np * j.KD + kk;
}
__device__ __forceinline__ void tr_store(const WJob& j, const f32x4 (&v)[8], bf16* d) {
#pragma unroll
    for (int q = 0; q < 4; ++q) { v4u o; o.x = pk2(v[0][q], v[1][q]); o.y = pk2(v[2][q], v[3][q]); o.z = pk2(v[4][q], v[5][q]); o.w = pk2(v[6][q], v[7][q]);
        *(GAS v4u*)(d + (size_t)q * j.KD) = o; }
}
__device__ __forceinline__ WJob mk_job(const float* W0, const float* W1, const float* gain, bf16* dst, int K, int N, int NP, int KD, int koff, int mode, int LDN = 0, int coff = 0, int skip_at = 1 << 30, int skip_by = 0, int nlo = 0) {
    WJob j; j.W0 = W0; j.W1 = W1; j.gain = gain; j.dst = dst; j.K = K; j.N = N; j.NP = NP; j.KD = KD; j.koff = koff; j.mode = mode; j.LDN = LDN ? LDN : N; j.coff = coff; j.skip_at = skip_at; j.skip_by = skip_by; j.nlo = nlo; return j;
}
__device__ __forceinline__ void run_job(const WJob& j, int gw, int NGW, int& base, LAS float* scr, int lane) {
    const int n = job_items(j);
    int first = (gw - base) % NGW; if (first < 0) first += NGW;
    (void)scr;
    for (int it = first; it < n; it += 2 * NGW) {
        f32x4 va[8], vb[8]; bf16* db = nullptr; const bool hb = it + NGW < n;
        bf16* da = tr_load(j, it, lane, va);
        if (hb) db = tr_load(j, it + NGW, lane, vb);
        tr_store(j, va, da);
        if (hb) tr_store(j, vb, db);
    }
    base = (base + n) % NGW;
}

__device__ __forceinline__ void rms_row_bf16(const float* xrow, bf16* orow, int lane) {
    const GAS f32x4* xr = (const GAS f32x4*)xrow + lane;
    f32x4 v[8]; float s = 0.f;
#pragma unroll
    for (int j = 0; j < 8; ++j) { v[j] = xr[64 * j]; s += (v[j].x * v[j].x + v[j].y * v[j].y) + (v[j].z * v[j].z + v[j].w * v[j].w); }
    const float rstd = 1.0f / sqrtf(wave_sum(s) * (1.f / DM) + EPS);
    GAS unsigned long long* o8 = (GAS unsigned long long*)orow + lane;
#pragma unroll
    for (int j = 0; j < 8; ++j) o8[64 * j] = (unsigned long long)pk2(v[j].x * rstd, v[j].y * rstd) | ((unsigned long long)pk2(v[j].z * rstd, v[j].w * rstd) << 32);
}
__device__ __forceinline__ void rms_pass(const float* X, bf16* H, int gw, int NGW, int lane) {
    for (int m = gw; m < T; m += NGW) rms_row_bf16(X + (size_t)m * DM, H + (size_t)m * DM, lane);
}
__device__ __forceinline__ void xb_pass(const float* X, bf16* XB, float* ss, int gw, int NGW, int lane) {
    for (int m = gw; m < T; m += 2 * NGW) {
        const int m2 = m + NGW; const bool hb = m2 < T;
        const GAS f32x4* xa = (const GAS f32x4*)(X + (size_t)m * DM) + lane; const GAS f32x4* xb = (const GAS f32x4*)(X + (size_t)(hb ? m2 : m) * DM) + lane;
        f32x4 va[8], vb[8]; float sa = 0.f, sb = 0.f;
#pragma unroll
        for (int j = 0; j < 8; ++j) va[j] = __builtin_nontemporal_load(xa + 64 * j);
#pragma unroll
        for (int j = 0; j < 8; ++j) vb[j] = __builtin_nontemporal_load(xb + 64 * j);
#pragma unroll
        for (int j = 0; j < 8; ++j) { sa += (va[j].x * va[j].x + va[j].y * va[j].y) + (va[j].z * va[j].z + va[j].w * va[j].w); sb += (vb[j].x * vb[j].x + vb[j].y * vb[j].y) + (vb[j].z * vb[j].z + vb[j].w * vb[j].w); }
        sa = wave_sum(sa); sb = wave_sum(sb);
        GAS unsigned long long* oa = (GAS unsigned long long*)(XB + (size_t)m * DM) + lane;
#pragma unroll
        for (int j = 0; j < 8; ++j) oa[64 * j] = (unsigned long long)pk2(va[j].x, va[j].y) | ((unsigned long long)pk2(va[j].z, va[j].w) << 32);
        if (lane == 0) ss[m] = sa;
        if (hb) { GAS unsigned long long* ob = (GAS unsigned long long*)(XB + (size_t)m2 * DM) + lane;
#pragma unroll
            for (int j = 0; j < 8; ++j) ob[64 * j] = (unsigned long long)pk2(vb[j].x, vb[j].y) | ((unsigned long long)pk2(vb[j].z, vb[j].w) << 32);
            if (lane == 0) ss[m2] = sb; }
    }
}

__device__ __forceinline__ void prep_a_row(int t, const bf16* Z, const float* mu, bf16* AQ, bf16* AKV, bf16* AL, int lane) {
    const bf16* zr = Z + (size_t)t * ZW;
    {
        const v4u w = *(const GAS v4u*)(zr + lane * 8);
        float x[8] = {bflo(w.x), bfhi(w.x), bflo(w.y), bfhi(w.y), bflo(w.z), bfhi(w.z), bflo(w.w), bfhi(w.w)};
        float s = 0.f;
#pragma unroll
        for (int e = 0; e < 8; ++e) s += x[e] * x[e];
        const float rstd = 1.0f / sqrtf(wave_sum(s) * (1.f / QL) + EPS);
        v4u o; o.x = pk2(x[0] * rstd, x[1] * rstd); o.y = pk2(x[2] * rstd, x[3] * rstd); o.z = pk2(x[4] * rstd, x[5] * rstd); o.w = pk2(x[6] * rstd, x[7] * rstd);
        *(GAS v4u*)(AQ + (size_t)t * QL + lane * 8) = o;
    }
    {
        const v2u w = *(const GAS v2u*)(zr + QL + lane * 4);
        float x[4] = {bflo(w.x), bfhi(w.x), bflo(w.y), bfhi(w.y)};
        const float s = (x[0] * x[0] + x[1] * x[1]) + (x[2] * x[2] + x[3] * x[3]);
        const float rstd = 1.0f / sqrtf(wave_sum(s) * (1.f / KVL) + EPS);
        v2u o; o.x = pk2(x[0] * rstd, x[1] * rstd); o.y = pk2(x[2] * rstd, x[3] * rstd);
        *(GAS v2u*)(AKV + (size_t)t * KVL + lane * 4) = o;
    }
    {
        const v2u w = *(const GAS v2u*)(zr + Z_LORA + lane * 4);
        v2u wp; wp.x = 0u; wp.y = 0u;
        if ((t % SEQ) != 0) wp = *(const GAS v2u*)(zr - ZW + Z_LORA + lane * 4);
        const f32x4 m4 = *(const GAS f32x4*)(mu + (Z_LORA - Z_R) + lane * 4);
        float c[4] = {bflo(w.x), bfhi(w.x), bflo(w.y), bfhi(w.y)}, p[4] = {bflo(wp.x), bfhi(wp.x), bflo(wp.y), bfhi(wp.y)}, o[4];
#pragma unroll
        for (int e = 0; e < 4; ++e) { const float zs = c[e] + (p[e] - c[e]) * m4[e];
            float r;
            if (lane < 16) r = 1.0f - 2.0f * __builtin_amdgcn_rcpf(__builtin_amdgcn_exp2f(2.8853900817779268f * zs) + 1.0f);
            else if (lane < 32) r = zs;
            else r = sigmoidf_(zs);
            o[e] = r; }
        v2u ow; ow.x = pk2(o[0], o[1]); ow.y = pk2(o[2], o[3]);
        *(GAS v2u*)(AL + (size_t)t * 256 + lane * 4) = ow;
    }
}

template <int CTRL> __device__ __forceinline__ float dpp_add(float x) { return x + __builtin_bit_cast(float, __builtin_amdgcn_update_dpp(0, __builtin_bit_cast(int, x), CTRL, 0xF, 0xF, true)); }
__device__ __forceinline__ float allreduce16(float x) { x = dpp_add<0xB1>(x); x = dpp_add<0x4E>(x); x = dpp_add<0x141>(x); x = dpp_add<0x140>(x); return x; }
__device__ __forceinline__ float wave_sum_dpp(float x) { x = allreduce16(x); x += __shfl_xor(x, 16); x += __shfl_xor(x, 32); return x; }
__device__ __forceinline__ float allreduce64(float x) { x = allreduce16(x); float a_ = x, b_ = x;
    asm volatile("s_nop 1\n\tv_permlane16_swap_b32 %0, %1" : "+v"(a_), "+v"(b_));
    x = a_ + b_; a_ = x; b_ = x;
    asm volatile("s_nop 1\n\tv_permlane32_swap_b32 %0, %1" : "+v"(a_), "+v"(b_));
    return a_ + b_; }
__device__ __forceinline__ void kpe_task(int task, const bf16* XB, const bf16* WK, const float* ss, float* KPE, LAS unsigned char* lds, int tid) {
    const int lane = tid & 63, wv = __builtin_amdgcn_readfirstlane(tid >> 6), r32 = lane & 31, hi = lane >> 5, r0 = task * 32;
    f32x16 acc0, acc1;
#pragma unroll
    for (int r = 0; r < 16; ++r) { acc0[r] = 0.f; acc1[r] = 0.f; }
    const bf16* ap = XB + (size_t)(r0 + r32) * DM + 256 * wv + 8 * hi;
    const bf16* bp0 = WK + (size_t)r32 * DM + 256 * wv + 8 * hi; const bf16* bp1 = bp0 + (size_t)32 * DM;
#pragma unroll
    for (int half = 0; half < 2; ++half) {
        bf16x8 a[8], b0[8], b1[8];
#pragma unroll
        for (int ks = 0; ks < 8; ++ks) { const int ko = (half * 8 + ks) * 16; a[ks] = *(const GAS bf16x8*)(ap + ko); b0[ks] = *(const GAS bf16x8*)(bp0 + ko); b1[ks] = *(const GAS bf16x8*)(bp1 + ko); }
#pragma unroll
        for (int ks = 0; ks < 8; ++ks) { acc0 = __builtin_amdgcn_mfma_f32_32x32x16_bf16(a[ks], b0[ks], acc0, 0, 0, 0); acc1 = __builtin_amdgcn_mfma_f32_32x32x16_bf16(a[ks], b1[ks], acc1, 0, 0, 0); }
    }
    LAS float* red = (LAS float*)lds;
#pragma unroll
    for (int r = 0; r < 16; ++r) { red[(wv * 32 + r) * 64 + lane] = acc0[r]; red[(wv * 32 + 16 + r) * 64 + lane] = acc1[r]; }
    __syncthreads();
#pragma unroll
    for (int q = 0; q < 4; ++q) { const int reg = 4 * wv + q; float s = 0.f;
#pragma unroll
        for (int w = 0; w < 8; ++w) s += red[(w * 32 + reg) * 64 + lane];
        const int tile = reg >> 4, rr = reg & 15, row = r0 + (rr & 3) + 8 * (rr >> 2) + 4 * hi, col = 32 * tile + r32;
        KPE[(size_t)row * 64 + col] = s * __builtin_amdgcn_rsqf(ss[row] * (1.0f / 2048.0f) + 1e-6f); }
    __syncthreads();
}
__device__ __forceinline__ int vpos(int kl) { const int ko = kl & 15; return (kl & 48) + 8 * ((ko >> 2) & 1) + 4 * (ko >> 3) + (ko & 3); }
__device__ __forceinline__ void mla_prep_task(int task, const bf16* QRAW, const bf16* KVRAW, const float* qn, const float* kn, const f32x2* rope,
                                              bf16* Qh, bf16* Kh, bf16* Vt, int lane, const float* KPEP) {
    const int ws = task & 7, tile = (task >> 3) & 63, bh = task >> 9, b = bh >> 3, h = bh & 7;
    const float qg0 = qn[lane], qg1 = qn[64 + lane], qg2 = qn[128 + lane], kg0 = kn[lane], kg1 = kn[64 + lane], kg2 = kn[128 + lane];
    unsigned short qx[8][3], kx[8][2], vx[8][2]; float kpe[8];
#pragma unroll
    for (int i = 0; i < 8; ++i) { const int t = b * SEQ + tile * 64 + ws * 8 + i;
        const bf16* qr = QRAW + (size_t)t * 1536 + h * QKH; const bf16* kr = KVRAW + (size_t)t * 2048 + h * 256;
        qx[i][0] = qr[lane]; qx[i][1] = qr[64 + lane]; qx[i][2] = qr[128 + lane];
        kx[i][0] = kr[lane]; kx[i][1] = kr[64 + lane];
        kpe[i] = KPEP[(size_t)t * 64 + lane];
        vx[i][0] = kr[128 + lane]; vx[i][1] = kr[192 + lane]; }
#pragma unroll
    for (int i = 0; i < 8; ++i) {
        const int kl = ws * 8 + i, s = tile * 64 + kl;
        const f32x2 cs = rope[s * 32 + (lane & 31)];
        const float sgn = (lane < 32) ? -1.0f : 1.0f;
        {   float x0 = bf2f(qx[i][0]), x1 = bf2f(qx[i][1]), x2 = bf2f(qx[i][2]);
            const float rstd = __builtin_amdgcn_rsqf(wave_sum_dpp(x0 * x0 + x1 * x1 + x2 * x2) * (1.f / QKH) + EPS);
            x0 *= rstd * qg0; x1 *= rstd * qg1; x2 *= rstd * qg2;
            const float pr = __shfl_xor(x2, 32);
            x2 = x2 * cs.x + sgn * pr * cs.y;
            bf16* qo = Qh + ((size_t)bh * SEQ + s) * QKH;
            qo[lane] = (bf16)f2bf(x0 * QSCALE); qo[64 + lane] = (bf16)f2bf(x1 * QSCALE); qo[128 + lane] = (bf16)f2bf(x2 * QSCALE); }
        {   float x0 = bf2f(kx[i][0]), x1 = bf2f(kx[i][1]), x2 = kpe[i];
            const float rstd = __builtin_amdgcn_rsqf(wave_sum_dpp(x0 * x0 + x1 * x1 + x2 * x2) * (1.f / QKH) + EPS);
            x0 *= rstd * kg0; x1 *= rstd * kg1; x2 *= rstd * kg2;
            const float pr = __shfl_xor(x2, 32);
            x2 = x2 * cs.x + sgn * pr * cs.y;
            bf16* ko = Kh + ((size_t)bh * SEQ + s) * QKH;
            ko[lane] = (bf16)f2bf(x0); ko[64 + lane] = (bf16)f2bf(x1); ko[128 + lane] = (bf16)f2bf(x2); }
    }
    {   bf16* vt = Vt + ((size_t)bh * 64 + tile) * 8192 + 16 * (ws >> 1) + 4 * (ws & 1);
        v2u a0, a1, c0, c1;
        a0.x = (unsigned)vx[0][0] | ((unsigned)vx[1][0] << 16); a0.y = (unsigned)vx[2][0] | ((unsigned)vx[3][0] << 16);
        a1.x = (unsigned)vx[4][0] | ((unsigned)vx[5][0] << 16); a1.y = (unsigned)vx[6][0] | ((unsigned)vx[7][0] << 16);
        c0.x = (unsigned)vx[0][1] | ((unsigned)vx[1][1] << 16); c0.y = (unsigned)vx[2][1] | ((unsigned)vx[3][1] << 16);
        c1.x = (unsigned)vx[4][1] | ((unsigned)vx[5][1] << 16); c1.y = (unsigned)vx[6][1] | ((unsigned)vx[7][1] << 16);
        *(GAS v2u*)(vt + lane * 64) = a0; *(GAS v2u*)(vt + lane * 64 + 8) = a1;
        *(GAS v2u*)(vt + (64 + lane) * 64) = c0; *(GAS v2u*)(vt + (64 + lane) * 64 + 8) = c1; }
}

namespace att {
constexpr int KROW = 400, VROW = 144, KT = 64 * KROW, VTB = 128 * VROW, BUFB = KT + VTB, WSF_OFF = 2 * BUFB;
static_assert(WSF_OFF + 8 * 32 * 4 <= RING_BYTES, "attention LDS");
static_assert(RING_OFF + pg8::STAGE_BYTES + 8 * 512 <= LDSCTL_OFF, "GEMM epilogue prefetch slots");
__device__ __forceinline__ int crow(int r, int hi) { return (r & 3) + 8 * (r >> 2) + 4 * hi; }
__device__ __forceinline__ bf16x8 pack8(const f32x16& p, int b0) {
    v4u w; w.x = pg8::cvt_pk_bf16(p[b0], p[b0 + 1]); w.y = pg8::cvt_pk_bf16(p[b0 + 2], p[b0 + 3]); w.z = pg8::cvt_pk_bf16(p[b0 + 4], p[b0 + 5]); w.w = pg8::cvt_pk_bf16(p[b0 + 6], p[b0 + 7]);
    return __builtin_bit_cast(bf16x8, w);
}
__device__ __forceinline__ void attn_unit(int bh, int qb, int part, const bf16* Qh, const bf16* Kh, const bf16* Vt, bf16* Odst, int opitch, f32x2* ST, LAS unsigned char* lds) {
    const int tid = threadIdx.x, lane = tid & 63, wid = __builtin_amdgcn_readfirstlane(tid >> 6), r32 = lane & 31, hi = lane >> 5;
    const int b = bh >> 3, h = bh & 7, NTP = 2 * (qb + 1);
    const char* Kg = (const char*)(Kh + (size_t)bh * SEQ * QKH);
    const char* Vg = (const char*)(Vt + (size_t)bh * 64 * 8192);
    const int q0 = qb * 256 + wid * 32;
    bf16x8 qf[12];
    {   const bf16* qp = Qh + ((size_t)bh * SEQ + q0 + r32) * QKH + hi * 8;
#pragma unroll
        for (int ks = 0; ks < 12; ++ks) qf[ks] = *(const GAS bf16x8*)(qp + ks * 16); }
    v4u kst[3], vst[2];
    int kdst[3], vdst[2];
#pragma unroll
    for (int i = 0; i < 3; ++i) { const int c = tid + 512 * i; kdst[i] = (c / 24) * KROW + (c % 24) * 16; }
#pragma unroll
    for (int i = 0; i < 2; ++i) { const int c = tid + 512 * i; vdst[i] = KT + (c >> 3) * VROW + (c & 7) * 16; }
#define ATT_LOAD(j) do { const char* kg = Kg + (size_t)(j) * (64 * QKH * 2); const char* vg = Vg + (size_t)(j) * 16384; \
        _Pragma("unroll") for (int i_ = 0; i_ < 3; ++i_) kst[i_] = *(const GAS v4u*)(kg + (tid + 512 * i_) * 16); \
        _Pragma("unroll") for (int i_ = 0; i_ < 2; ++i_) vst[i_] = *(const GAS v4u*)(vg + (tid + 512 * i_) * 16); } while (0)
#define ATT_STORE(buf) do { LAS unsigned char* bs = lds + (buf) * BUFB; \
        _Pragma("unroll") for (int i_ = 0; i_ < 3; ++i_) *(LAS v4u*)(bs + kdst[i_]) = kst[i_]; \
        _Pragma("unroll") for (int i_ = 0; i_ < 2; ++i_) *(LAS v4u*)(bs + vdst[i_]) = vst[i_]; } while (0)
    ATT_LOAD(part); ATT_STORE(0);
#pragma unroll
    for (int ks = 0; ks < 12; ++ks) asm volatile("" : "+v"(qf[ks]));
    __syncthreads();
    float m = -1e30f, l = 0.f;
    f32x16 o[4];
#pragma unroll
    for (int d = 0; d < 4; ++d)
#pragma unroll
        for (int r = 0; r < 16; ++r) o[d][r] = 0.f;
    LAS float* wsf = (LAS float*)(lds + WSF_OFF) + wid * 32;
    for (int it = 0; it < NTP; ++it) {
        const int j = 2 * it + part;
        if (it + 1 < NTP) ATT_LOAD(j + 2);
        const int k0 = j * 64;
        if (k0 <= q0) {
            const LAS unsigned char* kb = lds + (it & 1) * BUFB; const LAS unsigned char* vb = kb + KT;
            f32x16 p0, p1;
#pragma unroll
            for (int r = 0; r < 16; ++r) { p0[r] = 0.f; p1[r] = 0.f; }
            __builtin_amdgcn_s_setprio(1);
#pragma unroll
            for (int ks = 0; ks < 12; ++ks) {
                const bf16x8 a0 = *(const LAS bf16x8*)(kb + r32 * KROW + ks * 32 + hi * 16);
                const bf16x8 a1 = *(const LAS bf16x8*)(kb + (32 + r32) * KROW + ks * 32 + hi * 16);
                p0 = __builtin_amdgcn_mfma_f32_32x32x16_bf16(a0, qf[ks], p0, 0, 0, 0);
                p1 = __builtin_amdgcn_mfma_f32_32x32x16_bf16(a1, qf[ks], p1, 0, 0, 0);
            }
            __builtin_amdgcn_s_setprio(0);
            if (k0 + 63 > q0) {
                const int q = q0 + r32;
#pragma unroll
                for (int r = 0; r < 16; ++r) { const int key = k0 + crow(r, hi); if (key > q) p0[r] = -1e30f; if (key + 32 > q) p1[r] = -1e30f; }
            }
            float mx = fmaxf(p0[0], p1[0]);
#pragma unroll
            for (int r = 1; r < 16; ++r) mx = fmaxf(mx, fmaxf(p0[r], p1[r]));
            mx = fmaxf(mx, __shfl_xor(mx, 32));
            const float mn = fmaxf(m, mx);
            if (__any(mn > m)) {
                const float al = __builtin_amdgcn_exp2f(m - mn); l *= al; m = mn;
                if (hi == 0) wsf[r32] = al;
                LDS_WAIT();
#pragma unroll
                for (int g = 0; g < 4; ++g) { const f32x4 a4 = *(const LAS f32x4*)(wsf + 8 * g + 4 * hi);
#pragma unroll
                    for (int d = 0; d < 4; ++d)
#pragma unroll
                        for (int e = 0; e < 4; ++e) o[d][4 * g + e] *= a4[e]; }
            }
            float ps = 0.f;
#pragma unroll
            for (int r = 0; r < 16; ++r) { p0[r] = __builtin_amdgcn_exp2f(p0[r] - m); p1[r] = __builtin_amdgcn_exp2f(p1[r] - m); ps += p0[r] + p1[r]; }
            l += ps;
            bf16x8 pa[4]; pa[0] = pack8(p0, 0); pa[1] = pack8(p0, 8); pa[2] = pack8(p1, 0); pa[3] = pack8(p1, 8);
            __builtin_amdgcn_s_setprio(1);
#pragma unroll
            for (int d = 0; d < 4; ++d)
#pragma unroll
                for (int ks = 0; ks < 4; ++ks) {
                    const bf16x8 bv = *(const LAS bf16x8*)(vb + (32 * d + r32) * VROW + ks * 32 + hi * 16);
                    o[d] = __builtin_amdgcn_mfma_f32_32x32x16_bf16(pa[ks], bv, o[d], 0, 0, 0);
                }
            __builtin_amdgcn_s_setprio(0);
        }
        if (it + 1 < NTP) ATT_STORE((it + 1) & 1);
        __syncthreads();
    }
#undef ATT_LOAD
#undef ATT_STORE
    l += __shfl_xor(l, 32);
    const float inv = (l > 0.f) ? 1.0f / l : 0.f;
    if (hi == 0) { wsf[r32] = inv; ST[((size_t)(b * SEQ) + q0 + r32) * MLA_H + h] = (f32x2){m, l}; }
    LDS_WAIT();
    bf16* ob = Odst + ((size_t)(b * SEQ) + q0) * opitch + h * VH + r32;
#pragma unroll
    for (int g = 0; g < 4; ++g) { const f32x4 a4 = *(const LAS f32x4*)(wsf + 8 * g + 4 * hi);
#pragma unroll
        for (int e = 0; e < 4; ++e) { const int row = crow(4 * g + e, hi);
#pragma unroll
            for (int d = 0; d < 4; ++d) ob[(size_t)row * opitch + 32 * d] = (bf16)f2bf(o[d][4 * g + e] * a4[e]); } }
    LDS_WAIT();
}
__device__ __forceinline__ void attn_merge_item(int item, bf16* Omix, const bf16* OTMP, const f32x2* ST, int lane) {
    const int t = item >> 1, h = (item & 1) * 4 + (lane >> 4), dd = (lane & 15) * 8;
    const f32x2 s0 = ST[(size_t)t * MLA_H + h], s1 = ST[(size_t)(T + t) * MLA_H + h];
    const float M = fmaxf(s0.x, s1.x);
    float w0 = s0.y * __builtin_amdgcn_exp2f(s0.x - M), w1 = s1.y * __builtin_amdgcn_exp2f(s1.x - M);
    const float inv = __builtin_amdgcn_rcpf(w0 + w1); w0 *= inv; w1 *= inv;
    bf16* op = Omix + (size_t)t * 2048 + h * VH + dd;
    const v4u a = *(const GAS v4u*)op, bq = *(const GAS v4u*)(OTMP + (size_t)t * 1024 + h * VH + dd);
    v4u o; o.x = pk2(w0 * bflo(a.x) + w1 * bflo(bq.x), w0 * bfhi(a.x) + w1 * bfhi(bq.x)); o.y = pk2(w0 * bflo(a.y) + w1 * bflo(bq.y), w0 * bfhi(a.y) + w1 * bfhi(bq.y));
    o.z = pk2(w0 * bflo(a.z) + w1 * bflo(bq.z), w0 * bfhi(a.z) + w1 * bfhi(bq.z)); o.w = pk2(w0 * bflo(a.w) + w1 * bflo(bq.w), w0 * bfhi(a.w) + w1 * bfhi(bq.w));
    *(GAS v4u*)op = o;
}
}

namespace ck {
constexpr int CH = 32, NCH = SEQ / CH;
constexpr int PCK = 72, PKC = 32, PCC = 32;
constexpr int O_AT = 0, O_BT = 4608, O_KT = 9216, O_RT = 13824;
constexpr int O_P0 = 0, O_PT0 = 2048, O_P1 = 4096, O_PT1 = 6144, O_TT0 = 8192, O_TT1 = 10240, O_MAK = 12288, O_MBRT = 14336, O_G1 = 16384;
constexpr int O_AT2 = 0, O_VKT = 4096;
constexpr int O_ATT = 18432, O_RTT = 22528, O_BBT = 26624, O_KBT = 30720, O_VC = 34816, O_GC = 38912;
constexpr int UNIT_LDS = 39424, UNITS_PER_WG = 4;
static_assert(O_GC + 256 <= UNIT_LDS && UNITS_PER_WG * UNIT_LDS <= LDSCTL_OFF, "chunk_pre LDS");
typedef float ck_f32x2 __attribute__((ext_vector_type(2))); typedef __bf16 ck_bf16x2 __attribute__((ext_vector_type(2)));
__device__ __forceinline__ unsigned cvt2(float lo, float hi) { ck_f32x2 v = {lo, hi}; ck_bf16x2 b = __builtin_convertvector(v, ck_bf16x2); return __builtin_bit_cast(unsigned, b); }
__device__ __forceinline__ int crow(int r, int hi) { return (r & 3) + 8 * (r >> 2) + 4 * hi; }
__device__ __forceinline__ void zero16(f32x16& a) {
#pragma unroll
    for (int r = 0; r < 16; ++r) a[r] = 0.f; }
template <int KD> __device__ __forceinline__ void mm(f32x16& acc, const LAS unsigned char* X, int px, int xr0, const LAS unsigned char* YT, int py, int yr0, int r32, int hi) {
#pragma unroll
    for (int ks = 0; ks < KD / 16; ++ks) {
        const bf16x8 a = *(const LAS bf16x8*)(X + ((xr0 + r32) * px + ks * 16 + 8 * hi) * 2);
        const bf16x8 b = *(const LAS bf16x8*)(YT + ((yr0 + r32) * py + ks * 16 + 8 * hi) * 2);
        acc = __builtin_amdgcn_mfma_f32_32x32x16_bf16(a, b, acc, 0, 0, 0);
    }
}
__device__ __forceinline__ void storeT(const f32x16& acc, LAS unsigned char* dst, int pd, int r0, int c0, int r32, int hi) {
#pragma unroll
    for (int g = 0; g < 4; ++g) { v2u w; w.x = cvt2(acc[4 * g], acc[4 * g + 1]); w.y = cvt2(acc[4 * g + 2], acc[4 * g + 3]);
        *(LAS v2u*)(dst + ((r0 + r32) * pd + c0 + 8 * g + 4 * hi) * 2) = w; }
}
__device__ __forceinline__ void storeTg(const f32x16& acc, bf16* dst, int pd, int r0, int c0, int r32, int hi) {
#pragma unroll
    for (int g = 0; g < 4; ++g) { v2u w; w.x = cvt2(acc[4 * g], acc[4 * g + 1]); w.y = cvt2(acc[4 * g + 2], acc[4 * g + 3]);
        *(GAS v2u*)(dst + (size_t)(r0 + r32) * pd + c0 + 8 * g + 4 * hi) = w; }
}
__device__ __forceinline__ bf16x8 idfrag(int ks, int r32, int hi) {
    bf16x8 f;
#pragma unroll
    for (int j = 0; j < 8; ++j) f[j] = (ks * 16 + 8 * hi + j == r32) ? (short)0x3F80 : (short)0;
    return f;
}

struct Bat { unsigned short zr[8], zk[8], zv[8], lw[8], la[8]; };
#define CKA_LOAD(B, zp_, lp_, tb) do { _Pragma("unroll") for (int i = 0; i < 8; ++i) { const bf16* z1 = (zp_) + (size_t)((tb) + i) * ZW; B.zr[i] = z1[Z_R]; B.zk[i] = z1[Z_K]; B.zv[i] = z1[Z_V]; \
            B.lw[i] = (lp_)[(size_t)((tb) + i) * LW]; B.la[i] = (lp_)[(size_t)((tb) + i) * LW + 1024]; } } while (0)
__device__ __forceinline__ void preload(int unit, const bf16* Z, const bf16* L, Bat& B0, Bat& B1, unsigned short& qr, unsigned short& qk, unsigned short& qv, int lane) {
    const int chain = unit >> 7, c = unit & 127, b = chain >> 4, h = chain & 15, ch = h * 64 + lane, t0 = b * SEQ + c * CH;
    const bf16* zp = Z + (size_t)t0 * ZW + ch; const bf16* lp = L + (size_t)t0 * LW + ch;
    qr = 0; qk = 0; qv = 0;
    if (c > 0) { qr = zp[Z_R - ZW]; qk = zp[Z_K - ZW]; qv = zp[Z_V - ZW]; }
    CKA_LOAD(B0, zp, lp, 0); CKA_LOAD(B1, zp, lp, 8);
}
__device__ __forceinline__ void chunk_pre(int unit, const bf16* Z, const bf16* L, const float* mu, const float* w0, const float* a0, const float* k_k, const float* k_a, const float* r_k,
                                          float* BONUS, bf16* TRT, unsigned* SLOT, bf16* RRT, bf16* G2T, bf16* VCG, LAS unsigned char* lds, int lane,
                                          Bat& B0, Bat& B1, unsigned short& qr, unsigned short& qk, unsigned short& qv, int nxt) {
    const int chain = unit >> 7, c = unit & 127, b = chain >> 4, h = chain & 15, ch = h * 64 + lane, r32 = lane & 31, hi = lane >> 5;
    const int t0 = b * SEQ + c * CH;
    LAS bf16* At = (LAS bf16*)(lds + O_AT); LAS bf16* Bt = (LAS bf16*)(lds + O_BT); LAS bf16* Kt = (LAS bf16*)(lds + O_KT); LAS bf16* Rt = (LAS bf16*)(lds + O_RT);
    LAS bf16* AtT = (LAS bf16*)(lds + O_ATT); LAS bf16* RtT = (LAS bf16*)(lds + O_RTT); LAS bf16* BbT = (LAS bf16*)(lds + O_BBT); LAS bf16* KbT = (LAS bf16*)(lds + O_KBT);
    LAS bf16* Vc = (LAS bf16*)(lds + O_VC);
    {
        const float mu_r = mu[ch], mu_k = mu[1024 + ch], mu_v = mu[2048 + ch], w0c = w0[ch], a0c = a0[ch], kkc = k_k[ch], kac = k_a[ch], rkc = r_k[ch];
        const bf16* zp = Z + (size_t)t0 * ZW + ch; const bf16* lp = L + (size_t)t0 * LW + ch;
        float pr = bf2f(qr), pk = bf2f(qk), pv = bf2f(qv);
        float gam = 1.0f, mybon = 0.f;
        unsigned aRow = (unsigned)(size_t)(At + lane), aCol = (unsigned)(size_t)(AtT + lane * PKC);
        asm volatile("" : "+v"(aRow), "+v"(aCol));
#define CK_W16(base, off, v) (*(LAS bf16*)(size_t)((base) + (unsigned)(off)) = (v))
#define CKA_PROC(B, tb) do { unsigned short at8[8], rt8[8], vv8[8]; \
        _Pragma("unroll") for (int hf = 0; hf < 2; ++hf) { float r4[4], dec4[4], a4[4], kk4[4], kp4[4], n24[4], bo4[4]; \
        _Pragma("unroll") for (int j = 0; j < 4; ++j) { const int i = 4 * hf + j; \
            const float rc = bf2f(B.zr[i]), kc = bf2f(B.zk[i]), vc = bf2f(B.zv[i]); \
            r4[j] = rc + (pr - rc) * mu_r; const float k_ = kc + (pk - kc) * mu_k; vv8[i] = (unsigned short)(cvt2(vc + (pv - vc) * mu_v, 0.f) & 0xffffu); \
            pr = rc; pk = kc; pv = vc; \
            dec4[j] = __builtin_amdgcn_exp2f(-0.8750612633917001f * sigmoidf_(w0c + bf2f(B.lw[i]))); \
            a4[j] = sigmoidf_(a0c + bf2f(B.la[i])); \
            kk4[j] = k_ * kkc; n24[j] = kk4[j] * kk4[j]; \
            kp4[j] = k_ * (1.0f + (a4[j] - 1.0f) * kac); bo4[j] = r4[j] * kp4[j] * rkc; } \
        _Pragma("unroll") for (int j = 0; j < 4; ++j) { n24[j] = wave_sum_dpp(n24[j]); bo4[j] = wave_sum_dpp(bo4[j]); }     \
        _Pragma("unroll") for (int j = 0; j < 4; ++j) { const int i = 4 * hf + j, t = (tb) + i; \
            const float kk = kk4[j] * __builtin_amdgcn_rsqf(fmaxf(n24[j], 1e-24f)); \
            mybon = (lane == t) ? bo4[j] : mybon; \
            const float gprev = gam; gam *= dec4[j]; const float ig = __builtin_amdgcn_rcpf(gam); \
            const unsigned ar = cvt2(-gprev * kk, gam * r4[j]), bk = cvt2(kk * a4[j] * ig, kp4[j] * ig); \
            at8[i] = (unsigned short)(ar & 0xffffu); rt8[i] = (unsigned short)(ar >> 16); \
            CK_W16(aRow, t * PCK * 2, at8[i]); \
            CK_W16(aRow, (O_BT - O_AT) + t * PCK * 2, (bf16)(bk & 0xffffu)); CK_W16(aRow, (O_KT - O_AT) + t * PCK * 2, (bf16)(bk >> 16)); \
            CK_W16(aRow, (O_RT - O_AT) + t * PCK * 2, rt8[i]); } } \
          \
        { v4u q_; q_.x = at8[0] | ((unsigned)at8[1] << 16); q_.y = at8[2] | ((unsigned)at8[3] << 16); q_.z = at8[4] | ((unsigned)at8[5] << 16); q_.w = at8[6] | ((unsigned)at8[7] << 16); \
          *(LAS v4u*)(size_t)(aCol + (unsigned)((tb) * 2)) = q_; \
          q_.x = rt8[0] | ((unsigned)rt8[1] << 16); q_.y = rt8[2] | ((unsigned)rt8[3] << 16); q_.z = rt8[4] | ((unsigned)rt8[5] << 16); q_.w = rt8[6] | ((unsigned)rt8[7] << 16); \
          *(LAS v4u*)(size_t)(aCol + (unsigned)((O_RTT - O_ATT) + (tb) * 2)) = q_; \
          q_.x = vv8[0] | ((unsigned)vv8[1] << 16); q_.y = vv8[2] | ((unsigned)vv8[3] << 16); q_.z = vv8[4] | ((unsigned)vv8[5] << 16); q_.w = vv8[6] | ((unsigned)vv8[7] << 16); \
          *(LAS v4u*)(size_t)(aCol + (unsigned)((O_VC - O_ATT) + (tb) * 2)) = q_; } } while (0)
        CKA_PROC(B0, 0); asm volatile("" ::: "memory"); CKA_LOAD(B0, zp, lp, 16); asm volatile("" ::: "memory");
        CKA_PROC(B1, 8); asm volatile("" ::: "memory"); CKA_LOAD(B1, zp, lp, 24); asm volatile("" ::: "memory");
        CKA_PROC(B0, 16); asm volatile("" ::: "memory"); CKA_PROC(B1, 24); asm volatile("" ::: "memory");
#undef CKA_PROC
#undef CK_W16
        if (lane < CH) BONUS[(size_t)(t0 + lane) * RH + h] = mybon;
        const float gcr = bf2f((bf16)(cvt2(gam, 0.f) & 0xffffu));
        ((LAS float*)(lds + O_GC))[lane] = gcr;
#pragma unroll
        for (int t = 0; t < CH; t += 8) { v4u qb, qk;
            qb.x = cvt2(bf2f(Bt[t * PCK + lane]) * gam, bf2f(Bt[(t + 1) * PCK + lane]) * gam); qb.y = cvt2(bf2f(Bt[(t + 2) * PCK + lane]) * gam, bf2f(Bt[(t + 3) * PCK + lane]) * gam);
            qb.z = cvt2(bf2f(Bt[(t + 4) * PCK + lane]) * gam, bf2f(Bt[(t + 5) * PCK + lane]) * gam); qb.w = cvt2(bf2f(Bt[(t + 6) * PCK + lane]) * gam, bf2f(Bt[(t + 7) * PCK + lane]) * gam);
            qk.x = cvt2(bf2f(Kt[t * PCK + lane]) * gam, bf2f(Kt[(t + 1) * PCK + lane]) * gam); qk.y = cvt2(bf2f(Kt[(t + 2) * PCK + lane]) * gam, bf2f(Kt[(t + 3) * PCK + lane]) * gam);
            qk.z = cvt2(bf2f(Kt[(t + 4) * PCK + lane]) * gam, bf2f(Kt[(t + 5) * PCK + lane]) * gam); qk.w = cvt2(bf2f(Kt[(t + 6) * PCK + lane]) * gam, bf2f(Kt[(t + 7) * PCK + lane]) * gam);
            *(LAS v4u*)(BbT + lane * PKC + t) = qb; *(LAS v4u*)(KbT + lane * PKC + t) = qk; }
    }
    f32x16 accM, accMT, accG2, accT, accMakT, accMbr;
    zero16(accM); zero16(accMT); zero16(accMakT); zero16(accMbr); zero16(accG2);
    mm<64>(accM, lds + O_BT, PCK, 0, lds + O_AT, PCK, 0, r32, hi);
    mm<64>(accMT, lds + O_AT, PCK, 0, lds + O_BT, PCK, 0, r32, hi);
    mm<64>(accMakT, lds + O_AT, PCK, 0, lds + O_KT, PCK, 0, r32, hi);
    mm<64>(accMbr, lds + O_BT, PCK, 0, lds + O_RT, PCK, 0, r32, hi);
    mm<64>(accG2, lds + O_KT, PCK, 0, lds + O_RT, PCK, 0, r32, hi);
#pragma unroll
    for (int r = 0; r < 16; ++r) { const int row = crow(r, hi);
        accM[r] = (row < r32) ? accM[r] : 0.f; accMT[r] = (r32 < row) ? accMT[r] : 0.f; accMakT[r] = (r32 < row) ? accMakT[r] : 0.f;
        accMbr[r] = (row <= r32) ? accMbr[r] : 0.f; accG2[r] = (row <= r32) ? accG2[r] : 0.f; }
    asm volatile("" : "+v"(accM), "+v"(accMT), "+v"(accMakT), "+v"(accMbr), "+v"(accG2));
    storeT(accMT, lds + O_P0, PCC, 0, 0, r32, hi);
    storeT(accM, lds + O_PT0, PCC, 0, 0, r32, hi);
    storeT(accMakT, lds + O_MAK, PCC, 0, 0, r32, hi);
    storeT(accMbr, lds + O_MBRT, PCC, 0, 0, r32, hi);
    accT = accM;
#pragma unroll
    for (int r = 0; r < 16; ++r) if (crow(r, hi) == r32) accT[r] += 1.0f;
    storeT(accT, lds + O_TT0, PCC, 0, 0, r32, hi);
    if (nxt >= 0) preload(nxt, Z, L, B0, B1, qr, qk, qv, lane);
    {   f32x16 aP, aPT;
        zero16(aP); zero16(aPT);
        mm<32>(aP, lds + O_P0, PCC, 0, lds + O_PT0, PCC, 0, r32, hi); mm<32>(aPT, lds + O_PT0, PCC, 0, lds + O_P0, PCC, 0, r32, hi);
        storeT(aPT, lds + O_P1, PCC, 0, 0, r32, hi); storeT(aP, lds + O_PT1, PCC, 0, 0, r32, hi);
        mm<32>(accT, lds + O_P1, PCC, 0, lds + O_TT0, PCC, 0, r32, hi); storeT(accT, lds + O_TT1, PCC, 0, 0, r32, hi);
        zero16(aP); zero16(aPT);
        mm<32>(aP, lds + O_P1, PCC, 0, lds + O_PT1, PCC, 0, r32, hi); mm<32>(aPT, lds + O_PT1, PCC, 0, lds + O_P1, PCC, 0, r32, hi);
        storeT(aPT, lds + O_P0, PCC, 0, 0, r32, hi); storeT(aP, lds + O_PT0, PCC, 0, 0, r32, hi);
        mm<32>(accT, lds + O_P0, PCC, 0, lds + O_TT1, PCC, 0, r32, hi); storeT(accT, lds + O_TT0, PCC, 0, 0, r32, hi);
        zero16(aP); zero16(aPT);
        mm<32>(aP, lds + O_P0, PCC, 0, lds + O_PT0, PCC, 0, r32, hi); mm<32>(aPT, lds + O_PT0, PCC, 0, lds + O_P0, PCC, 0, r32, hi);
        storeT(aPT, lds + O_P1, PCC, 0, 0, r32, hi); storeT(aP, lds + O_PT1, PCC, 0, 0, r32, hi);
        mm<32>(accT, lds + O_P1, PCC, 0, lds + O_TT0, PCC, 0, r32, hi); storeT(accT, lds + O_TT1, PCC, 0, 0, r32, hi);
        zero16(aPT);
        mm<32>(aPT, lds + O_PT1, PCC, 0, lds + O_P1, PCC, 0, r32, hi);
        storeT(aPT, lds + O_P0, PCC, 0, 0, r32, hi);
        mm<32>(accT, lds + O_P0, PCC, 0, lds + O_TT1, PCC, 0, r32, hi); storeT(accT, lds + O_TT0, PCC, 0, 0, r32, hi);
    }
    {   f32x16 acc; zero16(acc);
        mm<32>(acc, lds + O_TT0, PCC, 0, lds + O_MAK, PCC, 0, r32, hi);
        storeT(acc, lds + O_G1, PCC, 0, 0, r32, hi);
#pragma unroll
        for (int kb = 0; kb < 2; ++kb) { zero16(acc);
            mm<32>(acc, lds + O_TT0, PCC, 0, lds + O_ATT, PKC, 32 * kb, r32, hi);
            storeT(acc, lds + O_AT2, PKC, 32 * kb, 0, r32, hi); }
        mm<32>(accG2, lds + O_G1, PCC, 0, lds + O_MBRT, PCC, 0, r32, hi);
        storeTg(accG2, G2T + (size_t)unit * 1024, 32, 0, 0, r32, hi);
        const bf16x8 id0 = idfrag(0, r32, hi), id1 = idfrag(1, r32, hi);
#pragma unroll
        for (int kb = 0; kb < 2; ++kb) { zero16(acc);
            mm<32>(acc, lds + O_AT2, PKC, 32 * kb, lds + O_MBRT, PCC, 0, r32, hi);
            acc = __builtin_amdgcn_mfma_f32_32x32x16_bf16(*(const LAS bf16x8*)(lds + O_RTT + ((32 * kb + r32) * PKC + 8 * hi) * 2), id0, acc, 0, 0, 0);
            acc = __builtin_amdgcn_mfma_f32_32x32x16_bf16(*(const LAS bf16x8*)(lds + O_RTT + ((32 * kb + r32) * PKC + 16 + 8 * hi) * 2), id1, acc, 0, 0, 0);
            storeTg(acc, RRT + (size_t)unit * 2048, 64, 0, 32 * kb, r32, hi); }
        const float gcv0 = ((const LAS float*)(lds + O_GC))[r32], gcv1 = ((const LAS float*)(lds + O_GC))[32 + r32];
#pragma unroll
        for (int rb = 0; rb < 2; ++rb)
#pragma unroll
            for (int cb = 0; cb < 2; ++cb) { zero16(acc);
                mm<32>(acc, lds + O_AT2, PKC, 32 * rb, lds + O_BBT, PKC, 32 * cb, r32, hi);
                if (rb == cb) { const float gv = cb ? gcv1 : gcv0;
#pragma unroll
                    for (int r = 0; r < 16; ++r) if (crow(r, hi) == r32) acc[r] += gv; }
                storeTg(acc, TRT + (size_t)unit * 4096, 64, 32 * cb, 32 * rb, r32, hi); }
#pragma unroll
        for (int cb = 0; cb < 2; ++cb) { zero16(acc);
            mm<32>(acc, lds + O_G1, PCC, 0, lds + O_BBT, PKC, 32 * cb, r32, hi);
            acc = __builtin_amdgcn_mfma_f32_32x32x16_bf16(id0, *(const LAS bf16x8*)(lds + O_KBT + ((32 * cb + r32) * PKC + 8 * hi) * 2), acc, 0, 0, 0);
            acc = __builtin_amdgcn_mfma_f32_32x32x16_bf16(id1, *(const LAS bf16x8*)(lds + O_KBT + ((32 * cb + r32) * PKC + 16 + 8 * hi) * 2), acc, 0, 0, 0);
            storeT(acc, lds + O_VKT, PKC, 32 * cb, 0, r32, hi); }
#pragma unroll
        for (int vb = 0; vb < 2; ++vb)
#pragma unroll
            for (int kb = 0; kb < 2; ++kb) { zero16(acc);
                mm<32>(acc, lds + O_VKT, PKC, 32 * kb, lds + O_VC, PKC, 32 * vb, r32, hi);
                v4u q0, q1; q0.x = cvt2(acc[0], acc[1]); q0.y = cvt2(acc[2], acc[3]); q0.z = cvt2(acc[4], acc[5]); q0.w = cvt2(acc[6], acc[7]);
                q1.x = cvt2(acc[8], acc[9]); q1.y = cvt2(acc[10], acc[11]); q1.z = cvt2(acc[12], acc[13]); q1.w = cvt2(acc[14], acc[15]);
                GAS v4u* sl = (GAS v4u*)(SLOT + (size_t)unit * 2048 + ((vb * 2 + kb) * 64 + lane) * 8);
                sl[0] = q0; sl[1] = q1; }
        {   const LAS v4u* vs = (const LAS v4u*)(lds + O_VC + lane * PKC * 2);
            GAS v4u* vd = (GAS v4u*)(VCG + (size_t)unit * 2048 + lane * 32);
            vd[0] = vs[0]; vd[1] = vs[1]; vd[2] = vs[2]; vd[3] = vs[3]; }
    }
}

constexpr int CHN_SLOT = 17408, CHN_S = 2 * CHN_SLOT, CHN_PT = 72;
#define CHN_BAR() do { asm volatile("s_waitcnt lgkmcnt(0)" ::: "memory"); __builtin_amdgcn_s_barrier(); asm volatile("" ::: "memory"); } while (0)
__device__ __forceinline__ void rwkv_chain(int chain, const bf16* TRT, unsigned* SLOT, LAS unsigned char* lds, int tid) {
    const int lane = tid & 63, wv = __builtin_amdgcn_readfirstlane(tid >> 6), r32 = lane & 31, hi = lane >> 5;
    constexpr int NIT = NCH - 1;
    if (wv >= 2 && wv < 6) {
        const int lt = tid - 128;
        const unsigned char* gT = (const unsigned char*)(TRT + (size_t)chain * NCH * 4096);
        const unsigned char* gS = (const unsigned char*)(SLOT + (size_t)chain * NCH * 2048);
        const bool isT = lt < 128;
        const unsigned char* gsrc = isT ? gT + lt * 64 : gS + (lt - 128) * 64;
        const int ldst = isT ? ((lt >> 1) * (CHN_PT * 2) + (lt & 1) * 64) : (64 * CHN_PT * 2 + (lt - 128) * 64);
        struct Set { v4u q[4]; };
        Set R0, R1, R2, R3, R4, R5, R6, R7;
#define CH_RAW(R, c_) do { const int cc_ = ((c_) < NIT) ? (c_) : NIT - 1; const unsigned char* p_ = gsrc + (size_t)cc_ * 8192; \
        _Pragma("unroll") for (int i_ = 0; i_ < 4; ++i_) R.q[i_] = *(const GAS v4u*)(p_ + 16 * i_); } while (0)
#define CH_PUT(R, buf) do { LAS unsigned char* d_ = lds + (buf) * CHN_SLOT + ldst; \
        _Pragma("unroll") for (int i_ = 0; i_ < 4; ++i_) *(LAS v4u*)(d_ + 16 * i_) = R.q[i_]; } while (0)
#define CH_ITER(R, c_) do { CH_PUT(R, ((c_) + 1) & 1); CH_RAW(R, (c_) + 9); CHN_BAR(); } while (0)
        CH_RAW(R0, 0); CH_RAW(R1, 1); CH_RAW(R2, 2); CH_RAW(R3, 3); CH_RAW(R4, 4); CH_RAW(R5, 5); CH_RAW(R6, 6); CH_RAW(R7, 7);
        CH_PUT(R0, 0); CH_RAW(R0, 8);
        CHN_BAR();
        for (int c = 0; c + 7 < NIT; c += 8) { CH_ITER(R1, c); CH_ITER(R2, c + 1); CH_ITER(R3, c + 2); CH_ITER(R4, c + 3); CH_ITER(R5, c + 4); CH_ITER(R6, c + 5); CH_ITER(R7, c + 6); CH_ITER(R0, c + 7); }
        CH_ITER(R1, 120); CH_ITER(R2, 121); CH_ITER(R3, 122); CH_ITER(R4, 123); CH_ITER(R5, 124); CH_ITER(R6, 125); CH_ITER(R7, 126);
#undef CH_RAW
#undef CH_PUT
#undef CH_ITER
    } else if (wv < 2) {
        const int vb = wv;
        LAS unsigned char* sl = lds + CHN_S + vb * (32 * CHN_PT * 2);
        for (int i = lane; i < 32 * CHN_PT / 2; i += 64) ((LAS unsigned*)sl)[i] = 0u;
        CHN_BAR();
        for (int c = 0; c < NIT; ++c) {
            const LAS unsigned char* bs = lds + (c & 1) * CHN_SLOT;
            bf16x8 sfr[4];
#pragma unroll
            for (int ks = 0; ks < 4; ++ks) sfr[ks] = *(const LAS bf16x8*)(sl + (r32 * CHN_PT + 16 * ks + 8 * hi) * 2);
            bf16* sg = (bf16*)(SLOT + ((size_t)chain * NCH + c) * 2048 + vb * 1024);
            f32x16 acc[2]; bf16x8 tr[2][4];
#pragma unroll
            for (int kb = 0; kb < 2; ++kb) {
                const LAS v4u* wp = (const LAS v4u*)(bs + 64 * CHN_PT * 2 + ((vb * 2 + kb) * 64 + lane) * 32);
                const v4u w0 = wp[0], w1 = wp[1];
                acc[kb][0] = bflo(w0.x); acc[kb][1] = bfhi(w0.x); acc[kb][2] = bflo(w0.y); acc[kb][3] = bfhi(w0.y); acc[kb][4] = bflo(w0.z); acc[kb][5] = bfhi(w0.z); acc[kb][6] = bflo(w0.w); acc[kb][7] = bfhi(w0.w);
                acc[kb][8] = bflo(w1.x); acc[kb][9] = bfhi(w1.x); acc[kb][10] = bflo(w1.y); acc[kb][11] = bfhi(w1.y); acc[kb][12] = bflo(w1.z); acc[kb][13] = bfhi(w1.z); acc[kb][14] = bflo(w1.w); acc[kb][15] = bfhi(w1.w);
#pragma unroll
                for (int ks = 0; ks < 4; ++ks) tr[kb][ks] = *(const LAS bf16x8*)(bs + ((32 * kb + r32) * CHN_PT + 16 * ks + 8 * hi) * 2);
            }
#pragma unroll
            for (int ks = 0; ks < 4; ++ks) {
                acc[0] = __builtin_amdgcn_mfma_f32_32x32x16_bf16(tr[0][ks], sfr[ks], acc[0], 0, 0, 0);
                acc[1] = __builtin_amdgcn_mfma_f32_32x32x16_bf16(tr[1][ks], sfr[ks], acc[1], 0, 0, 0); }
#pragma unroll
            for (int kb = 0; kb < 2; ++kb) { storeT(acc[kb], sl, CHN_PT, 0, 32 * kb, r32, hi); storeTg(acc[kb], sg, 64, 0, 32 * kb, r32, hi); }
            CHN_BAR();
        }
    } else {
        for (int c = 0; c < NIT + 1; ++c) CHN_BAR();
    }
}

#undef CHN_BAR
__device__ __forceinline__ void rwkv_out_item(int unit, const unsigned* SLOT, const bf16* RRT, const bf16* G2T, const bf16* VCG, const float* BONUS, const bf16* Z, const bf16* L,
                                              const float* mu, const float* lnw, const float* lnb, bf16* Omix, int lane) {
    const int chain = unit >> 7, c = unit & 127, b = chain >> 4, h = chain & 15, r32 = lane & 31, hi = lane >> 5;
    const int t = b * SEQ + c * CH + r32;
    f32x16 o[2]; zero16(o[0]); zero16(o[1]);
    if (c > 0) {
        bf16x8 rr[4];
#pragma unroll
        for (int ks = 0; ks < 4; ++ks) rr[ks] = *(const GAS bf16x8*)(RRT + (size_t)unit * 2048 + r32 * 64 + 16 * ks + 8 * hi);
#pragma unroll
        for (int vb = 0; vb < 2; ++vb) { const bf16* sg = (const bf16*)(SLOT + (size_t)(unit - 1) * 2048 + vb * 1024);
#pragma unroll
            for (int ks = 0; ks < 4; ++ks) o[vb] = __builtin_amdgcn_mfma_f32_32x32x16_bf16(*(const GAS bf16x8*)(sg + r32 * 64 + 16 * ks + 8 * hi), rr[ks], o[vb], 0, 0, 0); }
    }
    {   bf16x8 g2[2];
#pragma unroll
        for (int ks = 0; ks < 2; ++ks) g2[ks] = *(const GAS bf16x8*)(G2T + (size_t)unit * 1024 + r32 * 32 + 16 * ks + 8 * hi);
#pragma unroll
        for (int vb = 0; vb < 2; ++vb)
#pragma unroll
            for (int ks = 0; ks < 2; ++ks) o[vb] = __builtin_amdgcn_mfma_f32_32x32x16_bf16(*(const GAS bf16x8*)(VCG + (size_t)unit * 2048 + (32 * vb + r32) * 32 + 16 * ks + 8 * hi), g2[ks], o[vb], 0, 0, 0);
    }
    float s = 0.f;
#pragma unroll
    for (int r = 0; r < 16; ++r) s += o[0][r] + o[1][r];
    s += __shfl_xor(s, 32);
    const float mean = s * (1.f / 64.f); float q = 0.f;
#pragma unroll
    for (int r = 0; r < 16; ++r) { o[0][r] -= mean; o[1][r] -= mean; q += o[0][r] * o[0][r] + o[1][r] * o[1][r]; }
    q += __shfl_xor(q, 32);
    const float rstd = __builtin_amdgcn_rsqf(q * (1.f / 64.f) + GN_EPS);
    const float bon = BONUS[(size_t)t * RH + h];
    const bool first = (t % SEQ) == 0;
#pragma unroll
    for (int vb = 0; vb < 2; ++vb)
#pragma unroll
        for (int g = 0; g < 4; ++g) { const int c4 = h * 64 + 32 * vb + 8 * g + 4 * hi;
            const f32x4 lw4 = *(const GAS f32x4*)(lnw + c4), lb4 = *(const GAS f32x4*)(lnb + c4), mu4 = *(const GAS f32x4*)(mu + 2048 + c4);
            const v2u vcw = *(const GAS v2u*)(Z + (size_t)t * ZW + Z_V + c4);
            v2u vpw = {0u, 0u}; if (!first) vpw = *(const GAS v2u*)(Z + (size_t)t * ZW - ZW + Z_V + c4);
            const v2u gw = *(const GAS v2u*)(L + (size_t)t * LW + 2048 + c4);
            const float vc[4] = {bflo(vcw.x), bfhi(vcw.x), bflo(vcw.y), bfhi(vcw.y)}, vp[4] = {bflo(vpw.x), bfhi(vpw.x), bflo(vpw.y), bfhi(vpw.y)}, gg[4] = {bflo(gw.x), bfhi(gw.x), bflo(gw.y), bfhi(gw.y)};
            float y[4];
#pragma unroll
            for (int e = 0; e < 4; ++e) { const float v = vc[e] + (vp[e] - vc[e]) * mu4[e]; y[e] = (o[vb][4 * g + e] * rstd * lw4[e] + lb4[e] + bon * v) * gg[e]; }
            v2u ow; ow.x = pk2(y[0], y[1]); ow.y = pk2(y[2], y[3]);
            *(GAS v2u*)(Omix + (size_t)t * 2048 + 1024 + c4) = ow; }
}
}


#define WIN ((bf16*)(ws + WS_WIN))
#define WKPE ((bf16*)(ws + WS_WKPE))
#define KPEP ((float*)(ws + WS_KPEP))
#define WQB ((bf16*)(ws + WS_WQB))
#define WKVB ((bf16*)(ws + WS_WKVB))
#define WLORA ((bf16*)(ws + WS_WLORA))
#define WOUT ((bf16*)(ws + WS_WOUT))
#define WPG ((bf16*)(ws + WS_WPG))
#define WPP ((bf16*)(ws + WS_WPP))
#define WGU ((bf16*)(ws + WS_WGU))
#define WD ((bf16*)(ws + WS_WD))
#define WD2 ((bf16*)(ws + WS_WD2))
#define H ((bf16*)(ws + WS_H))
#define U ((bf16*)(ws + WS_U))
#define Zb ((bf16*)(ws + WS_Z))
#define AQ ((bf16*)(ws + WS_AQ))
#define AKV ((bf16*)(ws + WS_AKV))
#define AL ((bf16*)(ws + WS_AL))
#define QRAW ((bf16*)(ws + WS_QRAW))
#define KVRAW ((bf16*)(ws + WS_KVRAW))
#define LORA ((bf16*)(ws + WS_LORA))
#define QH ((bf16*)(ws + WS_QH))
#define KH ((bf16*)(ws + WS_KH))
#define VT ((bf16*)(ws + WS_VT))
#define OMIX ((bf16*)(ws + WS_OMIX))
#define TRT ((bf16*)(ws + WS_TRT))
#define OTMP ((bf16*)(ws + WS_OTMP))
#define AST ((f32x2*)(ws + WS_AST))
#define SLOT ((unsigned*)(ws + WS_SLOT))
#define RRT ((bf16*)out)
#define G2T ((bf16*)out + (size_t)8 * 1024 * 1024)
#define VCG ((bf16*)(ws + WS_VCG))
#define BONUS ((float*)(ws + WS_BONUS))
#define PB ((bf16*)(ws + WS_PB))
#define PPLE ((float*)(ws + WS_PPLE))
#define ROPE ((f32x2*)(ws + WS_ROPE))
#define SS0 ((float*)(ws + WS_CTL) + CW_SS)
#define SS1 (SS0 + T)
#define SS2 (SS0 + 2 * T)
#define SS3 (SS0 + 3 * T)
__global__ void __launch_bounds__(NTHR, 2) mk_fwd(Args args) {
    extern __shared__ __attribute__((aligned(16))) unsigned char lds_raw[];
    LAS unsigned char* lds = (LAS unsigned char*)lds_raw;
    volatile LAS unsigned* MISC = (volatile LAS unsigned*)(lds + MISC_OFF);
    const int tid = threadIdx.x, lane = tid & 63, wave = __builtin_amdgcn_readfirstlane(tid >> 6);
    const int G = gridDim.x, bx = blockIdx.x, vcu = (G % 8 == 0) ? (bx % 8) * (G / 8) + bx / 8 : bx;
    unsigned char* ws = args.ws;
    gu32* ctl = (gu32*)(ws + WS_CTL);
    for (int u = tid; u < (LDS_BYTES - LDSCTL_OFF) / 4; u += NTHR) ((LAS unsigned*)(lds + LDSCTL_OFF))[u] = 0u;
    __syncthreads();
    XcdBarrier bar; bar.bar = (unsigned*)(ctl + CW_BAR); bar.x = 0; bar.st = nullptr;
    if (N_LAUNCHES == 1) bar = xcd_barrier_post((unsigned*)(ctl + CW_BAR), MISC + 8);
#define GRID_BAR() do { if (N_LAUNCHES == 1) xcd_barrier(bar); } while (0)
    const int lo = args.ph_lo, hi = args.ph_hi;
#define IN(k) (lo <= (k) && (k) < hi)
#define BOTH(k) (IN(k) && IN((k) + 1))
    const int gw = vcu * NWAVES + wave, NGW = G * NWAVES;
    const float* x = args.in[0]; float* out = args.out;
    LAS float* scr = (LAS float*)(lds + RING_OFF + wave * 16384);

    if (IN(0)) {
        int base = 0;
        run_job(mk_job(args.in[3], args.in[4], args.in[2], WGU, DM, FF, 2 * FF, DM, 0, 1), gw, NGW, base, scr, lane);
        run_job(mk_job(args.in[7], nullptr, args.in[6], WIN, DM, ZW, ZW, DM, 0, 0, 4160, 0, 768, 64), gw, NGW, base, scr, lane);
        run_job(mk_job(args.in[7], nullptr, args.in[6], WKPE, DM, 64, 256, DM, 0, 0, 4160, 768), gw, NGW, base, scr, lane);
        run_job(mk_job(args.in[5], nullptr, nullptr, WD, FF, DM, DM, FF, 0, 0), gw, NGW, base, scr, lane);
        for (int e = gw * 64 + lane; e < SEQ * 32; e += NGW * 64) { const int s = e >> 5, i = e & 31;
            const float inv_freq = __builtin_amdgcn_exp2f(-(float)i * (13.287712379549449f / 32.0f));
            float rev = ((float)s * inv_freq) * 0.15915494309189535f; rev -= floorf(rev);
            f32x2 cs; cs.x = __builtin_amdgcn_cosf(rev); cs.y = __builtin_amdgcn_sinf(rev); ROPE[e] = cs; }
        xb_pass(x, H, SS0, gw, NGW, lane);
        if (BOTH(0)) GRID_BAR();
    }
    if (IN(1)) {
        pg8::Gemm g{H, WGU, T, 2 * FF, DM}; pg8::StaticOrder S; S.init(T, 2 * FF, G, bx);
        pg8::EpiSwiGLU E{U, FF, SS0};
        pg8::gemm_phase<pg8::EpiSwiGLU, pg8::StaticOrder, true, true>(lds + RING_OFF, g, S, E);
        if (bx >= (G >> 1)) { int base = 0;
            const int gw2 = (bx - (G >> 1)) * NWAVES + wave, ngw2 = (G - (G >> 1)) * NWAVES;
            run_job(mk_job(args.in[25], nullptr, nullptr, WOUT, DM, DM, DM, DM, 0, 0), gw2, ngw2, base, scr, lane);
            run_job(mk_job(args.in[31], nullptr, args.in[30], WPG, DM, DM, DM, DM, 0, 0), gw2, ngw2, base, scr, lane);
            run_job(mk_job(args.in[9], nullptr, args.in[8], WQB, QL, 1536, 1536, QL, 0, 0), gw2, ngw2, base, scr, lane);
            run_job(mk_job(args.in[11], nullptr, args.in[10], WKVB, KVL, 2048, 2048, KVL, 0, 0), gw2, ngw2, base, scr, lane);
            run_job(mk_job(args.in[16], nullptr, nullptr, WLORA, 64, 1024, 1024, 256, 0, 0), gw2, ngw2, base, scr, lane);
            run_job(mk_job(args.in[18], nullptr, nullptr, WLORA + (size_t)1024 * 256, 64, 1024, 1024, 256, 64, 0), gw2, ngw2, base, scr, lane);
            run_job(mk_job(args.in[19], nullptr, nullptr, WLORA + (size_t)2048 * 256, 128, 1024, 1024, 256, 128, 0), gw2, ngw2, base, scr, lane);
            run_job(mk_job(args.in[32], nullptr, nullptr, WPP, PLE, DM, DM, PLE, 0, 0), gw2, ngw2, base, scr, lane);
            { const float* p = args.in[1];
              for (int e = gw2 * 64 + lane; e < T * PLE / 4; e += ngw2 * 64) { const f32x4 v = *(const GAS f32x4*)(p + (size_t)e * 4); v2u o; o.x = pk2(v.x, v.y); o.y = pk2(v.z, v.w); *(GAS v2u*)(PB + (size_t)e * 4) = o; } }
 }
        if (BOTH(1)) GRID_BAR();
    }
    if (IN(2)) {
        pg8::Gemm g{U, WD, T, DM, FF}; pg8::StaticOrder S; S.init(T, DM, G, bx);
        pg8::EpiRes<false> E{x, DM, 0.5f, H, SS1};
        pg8::gemm_phase<pg8::EpiRes<false>, pg8::StaticOrder, false, true>(lds + RING_OFF, g, S, E);
        if (IN(2) && IN(4)) GRID_BAR();
    }
    if (IN(4)) {
        pg8::Gemm g{H, WIN, T, ZW, DM}; pg8::StaticOrder S; S.init(T, ZW, G, bx);
        pg8::EpiBf16 E{Zb, ZW, SS1};
        pg8::gemm_phase<pg8::EpiBf16, pg8::StaticOrder, true, true>(lds + RING_OFF, g, S, E);
        if (BOTH(4)) GRID_BAR();
    }
    if (IN(5)) {
        for (int t = gw; t < T; t += NGW) prep_a_row(t, Zb, args.in[14], AQ, AKV, AL, lane);
        if (BOTH(5)) GRID_BAR();
    }
    if (IN(6)) {
        {   pg8::Gemm g{AQ, WQB, T, 1536, QL}; pg8::StaticOrder S; S.init(T, 1536, G, bx); pg8::EpiBf16 E{QRAW, 1536, nullptr};
            pg8::gemm_phase<pg8::EpiBf16, pg8::StaticOrder, true, true>(lds + RING_OFF, g, S, E); }
        {   pg8::Gemm g{AKV, WKVB, T, 2048, KVL}; pg8::StaticOrder S; S.init(T, 2048, G, (bx + 192) % G); pg8::EpiBf16 E{KVRAW, 2048, nullptr};
            pg8::gemm_phase<pg8::EpiBf16, pg8::StaticOrder, true, true>(lds + RING_OFF, g, S, E); }
        {   pg8::Gemm g{AL, WLORA, T, LW, 256}; pg8::StaticOrder S; S.init(T, LW, G, (bx + 64) % G); pg8::EpiBf16 E{LORA, LW, nullptr};
            pg8::gemm_phase<pg8::EpiBf16, pg8::StaticOrder, true, true>(lds + RING_OFF, g, S, E); }
        __syncthreads();
        for (int task = (vcu + 64) % G; task < T / 32; task += G) kpe_task(task, H, WKPE, SS1, KPEP, lds, tid);
        if (BOTH(6)) GRID_BAR();
    }
    if (IN(7)) {
        if (wave < ck::UNITS_PER_WG) {
            ck::Bat B0, B1; unsigned short qr, qk, qv; const int NU = 32 * ck::NCH, st = ck::UNITS_PER_WG * G; int u = vcu * ck::UNITS_PER_WG + wave;
            if (u < NU) ck::preload(u, Zb, LORA, B0, B1, qr, qk, qv, lane);
            for (; u < NU; u += st)
                ck::chunk_pre(u, Zb, LORA, args.in[14], args.in[15], args.in[17], args.in[20], args.in[21], args.in[22], BONUS, TRT, SLOT, RRT, G2T, VCG, lds + wave * ck::UNIT_LDS, lane,
                              B0, B1, qr, qk, qv, (u + st < NU) ? u + st : -1);
        } else {
            const int nmw = NWAVES - ck::UNITS_PER_WG;
            for (int task = vcu * nmw + (wave - ck::UNITS_PER_WG); task < 16 * 64 * 8; task += G * nmw)
                mla_prep_task(task, QRAW, KVRAW, args.in[12], args.in[13], ROPE, QH, KH, VT, lane, KPEP);
        }
        if (BOTH(7)) GRID_BAR();
    }
    if (IN(8)) {
        for (int rep = 0; rep < REP(8); ++rep) {
        if (vcu < 32) { ck::rwkv_chain(vcu, TRT, SLOT, lds, tid); __syncthreads(); }
        for (;;) {
            if (tid == 0) MISC[16] = __hip_atomic_fetch_add(ctl + CW_QUEUE + 64 * rep, 1u, RLX_AGENT);
            __syncthreads();
            const unsigned idx = MISC[16];
            __syncthreads();
            if (idx >= 512u) break;
            { const int part = (int)((idx >> 4) & 1u);
              att::attn_unit((int)(idx & 15u), 15 - (int)(idx >> 5), part, QH, KH, VT, part ? OTMP : OMIX, part ? 1024 : 2048, AST + (size_t)part * T * MLA_H, lds); }
        }
        }
        if (BOTH(8)) GRID_BAR();
    }
    if (IN(9)) {
        { int base = 0;
          run_job(mk_job(args.in[27], args.in[28], args.in[26], WGU, DM, FF, 8192, DM, 0, 1, 0, 0, 1 << 30, 0, 0), gw, NGW, base, scr, lane); }
        for (int it = gw; it < T * 2; it += NGW) att::attn_merge_item(it, OMIX, OTMP, AST, lane);
        for (int u = gw; u < 32 * ck::NCH; u += NGW) ck::rwkv_out_item(u, SLOT, RRT, G2T, VCG, BONUS, Zb, LORA, args.in[14], args.in[23], args.in[24], OMIX, lane);
        if (BOTH(9)) GRID_BAR();
    }
    if (IN(10)) {
        { int base = 0;
          run_job(mk_job(args.in[27], args.in[28], args.in[26], WGU, DM, FF, 2 * FF - 8192, DM, 0, 1, 0, 0, 1 << 30, 0, 8192), gw, NGW, base, scr, lane);
          run_job(mk_job(args.in[29], nullptr, nullptr, WD2, FF, DM, 1024, FF, 0, 0, 0, 0, 1 << 30, 0, 0), gw, NGW, base, scr, lane); }
        __syncthreads();
        pg8::Gemm g{OMIX, WOUT, T, DM, DM}; pg8::StaticOrder S; S.init(T, DM, G, bx);
        pg8::EpiRes<true> E{nullptr, DM, 1.0f, H, SS2};
        pg8::gemm_phase<pg8::EpiRes<true>, pg8::StaticOrder, false, true>(lds + RING_OFF, g, S, E);
        if (IN(10) && IN(12)) GRID_BAR();
    }
    if (IN(12)) {
        pg8::Gemm g{H, WGU, T, 2 * FF, DM}; pg8::StaticOrder S; S.init(T, 2 * FF, G, bx);
        pg8::EpiSwiGLU E{U, FF, SS2};
        pg8::gemm_phase<pg8::EpiSwiGLU, pg8::StaticOrder, true, true>(lds + RING_OFF, g, S, E);
        if (bx >= (G >> 1)) { int base = 0; const int hg = G >> 1;
            run_job(mk_job(args.in[29], nullptr, nullptr, WD2, FF, DM, 1024, FF, 0, 0, 0, 0, 1 << 30, 0, 1024), (bx - hg) * NWAVES + wave, (G - hg) * NWAVES, base, scr, lane);
            __syncthreads();
            pg8::Gemm g2{PB, WPP, T, DM, PLE}; pg8::StaticOrder S2; S2.init(T, DM, G - hg, bx - hg); pg8::EpiBf16NP E2{(pg8::bf16_t*)PPLE, DM};
            pg8::gemm_phase<pg8::EpiBf16NP, pg8::StaticOrder, true, true>(lds + RING_OFF, g2, S2, E2); }
        if (BOTH(12)) GRID_BAR();
    }
    if (IN(13)) {
        pg8::Gemm g{U, WD2, T, DM, FF}; pg8::StaticOrder S; S.init(T, DM, G, bx);
        pg8::EpiRes<true> E{nullptr, DM, 0.5f, H, SS3};
        pg8::gemm_phase<pg8::EpiRes<true>, pg8::StaticOrder, false, true>(lds + RING_OFF, g, S, E);
        if (IN(13) && IN(15)) GRID_BAR();
    }
    if (IN(15)) {
        {   pg8::Gemm g{H, WPG, T, DM, DM}; pg8::StaticOrder S; S.init(T, DM, G, bx); pg8::EpiPle E{H, (const pg8::bf16_t*)PPLE, out, DM, SS3};
            pg8::gemm_phase<pg8::EpiPle, pg8::StaticOrder, false, true>(lds + RING_OFF, g, S, E); }
    }
#undef IN
#undef BOTH
#undef GRID_BAR
}

extern "C" void kernel_launch(void* const* d_in, const int* in_sizes, int n_in, void* d_out, int out_size, void* d_ws, size_t ws_size, hipStream_t stream) {
    static int grid = 0;
    if (grid == 0) {
        if (n_in != 33 || out_size != T * DM || ws_size < WS_END) { fprintf(stderr, "kernel_launch: unexpected shapes (n_in %d, out %d, ws %zu, need %zu)\n", n_in, out_size, ws_size, (size_t)WS_END); grid = -1; return; }
        int dev = 0, cus = 0, per_cu = 0;
        if (hipGetDevice(&dev) != hipSuccess || hipDeviceGetAttribute(&cus, hipDeviceAttributeMultiprocessorCount, dev) != hipSuccess) { grid = -1; return; }
        if (hipFuncSetAttribute((const void*)mk_fwd, hipFuncAttributeMaxDynamicSharedMemorySize, LDS_BYTES) != hipSuccess) { fprintf(stderr, "kernel_launch: hipFuncSetAttribute failed\n"); grid = -1; return; }
        if (hipOccupancyMaxActiveBlocksPerMultiprocessor(&per_cu, (const void*)mk_fwd, NTHR, LDS_BYTES) != hipSuccess || per_cu < 1) { fprintf(stderr, "kernel_launch: occupancy query says %d blocks per CU\n", per_cu); (void)hipGetLastError(); grid = -1; return; }
        grid = cus;
        fprintf(stderr, "kernel_launch: grid %d, per_cu %d, ws %zu\n", grid, per_cu, ws_size);
    }
    if (grid < 0) return;
    (void)hipMemsetAsync((char*)d_ws + WS_CTL, 0, CTL_ZERO_BYTES, stream);
    Args a{};
    for (int i = 0; i < 33; ++i) a.in[i] = (const float*)d_in[i];
    a.out = (float*)d_out; a.ws = (unsigned char*)d_ws;
    for (int li = 0; li < N_LAUNCHES; ++li) {
        a.ph_lo = (N_LAUNCHES == 1) ? 0 : li; a.ph_hi = (N_LAUNCHES == 1) ? NPH : li + 1;
        hipLaunchKernelGGL(mk_fwd, dim3(grid), dim3(NTHR), LDS_BYTES, stream, a);
    }
}
```

```cpp
#include <hip/hip_runtime.h>
#include <cstdio>
#include <cstdint>
namespace pg8 {
#define PG8_LAS __attribute__((address_space(3)))
typedef unsigned short bf16_t;
typedef short bf16x8 __attribute__((ext_vector_type(8)));
typedef float f32x4 __attribute__((ext_vector_type(4)));
typedef unsigned u32x4 __attribute__((ext_vector_type(4)));
typedef unsigned u32x2 __attribute__((ext_vector_type(2)));
constexpr int BM = 256, BK = 64, HALF = 128, HTB = HALF * BK * 2  , STAGE_BYTES = 8 * HTB, NXCD = 8, WGM = 8;

__host__ __device__ __forceinline__ int lds_byte(int r, int c) { const int st = (r >> 4) * 2 + (c >> 5), rr = r & 15, cc = c & 31, ob = rr * 64 + cc * 2; return st * 1024 + (ob ^ (((ob >> 9) & 1) << 5)); }
__host__ __device__ __forceinline__ void stage_rc(int b, int& R, int& C) { const int st = b / 1024, sb = b % 1024, swz = sb ^ (((sb >> 9) & 1) << 5); R = (st >> 1) * 16 + swz / 64; C = (st & 1) * 32 + (swz % 64) / 2; }
__host__ __device__ __forceinline__ int perm32(int rho) { const int n = rho >> 4, i = rho & 15; return 8 * (i >> 2) + 4 * n + (i & 3); }

struct Unit { int pm, pn; };
struct Gemm { const bf16_t* A; const bf16_t* Bt; int M, N, K; int ld; size_t kofs; };

struct StaticOrder {
    int nM, nN, nwg, G, c;
    __host__ __device__ void init(int M, int N, int G_, int c_) { nM = M / BM; nN = N / BM; nwg = nM * nN; G = G_; c = c_; }
    __host__ __device__ bool next(int i, Unit& u) const {
        const long L = (long)i * G + c; if (L >= nwg) return false;
        int wgid = (int)L; { const int q = nwg / NXCD, r = nwg % NXCD, xcd = wgid % NXCD, off = wgid / NXCD; wgid = (xcd < r ? xcd * (q + 1) : r * (q + 1) + (xcd - r) * q) + off; }
        const int nig = WGM * nN, gid = wgid / nig, fm = gid * WGM, gsz = (nM - fm) < WGM ? (nM - fm) : WGM;
        u.pm = fm + ((wgid % nig) % gsz); u.pn = (wgid % nig) / gsz; return true;
    }
    __device__ __forceinline__ void a_ready(const Unit&) const {}
    __device__ __forceinline__ void done(const Unit&) const {}
};


__device__ __forceinline__ unsigned cvt_pk_bf16(float lo, float hi) { unsigned r; asm volatile("v_cvt_pk_bf16_f32 %0, %1, %2" : "=v"(r) : "v"(lo), "v"(hi)); return r; }
__device__ __forceinline__ float fast_sigmoid(float x) { return __builtin_amdgcn_rcpf(1.0f + __builtin_amdgcn_exp2f(-1.4426950408889634f * x)); }

__device__ __forceinline__ float row_rstd(const float* ss, int row) { return ss ? __builtin_amdgcn_rsqf(ss[row] * (1.0f / 2048.0f) + 1e-6f) : 1.0f; }
__device__ __forceinline__ void pf_rows_lds(PG8_LAS unsigned char* slot, const float* ss, int rowbase, int lane) {
    if (ss) { const float* src = ss + rowbase + lane;
        __builtin_amdgcn_global_load_lds((const unsigned*)src, (PG8_LAS unsigned*)slot, 4, 0, 0);
        __builtin_amdgcn_global_load_lds((const unsigned*)(src + HALF), (PG8_LAS unsigned*)(slot + 256), 4, 0, 0); }
}
__device__ __forceinline__ void rstd8_lds(float (&rs8)[2][4], const PG8_LAS unsigned char* slot, const float* ss, int fr) {
    if (ss) {
#pragma unroll
        for (int ai = 0; ai < 2; ++ai)
#pragma unroll
            for (int m = 0; m < 4; ++m) rs8[ai][m] = *(const PG8_LAS float*)(slot + ai * 256 + (m * 16 + fr) * 4);
#pragma unroll
        for (int ai = 0; ai < 2; ++ai)
#pragma unroll
            for (int m = 0; m < 4; ++m) rs8[ai][m] = __builtin_amdgcn_rsqf(rs8[ai][m] * (1.0f / 2048.0f) + 1e-6f);
    } else {
#pragma unroll
        for (int ai = 0; ai < 2; ++ai)
#pragma unroll
            for (int m = 0; m < 4; ++m) rs8[ai][m] = 1.0f;
    }
}
__device__ __forceinline__ void load_rstd8(float (&rs8)[2][4], const float* ss, int row0) {
    if (ss) {
#pragma unroll
        for (int ai = 0; ai < 2; ++ai)
#pragma unroll
            for (int m = 0; m < 4; ++m) rs8[ai][m] = ss[row0 + ai * HALF + m * 16];
#pragma unroll
        for (int ai = 0; ai < 2; ++ai)
#pragma unroll
            for (int m = 0; m < 4; ++m) rs8[ai][m] = __builtin_amdgcn_rsqf(rs8[ai][m] * (1.0f / 2048.0f) + 1e-6f);
    } else {
#pragma unroll
        for (int ai = 0; ai < 2; ++ai)
#pragma unroll
            for (int m = 0; m < 4; ++m) rs8[ai][m] = 1.0f;
    }
}
struct EpiBf16 {
    static constexpr bool PERM = true, AFTER_DRAIN = false, PF = true;
    bf16_t* O; int ldc; const float* ss;
    __device__ __forceinline__ void prefetch(PG8_LAS unsigned char* slot, const Unit& u, int wr, int lane) const { pf_rows_lds(slot, ss, u.pm * BM + wr * 64, lane); }
    __device__ __forceinline__ void operator()(const f32x4 (&acc)[2][2][4][2], const Unit& u, int wr, int wc, int fr, int fq, const PG8_LAS unsigned char* slot) const {
        const int row0 = u.pm * BM + wr * 64 + fr, col0 = u.pn * BM + wc * 32 + 8 * fq;
        float rs8[2][4];
        rstd8_lds(rs8, slot, ss, fr);
#pragma unroll
        for (int ai = 0; ai < 2; ++ai)
#pragma unroll
            for (int m = 0; m < 4; ++m) { const int row = row0 + ai * HALF + m * 16; const float rs = rs8[ai][m]; bf16_t* rowp = O + (size_t)row * ldc + col0;
#pragma unroll
                for (int bj = 0; bj < 2; ++bj) { const f32x4 v0 = acc[ai][bj][m][0] * rs, v1 = acc[ai][bj][m][1] * rs;
                    u32x4 w; w.x = cvt_pk_bf16(v0[0], v0[1]); w.y = cvt_pk_bf16(v0[2], v0[3]); w.z = cvt_pk_bf16(v1[0], v1[1]); w.w = cvt_pk_bf16(v1[2], v1[3]);
                    *(u32x4*)(rowp + bj * HALF) = w; } }
    }
};
struct EpiSwiGLU {
    static constexpr bool PERM = true, AFTER_DRAIN = false, PF = true;
    bf16_t* O; int ldc; const float* ss;
    __device__ __forceinline__ void prefetch(PG8_LAS unsigned char* slot, const Unit& u, int wr, int lane) const { pf_rows_lds(slot, ss, u.pm * BM + wr * 64, lane); }
    __device__ __forceinline__ void operator()(const f32x4 (&acc)[2][2][4][2], const Unit& u, int wr, int wc, int fr, int fq, const PG8_LAS unsigned char* slot) const {
        const int row0 = u.pm * BM + wr * 64 + fr, hid0 = u.pn * 128 + wc * 32 + 8 * fq;
        float rs8[2][4];
        rstd8_lds(rs8, slot, ss, fr);
#pragma unroll
        for (int ai = 0; ai < 2; ++ai)
#pragma unroll
            for (int m = 0; m < 4; ++m) { const int row = row0 + ai * HALF + m * 16; const float rs = rs8[ai][m]; bf16_t* rowp = O + (size_t)row * ldc + hid0; float o[8];
#pragma unroll
                for (int n = 0; n < 2; ++n) { const f32x4 g = acc[ai][0][m][n] * rs, up = acc[ai][1][m][n] * rs;
#pragma unroll
                    for (int e = 0; e < 4; ++e) o[4 * n + e] = g[e] * up[e] * fast_sigmoid(g[e]); }
                u32x4 w; w.x = cvt_pk_bf16(o[0], o[1]); w.y = cvt_pk_bf16(o[2], o[3]); w.z = cvt_pk_bf16(o[4], o[5]); w.w = cvt_pk_bf16(o[6], o[7]);
                *(u32x4*)rowp = w; }
    }
};
__device__ __forceinline__ f32x4 bf4_to_f32(const u32x2 w) { f32x4 r; r[0] = __builtin_bit_cast(float, w.x << 16); r[1] = __builtin_bit_cast(float, w.x & 0xffff0000u); r[2] = __builtin_bit_cast(float, w.y << 16); r[3] = __builtin_bit_cast(float, w.y & 0xffff0000u); return r; }
__device__ __forceinline__ void bf8_to_f32(const u32x4 w, f32x4& lo, f32x4& hi) {
    lo[0] = __builtin_bit_cast(float, w.x << 16); lo[1] = __builtin_bit_cast(float, w.x & 0xffff0000u); lo[2] = __builtin_bit_cast(float, w.y << 16); lo[3] = __builtin_bit_cast(float, w.y & 0xffff0000u);
    hi[0] = __builtin_bit_cast(float, w.z << 16); hi[1] = __builtin_bit_cast(float, w.z & 0xffff0000u); hi[2] = __builtin_bit_cast(float, w.w << 16); hi[3] = __builtin_bit_cast(float, w.w & 0xffff0000u);
}
template <bool RB>
struct EpiRes {
    static constexpr bool PERM = true, AFTER_DRAIN = false, PF = false;
    const float* resid; int ldc; float scale; bf16_t* xb; float* ss_out;
    __device__ __forceinline__ void operator()(const f32x4 (&acc)[2][2][4][2], const Unit& u, int wr, int wc, int fr, int fq) const {
        const int row0 = u.pm * BM + wr * 64 + fr, col0 = u.pn * BM + wc * 32 + 8 * fq;
        const float* const resid_ = resid; bf16_t* const xb_ = xb; float* const ss_ = ss_out; const float scale_ = scale; const int ldc_ = ldc;
        f32x4 rs[2][2][2]; u32x4 rb[2][2];
#pragma unroll
        for (int bj = 0; bj < 2; ++bj) { const size_t o0 = (size_t)row0 * ldc_ + col0 + bj * HALF;
            if constexpr (RB) rb[0][bj] = *(const u32x4*)(xb_ + o0); else { rs[0][bj][0] = *(const f32x4*)(resid_ + o0); rs[0][bj][1] = *(const f32x4*)(resid_ + o0 + 4); } }
#pragma unroll
        for (int gi = 0; gi < 8; ++gi) { const int ai = gi >> 2, m = gi & 3; const int row = row0 + ai * HALF + m * 16; const size_t off = (size_t)row * ldc_ + col0;
            if (gi < 7) { const size_t offn = (size_t)(row0 + ((gi + 1) >> 2) * HALF + ((gi + 1) & 3) * 16) * ldc_ + col0;
#pragma unroll
                for (int bj = 0; bj < 2; ++bj) { if constexpr (RB) rb[(gi + 1) & 1][bj] = *(const u32x4*)(xb_ + offn + bj * HALF);
                    else { rs[(gi + 1) & 1][bj][0] = *(const f32x4*)(resid_ + offn + bj * HALF); rs[(gi + 1) & 1][bj][1] = *(const f32x4*)(resid_ + offn + bj * HALF + 4); } } }
            float q = 0.f;
#pragma unroll
            for (int bj = 0; bj < 2; ++bj) { f32x4 r0, r1; if constexpr (RB) bf8_to_f32(rb[gi & 1][bj], r0, r1); else { r0 = rs[gi & 1][bj][0]; r1 = rs[gi & 1][bj][1]; }
                const f32x4 o0 = r0 + acc[ai][bj][m][0] * scale_, o1 = r1 + acc[ai][bj][m][1] * scale_;
                u32x4 w; w.x = cvt_pk_bf16(o0[0], o0[1]); w.y = cvt_pk_bf16(o0[2], o0[3]); w.z = cvt_pk_bf16(o1[0], o1[1]); w.w = cvt_pk_bf16(o1[2], o1[3]);
                *(u32x4*)(xb_ + off + bj * HALF) = w;
                q += ((o0[0] * o0[0] + o0[1] * o0[1]) + (o0[2] * o0[2] + o0[3] * o0[3])) + ((o1[0] * o1[0] + o1[1] * o1[1]) + (o1[2] * o1[2] + o1[3] * o1[3])); }
            q += __shfl_xor(q, 16); q += __shfl_xor(q, 32);
            if (fq == 0) __hip_atomic_fetch_add((__attribute__((address_space(1))) float*)(ss_ + row), q, __ATOMIC_RELAXED, __HIP_MEMORY_SCOPE_AGENT);
            asm volatile("" ::: "memory"); }
    }
};
struct EpiKpe {
    static constexpr bool PERM = true, AFTER_DRAIN = false, PF = false;
    float* P; int Mrows; const float* ss;
    __device__ __forceinline__ void operator()(const f32x4 (&acc)[2][2][4][2], const Unit& u, int wr, int wc, int fr, int fq) const {
        if (wc >= 2) return;
        const int row0 = u.pm * BM + wr * 64 + fr, col0 = wc * 32 + 8 * fq;
#pragma unroll
        for (int ai = 0; ai < 2; ++ai)
#pragma unroll
            for (int m = 0; m < 4; ++m) { const int row = row0 + ai * HALF + m * 16; const float rs = row_rstd(ss, row); float* dst = P + ((size_t)u.pn * Mrows + row) * 64 + col0;
                *(f32x4*)dst = acc[ai][0][m][0] * rs; *(f32x4*)(dst + 4) = acc[ai][0][m][1] * rs; }
    }
};
struct EpiF32 {
    static constexpr bool PERM = false, AFTER_DRAIN = false, PF = false;
    float* C; int ldc;
    __device__ __forceinline__ void operator()(const f32x4 (&acc)[2][2][4][2], const Unit& u, int wr, int wc, int fr, int fq) const {
        const int row0 = u.pm * BM + wr * 64 + fr, col0 = u.pn * BM + wc * 32 + 4 * fq;
#pragma unroll
        for (int ai = 0; ai < 2; ++ai)
#pragma unroll
            for (int m = 0; m < 4; ++m) { float* rowp = C + (size_t)(row0 + ai * HALF + m * 16) * ldc + col0;
#pragma unroll
                for (int bj = 0; bj < 2; ++bj)
#pragma unroll
                    for (int n = 0; n < 2; ++n) *(f32x4*)(rowp + bj * HALF + n * 16) = acc[ai][bj][m][n]; }
    }
};
struct EpiPle {
    static constexpr bool PERM = true, AFTER_DRAIN = false, PF = false;
    const bf16_t* x; const bf16_t* P; float* out; int ldc; const float* ss;
    __device__ __forceinline__ void operator()(const f32x4 (&acc)[2][2][4][2], const Unit& u, int wr, int wc, int fr, int fq) const {
        const int row0 = u.pm * BM + wr * 64 + fr, col0 = u.pn * BM + wc * 32 + 8 * fq;
        const bf16_t* const x_ = x; const bf16_t* const P_ = P; float* const out_ = out; const int ldc_ = ldc;
        float rs8[2][4];
        load_rstd8(rs8, ss, row0);
        u32x4 xs[2], ps[2];
        xs[0] = *(const u32x4*)(x_ + (size_t)row0 * ldc_ + col0); ps[0] = *(const u32x4*)(P_ + (size_t)row0 * ldc_ + col0);
#pragma unroll
        for (int st = 0; st < 16; ++st) { const int ai = st >> 3, m = (st >> 1) & 3, bj = st & 1; const size_t off = (size_t)(row0 + ai * HALF + m * 16) * ldc_ + col0 + bj * HALF; const float rsd = rs8[ai][m];
            if (st < 15) { const int s2 = st + 1; const size_t offn = (size_t)(row0 + (s2 >> 3) * HALF + ((s2 >> 1) & 3) * 16) * ldc_ + col0 + (s2 & 1) * HALF;
                xs[s2 & 1] = *(const u32x4*)(x_ + offn); ps[s2 & 1] = *(const u32x4*)(P_ + offn); }
            f32x4 xv[2], pv[2]; bf8_to_f32(xs[st & 1], xv[0], xv[1]); bf8_to_f32(ps[st & 1], pv[0], pv[1]);
#pragma unroll
            for (int n = 0; n < 2; ++n) { f32x4 o;
#pragma unroll
                for (int e = 0; e < 4; ++e) o[e] = xv[n][e] + fast_sigmoid(acc[ai][bj][m][n][e] * rsd) * pv[n][e];
                *(f32x4*)(out_ + off + n * 4) = o; }
            asm volatile("" ::: "memory"); }
    }
};

template <class Epi, class Sched, bool ALIGN_EPI = false, bool SP2 = false>
__device__ __forceinline__ void gemm_phase(PG8_LAS unsigned char* lds, const Gemm g, const Sched S, const Epi E) {
    const int tid = threadIdx.x, wid = __builtin_amdgcn_readfirstlane(tid >> 6), lane = tid & 63, wr = wid >> 2, wc = wid & 3, fr = lane & 15, fq = lane >> 4;
    const int K = g.K, nt = K / BK, LD = g.ld ? g.ld : K;
    unsigned voffA[2], voffB[2];
#pragma unroll
    for (int i = 0; i < 2; ++i) { int R, C; stage_rc(tid * 16 + i * 8192, R, C); const int Rb = Epi::PERM ? ((R & ~31) + perm32(R & 31)) : R;
        voffA[i] = (unsigned)(R * LD + C) * 2u; voffB[i] = (unsigned)(Rb * LD + C) * 2u; }
    const size_t kstep = (size_t)(BK * 2);
    const size_t hstep = (size_t)HALF * LD * 2;
    const size_t tstep = 2 * hstep;
    const unsigned ldsw = (unsigned)wid * 1024u;
    const int aoff = lds_byte(wr * 64 + fr, fq * 8), boff = lds_byte(wc * 32 + fr, fq * 8);
#define PG8_SA(b, h) (((b) * 2 + (h)) * HTB)
#define PG8_SB(b, h) ((4 + (b) * 2 + (h)) * HTB)
#define PG8_STAGE(bufoff, gbase, voff) do { _Pragma("unroll") for (int _i = 0; _i < 2; ++_i) \
        __builtin_amdgcn_global_load_lds((const unsigned*)((const char*)(gbase) + (voff)[_i]), (PG8_LAS unsigned*)(lds + (bufoff) + ldsw + _i * 8192), 16, 0, 0); } while (0)
#define PG8_LDA(dst, b, h) do { _Pragma("unroll") for (int m = 0; m < 4; ++m) _Pragma("unroll") for (int k = 0; k < 2; ++k) dst[m][k] = *(const PG8_LAS bf16x8*)(lds + PG8_SA(b, h) + aoff + m * 2048 + k * 1024); } while (0)
#define PG8_LDB(dst, b, h) do { _Pragma("unroll") for (int n = 0; n < 2; ++n) _Pragma("unroll") for (int k = 0; k < 2; ++k) dst[n][k] = *(const PG8_LAS bf16x8*)(lds + PG8_SB(b, h) + boff + n * 2048 + k * 1024); } while (0)
#define PG8_MMA(ai, bj, At, Bt) do { __builtin_amdgcn_s_setprio(1); _Pragma("unroll") for (int m = 0; m < 4; ++m) _Pragma("unroll") for (int n = 0; n < 2; ++n) _Pragma("unroll") for (int k = 0; k < 2; ++k) \
        acc[ai][bj][m][n] = __builtin_amdgcn_mfma_f32_16x16x32_bf16(Bt[n][k], At[m][k], acc[ai][bj][m][n], 0, 0, 0); __builtin_amdgcn_s_setprio(0); } while (0)
#define PG8_WAIT_V(n) asm volatile("s_waitcnt vmcnt(" #n ")" ::: "memory")
#define PG8_WAIT_L(n) asm volatile("s_waitcnt lgkmcnt(" #n ")" ::: "memory")
#define PG8_BAR __builtin_amdgcn_s_barrier()
#define PG8_SCHED __builtin_amdgcn_sched_barrier(0)
    Unit cur, nxt; int ui = 0;
    if (!S.next(0, cur)) return;
    f32x4 acc[2][2][4][2];
#pragma unroll
    for (int a = 0; a < 2; ++a)
#pragma unroll
        for (int b = 0; b < 2; ++b)
#pragma unroll
            for (int m = 0; m < 4; ++m)
#pragma unroll
                for (int n = 0; n < 2; ++n) acc[a][b][m][n] = (f32x4){0.f, 0.f, 0.f, 0.f};
    bf16x8 At[4][2], B0[2][2], B1[2][2];
    const size_t bstep = g.kofs ? g.kofs : tstep;
    const char* cA = (const char*)g.A + (size_t)cur.pm * tstep + (size_t)cur.pn * g.kofs; const char* cB = (const char*)g.Bt + (size_t)cur.pn * bstep;
    S.a_ready(cur);
    if constexpr (SP2) {
        PG8_STAGE(PG8_SB(0, 0), cB, voffB); PG8_STAGE(PG8_SB(0, 1), cB + hstep, voffB); PG8_STAGE(PG8_SA(0, 0), cA, voffA); PG8_STAGE(PG8_SA(0, 1), cA + hstep, voffA);
        if (wr == 1) PG8_BAR;
        PG8_WAIT_V(2); PG8_BAR;
        PG8_STAGE(PG8_SB(1, 0), cB + kstep, voffB); PG8_STAGE(PG8_SA(1, 0), cA + kstep, voffA); PG8_STAGE(PG8_SB(1, 1), cB + hstep + kstep, voffB);
        PG8_WAIT_V(6); PG8_BAR;
    } else {
        PG8_STAGE(PG8_SB(0, 0), cB, voffB); PG8_STAGE(PG8_SA(0, 0), cA, voffA); PG8_STAGE(PG8_SB(0, 1), cB + hstep, voffB); PG8_STAGE(PG8_SA(0, 1), cA + hstep, voffA);
        if (wr == 1) PG8_BAR;
        PG8_WAIT_V(4); PG8_BAR;
        PG8_STAGE(PG8_SB(1, 0), cB + kstep, voffB); PG8_STAGE(PG8_SA(1, 0), cA + kstep, voffA); PG8_STAGE(PG8_SB(1, 1), cB + hstep + kstep, voffB);
        PG8_WAIT_V(6); PG8_BAR;
    }
    for (;;) {
        const bool has_next = S.next(ui + 1, nxt);
        const char* nA = has_next ? (const char*)g.A + (size_t)nxt.pm * tstep + (size_t)nxt.pn * g.kofs : cA; const char* nB = has_next ? (const char*)g.Bt + (size_t)nxt.pn * bstep : cB;
        for (int t = 0; t < nt; t += 2) {
            const bool last = (t == nt - 2);
            const char* a1 = cA + (size_t)(t + 1) * kstep;
            const char* a2 = last ? nA : cA + (size_t)(t + 2) * kstep; const char* b2 = last ? nB : cB + (size_t)(t + 2) * kstep;
            const char* a3 = a2 + kstep; const char* b3 = b2 + kstep;
            if (last && has_next) S.a_ready(nxt);
            if constexpr (Epi::PF) { if (last) E.prefetch(lds + STAGE_BYTES + wid * 512, cur, wr, lane); }
            if constexpr (SP2) {
            PG8_LDB(B0, 0, 0); PG8_LDB(B1, 0, 1); PG8_SCHED; PG8_LDA(At, 0, 0); PG8_STAGE(PG8_SA(1, 1), a1 + hstep, voffA);
            PG8_WAIT_V(8); PG8_WAIT_L(0); PG8_BAR; PG8_MMA(0, 0, At, B0); PG8_MMA(0, 1, At, B1); PG8_BAR; PG8_SCHED;
            PG8_LDA(At, 0, 1); PG8_STAGE(PG8_SB(0, 0), b2, voffB); PG8_STAGE(PG8_SB(0, 1), b2 + hstep, voffB); PG8_STAGE(PG8_SA(0, 0), a2, voffA);
            PG8_WAIT_V(8); PG8_WAIT_L(0); PG8_BAR; PG8_MMA(1, 0, At, B0); PG8_MMA(1, 1, At, B1); PG8_BAR; PG8_SCHED;
            PG8_LDB(B0, 1, 0); PG8_LDB(B1, 1, 1); PG8_SCHED; PG8_LDA(At, 1, 0); PG8_STAGE(PG8_SA(0, 1), a2 + hstep, voffA);
            PG8_WAIT_V(8); PG8_WAIT_L(0); PG8_BAR; PG8_MMA(0, 0, At, B0); PG8_MMA(0, 1, At, B1); PG8_BAR; PG8_SCHED;
            PG8_LDA(At, 1, 1); PG8_STAGE(PG8_SB(1, 0), b3, voffB); PG8_STAGE(PG8_SB(1, 1), b3 + hstep, voffB); PG8_STAGE(PG8_SA(1, 0), a3, voffA);
            PG8_WAIT_V(8); PG8_WAIT_L(0); PG8_BAR; PG8_MMA(1, 0, At, B0); PG8_MMA(1, 1, At, B1); PG8_BAR; PG8_SCHED;
            } else {
            PG8_LDB(B0, 0, 0); PG8_SCHED; PG8_LDA(At, 0, 0); PG8_STAGE(PG8_SA(1, 1), a1 + hstep, voffA);
            PG8_WAIT_L(8); PG8_BAR; PG8_WAIT_L(0); PG8_MMA(0, 0, At, B0); PG8_BAR; PG8_SCHED;
            PG8_LDB(B1, 0, 1); PG8_STAGE(PG8_SB(0, 0), b2, voffB);
            PG8_BAR; PG8_WAIT_L(0); PG8_MMA(0, 1, At, B1); PG8_BAR;
            PG8_LDA(At, 0, 1); PG8_STAGE(PG8_SA(0, 0), a2, voffA);
            PG8_BAR; PG8_WAIT_L(0); PG8_MMA(1, 0, At, B0); PG8_BAR; PG8_SCHED;
            PG8_STAGE(PG8_SB(0, 1), b2 + hstep, voffB);
            PG8_WAIT_V(6); PG8_BAR; PG8_MMA(1, 1, At, B1); PG8_BAR;
            PG8_LDB(B0, 1, 0); PG8_SCHED; PG8_LDA(At, 1, 0); PG8_STAGE(PG8_SA(0, 1), a2 + hstep, voffA);
            PG8_WAIT_L(8); PG8_BAR; PG8_WAIT_L(0); PG8_MMA(0, 0, At, B0); PG8_BAR; PG8_SCHED;
            PG8_LDB(B1, 1, 1); PG8_STAGE(PG8_SB(1, 0), b3, voffB);
            PG8_BAR; PG8_WAIT_L(0); PG8_MMA(0, 1, At, B1); PG8_BAR;
            PG8_LDA(At, 1, 1); PG8_STAGE(PG8_SA(1, 0), a3, voffA);
            PG8_BAR; PG8_WAIT_L(0); PG8_MMA(1, 0, At, B0); PG8_BAR; PG8_SCHED;
            PG8_STAGE(PG8_SB(1, 1), b3 + hstep, voffB);
            PG8_WAIT_V(6); PG8_BAR; PG8_MMA(1, 1, At, B1); PG8_BAR;
            }
        }
        if constexpr (ALIGN_EPI) { if (wr == 0) PG8_BAR; }
        if constexpr (!Epi::AFTER_DRAIN) { if constexpr (Epi::PF) E(acc, cur, wr, wc, fr, fq, lds + STAGE_BYTES + wid * 512); else E(acc, cur, wr, wc, fr, fq); S.done(cur); }
        if (!has_next) break;
#pragma unroll
        for (int a = 0; a < 2; ++a)
#pragma unroll
            for (int b = 0; b < 2; ++b)
#pragma unroll
                for (int m = 0; m < 4; ++m)
#pragma unroll
                    for (int n = 0; n < 2; ++n) acc[a][b][m][n] = (f32x4){0.f, 0.f, 0.f, 0.f};
        cur = nxt; cA = nA; cB = nB; ++ui;
        if constexpr (ALIGN_EPI) { if (wr == 1) PG8_BAR; }
    }
    PG8_WAIT_V(0);
    if constexpr (!ALIGN_EPI) { if (wr == 0) PG8_BAR; }
    PG8_BAR;
    if constexpr (Epi::AFTER_DRAIN) { E.fused(acc, cur, wr, wc, fr, fq, lds, wid, lane); S.done(cur); }
#undef PG8_SA
#undef PG8_SB
#undef PG8_STAGE
#undef PG8_LDA
#undef PG8_LDB
#undef PG8_MMA
#undef PG8_WAIT_V
#undef PG8_WAIT_L
#undef PG8_BAR
#undef PG8_SCHED
}
}

#ifndef MK_N_LAUNCHES
#define MK_N_LAUNCHES 1
#endif
#ifndef PROBE_PHASE
#define PROBE_PHASE -1
#endif
#define REP(k) (((k) == PROBE_PHASE) ? 2 : 1)
constexpr int NPH = 16;
constexpr int N_LAUNCHES = MK_N_LAUNCHES;
constexpr int NWAVES = 8, NTHR = 512;
constexpr int BATCH = 2, SEQ = 4096, T = BATCH * SEQ, DM = 2048, FF = 5632, PLE = 256;
constexpr int MLA_H = 8, QKH = 192, VH = 128, QL = 512, KVL = 256;
constexpr int RH = 16, RD = 1024;
constexpr int ZW = 4096;
constexpr int Z_R = 768, Z_K = 1792, Z_V = 2816, Z_LORA = 3840;
constexpr int LW = 3072;
constexpr float EPS = 1e-6f, GN_EPS = 64e-5f;
constexpr float QSCALE = 1.4426950408889634f * 0.07216878364870322f;

constexpr size_t MiB = 1u << 20;
constexpr size_t WS_CTL = 0, CTL_ZERO_BYTES = 1 * MiB;
constexpr size_t WS_ROPE = 1 * MiB;
constexpr size_t WS_BONUS = 2 * MiB;
constexpr size_t WS_WIN = 3 * MiB;
constexpr size_t WS_WQB = 20 * MiB;
constexpr size_t WS_WKVB = WS_WQB + 1536 * 512 * 2;
constexpr size_t WS_WLORA = WS_WKVB + 2048 * 256 * 2;
constexpr size_t WS_WOUT = 25 * MiB;
constexpr size_t WS_WPG = 33 * MiB;
constexpr size_t WS_WPP = 41 * MiB;
constexpr size_t WS_WGU = 42 * MiB;
constexpr size_t WS_WD = 86 * MiB;
constexpr size_t WS_WD2 = 3 * MiB;
static_assert(WS_WD2 + (size_t)2048 * 5632 * 2 <= WS_WOUT && WS_WPP + 2048 * 256 * 2 <= WS_WGU, "ws map 2");
constexpr size_t WS_H = 108 * MiB;
constexpr size_t WS_U = 140 * MiB;
constexpr size_t WS_X = 228 * MiB;
constexpr size_t WS_END = 408 * MiB;
constexpr size_t WS_Z = WS_U, WS_AQ = WS_U + 64 * MiB, WS_AKV = WS_AQ + 8 * MiB, WS_AL = WS_AKV + 4 * MiB, WS_KPEP = WS_AL + 4 * MiB;
constexpr size_t WS_WKPE = WS_WIN + 16 * MiB;
constexpr size_t WS_QRAW = WS_X, WS_KVRAW = WS_X + 24 * MiB, WS_LORA = WS_X + 56 * MiB;
constexpr size_t WS_QH = WS_X + 104 * MiB, WS_KH = WS_X + 128 * MiB, WS_VT = WS_X + 152 * MiB;
constexpr size_t WS_OMIX = WS_X;
constexpr size_t WS_TRT = WS_WGU;
constexpr size_t WS_SLOT = WS_TRT + 32 * MiB;
constexpr size_t WS_RRT = WS_SLOT + 32 * MiB;
constexpr size_t WS_G2T = WS_RRT + 16 * MiB;
constexpr size_t WS_VCG = WS_AQ;
static_assert(WS_G2T + 8 * MiB <= WS_U && WS_VCG + 16 * MiB <= WS_X, "chunk matrices");
constexpr size_t WS_OTMP = WS_X + 32 * MiB;
constexpr size_t WS_AST = WS_X + 172 * MiB;
constexpr size_t WS_PB = WS_X + 168 * MiB, WS_PPLE = WS_X + 8 * MiB;
static_assert(WS_WLORA + 3072 * 256 * 2 <= WS_WOUT && WS_VT + 16 * MiB <= WS_END && WS_AL + 4 * MiB <= WS_X, "ws map");
constexpr int CW_BAR = 4096, CW_QUEUE = 64, CW_SS = 32768;

constexpr int RING_OFF = 0, RING_BYTES = 131072;
constexpr int LDSCTL_OFF = 157696, MISC_OFF = LDSCTL_OFF + 320;
constexpr int LDS_BYTES = 159744;

#define GAS __attribute__((address_space(1)))
#define LAS __attribute__((address_space(3)))
typedef unsigned short bf16;
typedef unsigned v4u __attribute__((ext_vector_type(4)));
typedef unsigned v2u __attribute__((ext_vector_type(2)));
typedef float f32x4 __attribute__((ext_vector_type(4)));
typedef float f32x2 __attribute__((ext_vector_type(2)));
typedef float f32x16 __attribute__((ext_vector_type(16)));
typedef short bf16x8 __attribute__((ext_vector_type(8)));
typedef GAS unsigned gu32;
#define RLX_AGENT __ATOMIC_RELAXED, __HIP_MEMORY_SCOPE_AGENT
#define LDS_WAIT() asm volatile("s_waitcnt lgkmcnt(0)" ::: "memory")
#define VM_WAIT() asm volatile("s_waitcnt vmcnt(0)" ::: "memory")
__device__ __forceinline__ unsigned f2bf(float f) { unsigned u = __builtin_bit_cast(unsigned, f); return (u + 0x7fffu + ((u >> 16) & 1u)) >> 16; }
__device__ __forceinline__ unsigned pk2(float lo, float hi) { return f2bf(lo) | (f2bf(hi) << 16); }
__device__ __forceinline__ float bf2f(unsigned short h) { return __builtin_bit_cast(float, (unsigned)h << 16); }
__device__ __forceinline__ float bflo(unsigned w) { return __builtin_bit_cast(float, w << 16); }
__device__ __forceinline__ float bfhi(unsigned w) { return __builtin_bit_cast(float, w & 0xffff0000u); }
__device__ __forceinline__ float sigmoidf_(float x) { return __builtin_amdgcn_rcpf(1.0f + __builtin_amdgcn_exp2f(-1.4426950408889634f * x)); }
__device__ __forceinline__ float wave_sum(float v) {
#pragma unroll
    for (int o = 1; o < 64; o <<= 1) v += __shfl_xor(v, o);
    return v;
}

#define XB_TMO      128
#define XB_XCNT(j)  (256  + 64 * (j))
#define XB_XSUB(j)  (1280 + 64 * (j))
#define XB_XGEN(j)  (2304 + 64 * (j))
#define XB_TOP      3328
#define XB_TOPGEN   3392
#define XCD_BAR_WORDS 3456
#define XB_SPIN_CAP (1u << 18)

__device__ __forceinline__ unsigned xb_ld(unsigned* p)              { return __hip_atomic_load(p, __ATOMIC_RELAXED, __HIP_MEMORY_SCOPE_AGENT); }
__device__ __forceinline__ unsigned xb_add(unsigned* p, unsigned v) { return __hip_atomic_fetch_add(p, v, __ATOMIC_RELAXED, __HIP_MEMORY_SCOPE_AGENT); }
__device__ __forceinline__ unsigned xb_xcc_id() { return (unsigned)__builtin_amdgcn_s_getreg((3 << 11) | 20) & 0xFu; }
#define XB_SPIN(cond, bar) do { unsigned _sp = 0; while (cond) { __builtin_amdgcn_s_sleep(1); \
    if ((++_sp & 255u) == 0u) { if (xb_ld(&(bar)[XB_TMO])) break; if (_sp > XB_SPIN_CAP) { atomicAdd(&(bar)[XB_TMO], 1u); break; } } } } while (0)

struct XcdBarrier {
    unsigned* bar; unsigned x;
    volatile LAS unsigned* st;
};

__device__ __forceinline__ XcdBarrier xcd_barrier_post(unsigned* bar, volatile LAS unsigned* st) {
    XcdBarrier b; b.bar = bar; b.x = xb_xcc_id(); b.st = st;
    if (threadIdx.x == 0) (void)xb_add(&bar[XB_XCNT(b.x)], 1u);
    return b;
}
__device__ __forceinline__ void xcd_barrier_complete(unsigned* bar, unsigned x, unsigned& nloc, unsigned& nx) {
    const unsigned G = gridDim.x * gridDim.y * gridDim.z;
    unsigned sum, cnt, mine, sp = 0u;
    for (;;) {
        sum = 0u; cnt = 0u; mine = 0u;
#pragma unroll
        for (unsigned j = 0; j < 16; ++j) { const unsigned c = xb_ld(&bar[XB_XCNT(j)]); sum += c; cnt += (c > 0u) ? 1u : 0u; mine = (j == x) ? c : mine; }
        if (sum == G) break;
        __builtin_amdgcn_s_sleep(1);
        if ((++sp & 255u) == 0u) { if (xb_ld(&bar[XB_TMO])) break; if (sp > XB_SPIN_CAP) { atomicAdd(&bar[XB_TMO], 1u); break; } }
    }
    nloc = mine > 0u ? mine : 1u; nx = cnt > 0u ? cnt : 1u;
}

__device__ __forceinline__ void xcd_barrier(const XcdBarrier& b) {
    asm volatile("s_waitcnt vmcnt(0)" ::: "memory");
    __syncthreads();
    if (threadIdx.x == 0) {
        unsigned* bar = b.bar;
        __builtin_amdgcn_s_waitcnt(0);
        unsigned nloc = b.st[0], nx = b.st[1];
        if (nloc == 0u) { xcd_barrier_complete(bar, b.x, nloc, nx); b.st[0] = nloc; b.st[1] = nx; }
        const unsigned old = xb_add(&bar[XB_XSUB(b.x)], 1u);
        const unsigned gen = old / nloc;
        if (old + 1u == (gen + 1u) * nloc) {
            __builtin_amdgcn_fence(__ATOMIC_RELEASE, "agent");
            asm volatile("s_waitcnt vmcnt(0)" ::: "memory");
            const unsigned og = xb_add(&bar[XB_TOP], 1u);
            const unsigned tg = og / nx;
            if (og + 1u == (tg + 1u) * nx) xb_add(&bar[XB_TOPGEN], 1u);
            else XB_SPIN(xb_ld(&bar[XB_TOPGEN]) == tg, bar);
            __builtin_amdgcn_fence(__ATOMIC_ACQUIRE, "agent");
            xb_add(&bar[XB_XGEN(b.x)], 1u);
            asm volatile("s_waitcnt vmcnt(0)" ::: "memory");
        } else {
            XB_SPIN(xb_ld(&bar[XB_XGEN(b.x)]) == gen, bar);
            __builtin_amdgcn_fence(__ATOMIC_ACQUIRE, "agent");
            asm volatile("s_waitcnt vmcnt(0)" ::: "memory");
        }
    }
    __syncthreads();
}


struct Args { const float* in[33]; float* out; unsigned char* ws; int ph_lo, ph_hi; };

struct WJob { const float* W0; const float* W1; const float* gain; bf16* dst; int K, N, NP, KD, koff, mode, LDN, coff, skip_at, skip_by, nlo; };
__device__ __forceinline__ int job_items(const WJob& j) { return (j.KD / 64) * (j.NP / 32); }
__device__ __forceinline__ bf16* tr_load(const WJob& j, int item, int lane, f32x4 (&v)[8]) {
    const int nblk = j.NP / 32, kb = item / nblk, nb = item % nblk, k0 = 64 * kb, n0 = j.nlo + 32 * nb;
    const int g = lane & 7, kc = lane >> 3, np = n0 + 4 * g, kk = k0 + 8 * kc;
    const float* W = j.W0; int col = np + j.coff + (np >= j.skip_at ? j.skip_by : 0); bool nvalid = np < j.N;
    if (j.mode == 1) { const int r = np & 255, pn = np >> 8; const ptrdiff_t dW = j.W1 - j.W0; W = j.W0 + ((r < 128) ? (ptrdiff_t)0 : dW); col = 128 * pn + (r & 127); nvalid = true; }
#pragma unroll
    for (int i = 0; i < 8; ++i) {
        const int k = kk + i - j.koff;
        const bool ok = nvalid && k >= 0 && k < j.K;
        v[i] = (f32x4){0.f, 0.f, 0.f, 0.f};
        if (ok) { v[i] = __builtin_nontemporal_load((const GAS f32x4*)(W + (size_t)k * j.LDN + col)); if (j.gain) v[i] = v[i] * j.gain[k]; }
    }
    return j.dst + (size_t)np * j.KD + kk;
}
__device__ __forceinline__ void tr_store(const WJob& j, const f32x4 (&v)[8], bf16* d) {
#pragma unroll
    for (int q = 0; q < 4; ++q) { v4u o; o.x = pk2(v[0][q], v[1][q]); o.y = pk2(v[2][q], v[3][q]); o.z = pk2(v[4][q], v[5][q]); o.w = pk2(v[6][q], v[7][q]);
        *(GAS v4u*)(d + (size_t)q * j.KD) = o; }
}
__device__ __forceinline__ WJob mk_job(const float* W0, const float* W1, const float* gain, bf16* dst, int K, int N, int NP, int KD, int koff, int mode, int LDN = 0, int coff = 0, int skip_at = 1 << 30, int skip_by = 0, int nlo = 0) {
    WJob j; j.W0 = W0; j.W1 = W1; j.gain = gain; j.dst = dst; j.K = K; j.N = N; j.NP = NP; j.KD = KD; j.koff = koff; j.mode = mode; j.LDN = LDN ? LDN : N; j.coff = coff; j.skip_at = skip_at; j.skip_by = skip_by; j.nlo = nlo; return j;
}
__device__ __forceinline__ void run_job4(const WJob& j, int gw, int NGW, int& base, int lane) {
    const int n = job_items(j);
    int first = (gw - base) % NGW; if (first < 0) first += NGW;
    for (int it = first; it < n; it += 4 * NGW) {
        f32x4 va[8], vb[8], vc[8], vd[8]; bf16 *db = nullptr, *dc = nullptr, *dd = nullptr; const bool hb = it + NGW < n, hc = it + 2 * NGW < n, hd = it + 3 * NGW < n;
        bf16* da = tr_load(j, it, lane, va);
        if (hb) db = tr_load(j, it + NGW, lane, vb);
        if (hc) dc = tr_load(j, it + 2 * NGW, lane, vc);
        if (hd) dd = tr_load(j, it + 3 * NGW, lane, vd);
        tr_store(j, va, da);
        if (hb) tr_store(j, vb, db);
        if (hc) tr_store(j, vc, dc);
        if (hd) tr_store(j, vd, dd);
    }
    base = (base + n) % NGW;
}
__device__ __forceinline__ void run_job(const WJob& j, int gw, int NGW, int& base, LAS float* scr, int lane) {
    const int n = job_items(j);
    int first = (gw - base) % NGW; if (first < 0) first += NGW;
    (void)scr;
    for (int it = first; it < n; it += 2 * NGW) {
        f32x4 va[8], vb[8]; bf16* db = nullptr; const bool hb = it + NGW < n;
        bf16* da = tr_load(j, it, lane, va);
        if (hb) db = tr_load(j, it + NGW, lane, vb);
        tr_store(j, va, da);
        if (hb) tr_store(j, vb, db);
    }
    base = (base + n) % NGW;
}

__device__ __forceinline__ void rms_row_bf16(const float* xrow, bf16* orow, int lane) {
    const GAS f32x4* xr = (const GAS f32x4*)xrow + lane;
    f32x4 v[8]; float s = 0.f;
#pragma unroll
    for (int j = 0; j < 8; ++j) { v[j] = xr[64 * j]; s += (v[j].x * v[j].x + v[j].y * v[j].y) + (v[j].z * v[j].z + v[j].w * v[j].w); }
    const float rstd = 1.0f / sqrtf(wave_sum(s) * (1.f / DM) + EPS);
    GAS unsigned long long* o8 = (GAS unsigned long long*)orow + lane;
#pragma unroll
    for (int j = 0; j < 8; ++j) o8[64 * j] = (unsigned long long)pk2(v[j].x * rstd, v[j].y * rstd) | ((unsigned long long)pk2(v[j].z * rstd, v[j].w * rstd) << 32);
}
__device__ __forceinline__ void rms_pass(const float* X, bf16* H, int gw, int NGW, int lane) {
    for (int m = gw; m < T; m += NGW) rms_row_bf16(X + (size_t)m * DM, H + (size_t)m * DM, lane);
}
__device__ __forceinline__ void xb_pass(const float* X, bf16* XB, float* ss, int gw, int NGW, int lane) {
    for (int m = gw; m < T; m += 2 * NGW) {
        const int m2 = m + NGW; const bool hb = m2 < T;
        const GAS f32x4* xa = (const GAS f32x4*)(X + (size_t)m * DM) + lane; const GAS f32x4* xb = (const GAS f32x4*)(X + (size_t)(hb ? m2 : m) * DM) + lane;
        f32x4 va[8], vb[8]; float sa = 0.f, sb = 0.f;
#pragma unroll
        for (int j = 0; j < 8; ++j) va[j] = __builtin_nontemporal_load(xa + 64 * j);
#pragma unroll
        for (int j = 0; j < 8; ++j) vb[j] = __builtin_nontemporal_load(xb + 64 * j);
#pragma unroll
        for (int j = 0; j < 8; ++j) { sa += (va[j].x * va[j].x + va[j].y * va[j].y) + (va[j].z * va[j].z + va[j].w * va[j].w); sb += (vb[j].x * vb[j].x + vb[j].y * vb[j].y) + (vb[j].z * vb[j].z + vb[j].w * vb[j].w); }
        sa = wave_sum(sa); sb = wave_sum(sb);
        GAS unsigned long long* oa = (GAS unsigned long long*)(XB + (size_t)m * DM) + lane;
#pragma unroll
        for (int j = 0; j < 8; ++j) oa[64 * j] = (unsigned long long)pk2(va[j].x, va[j].y) | ((unsigned long long)pk2(va[j].z, va[j].w) << 32);
        if (lane == 0) ss[m] = sa;
        if (hb) { GAS unsigned long long* ob = (GAS unsigned long long*)(XB + (size_t)m2 * DM) + lane;
#pragma unroll
            for (int j = 0; j < 8; ++j) ob[64 * j] = (unsigned long long)pk2(vb[j].x, vb[j].y) | ((unsigned long long)pk2(vb[j].z, vb[j].w) << 32);
            if (lane == 0) ss[m2] = sb; }
    }
}

struct PrepRow { v4u q; v2u kv, lc, lp; };
__device__ __forceinline__ void prep_load(PrepRow& r, int t, const bf16* Z, int lane) {
    const bf16* zr = Z + (size_t)t * ZW;
    r.q = *(const GAS v4u*)(zr + lane * 8);
    r.kv = *(const GAS v2u*)(zr + QL + lane * 4);
    r.lc = *(const GAS v2u*)(zr + Z_LORA + lane * 4);
    r.lp.x = 0u; r.lp.y = 0u;
    if ((t % SEQ) != 0) r.lp = *(const GAS v2u*)(zr - ZW + Z_LORA + lane * 4);
}
__device__ __forceinline__ void prep_finish(const PrepRow& r, int t, const f32x4 m4, bf16* AQ, bf16* AKV, bf16* AL, int lane) {
    {   const v4u w = r.q;
        float x[8] = {bflo(w.x), bfhi(w.x), bflo(w.y), bfhi(w.y), bflo(w.z), bfhi(w.z), bflo(w.w), bfhi(w.w)};
        float s = 0.f;
#pragma unroll
        for (int e = 0; e < 8; ++e) s += x[e] * x[e];
        const float rstd = 1.0f / sqrtf(wave_sum(s) * (1.f / QL) + EPS);
        v4u o; o.x = pk2(x[0] * rstd, x[1] * rstd); o.y = pk2(x[2] * rstd, x[3] * rstd); o.z = pk2(x[4] * rstd, x[5] * rstd); o.w = pk2(x[6] * rstd, x[7] * rstd);
        *(GAS v4u*)(AQ + (size_t)t * QL + lane * 8) = o;
    }
    {   const v2u w = r.kv;
        float x[4] = {bflo(w.x), bfhi(w.x), bflo(w.y), bfhi(w.y)};
        const float s = (x[0] * x[0] + x[1] * x[1]) + (x[2] * x[2] + x[3] * x[3]);
        const float rstd = 1.0f / sqrtf(wave_sum(s) * (1.f / KVL) + EPS);
        v2u o; o.x = pk2(x[0] * rstd, x[1] * rstd); o.y = pk2(x[2] * rstd, x[3] * rstd);
        *(GAS v2u*)(AKV + (size_t)t * KVL + lane * 4) = o;
    }
    {
        const v2u w = r.lc, wp = r.lp;
        float c[4] = {bflo(w.x), bfhi(w.x), bflo(w.y), bfhi(w.y)}, p[4] = {bflo(wp.x), bfhi(wp.x), bflo(wp.y), bfhi(wp.y)}, o[4];
#pragma unroll
        for (int e = 0; e < 4; ++e) { const float zs = c[e] + (p[e] - c[e]) * m4[e];
            float rr;
            if (lane < 16) rr = 1.0f - 2.0f * __builtin_amdgcn_rcpf(__builtin_amdgcn_exp2f(2.8853900817779268f * zs) + 1.0f);
            else if (lane < 32) rr = zs;
            else rr = sigmoidf_(zs);
            o[e] = rr; }
        v2u ow; ow.x = pk2(o[0], o[1]); ow.y = pk2(o[2], o[3]);
        *(GAS v2u*)(AL + (size_t)t * 256 + lane * 4) = ow;
    }
}

template <int CTRL> __device__ __forceinline__ float dpp_add(float x) { return x + __builtin_bit_cast(float, __builtin_amdgcn_update_dpp(0, __builtin_bit_cast(int, x), CTRL, 0xF, 0xF, true)); }
__device__ __forceinline__ float allreduce16(float x) { x = dpp_add<0xB1>(x); x = dpp_add<0x4E>(x); x = dpp_add<0x141>(x); x = dpp_add<0x140>(x); return x; }
__device__ __forceinline__ float wave_sum_dpp(float x) { x = allreduce16(x); x += __shfl_xor(x, 16); x += __shfl_xor(x, 32); return x; }
__device__ __forceinline__ float allreduce64(float x) { x = allreduce16(x); float a_ = x, b_ = x;
    asm volatile("s_nop 1\n\tv_permlane16_swap_b32 %0, %1" : "+v"(a_), "+v"(b_));
    x = a_ + b_; a_ = x; b_ = x;
    asm volatile("s_nop 1\n\tv_permlane32_swap_b32 %0, %1" : "+v"(a_), "+v"(b_));
    return a_ + b_; }
__device__ __forceinline__ void kpe_task(int task, const bf16* XB, const bf16* WK, const float* ss, float* KPE, LAS unsigned char* lds, int tid) {
    const int lane = tid & 63, wv = __builtin_amdgcn_readfirstlane(tid >> 6), r32 = lane & 31, hi = lane >> 5, r0 = task * 32;
    f32x16 acc0, acc1;
#pragma unroll
    for (int r = 0; r < 16; ++r) { acc0[r] = 0.f; acc1[r] = 0.f; }
    const bf16* ap = XB + (size_t)(r0 + r32) * DM + 256 * wv + 8 * hi;
    const bf16* bp0 = WK + (size_t)r32 * DM + 256 * wv + 8 * hi; const bf16* bp1 = bp0 + (size_t)32 * DM;
#pragma unroll
    for (int half = 0; half < 2; ++half) {
        bf16x8 a[8], b0[8], b1[8];
#pragma unroll
        for (int ks = 0; ks < 8; ++ks) { const int ko = (half * 8 + ks) * 16; a[ks] = *(const GAS bf16x8*)(ap + ko); b0[ks] = *(const GAS bf16x8*)(bp0 + ko); b1[ks] = *(const GAS bf16x8*)(bp1 + ko); }
#pragma unroll
        for (int ks = 0; ks < 8; ++ks) { acc0 = __builtin_amdgcn_mfma_f32_32x32x16_bf16(a[ks], b0[ks], acc0, 0, 0, 0); acc1 = __builtin_amdgcn_mfma_f32_32x32x16_bf16(a[ks], b1[ks], acc1, 0, 0, 0); }
    }
    LAS float* red = (LAS float*)lds;
#pragma unroll
    for (int r = 0; r < 16; ++r) { red[(wv * 32 + r) * 64 + lane] = acc0[r]; red[(wv * 32 + 16 + r) * 64 + lane] = acc1[r]; }
    __syncthreads();
#pragma unroll
    for (int q = 0; q < 4; ++q) { const int reg = 4 * wv + q; float s = 0.f;
#pragma unroll
        for (int w = 0; w < 8; ++w) s += red[(w * 32 + reg) * 64 + lane];
        const int tile = reg >> 4, rr = reg & 15, row = r0 + (rr & 3) + 8 * (rr >> 2) + 4 * hi, col = 32 * tile + r32;
        KPE[(size_t)row * 64 + col] = s * __builtin_amdgcn_rsqf(ss[row] * (1.0f / 2048.0f) + 1e-6f); }
    __syncthreads();
}
__device__ __forceinline__ int vpos(int kl) { const int ko = kl & 15; return (kl & 48) + 8 * ((ko >> 2) & 1) + 4 * (ko >> 3) + (ko & 3); }
__device__ __forceinline__ void mla_prep_task(int task, const bf16* QRAW, const bf16* KVRAW, const float* qn, const float* kn, const f32x2* rope,
                                              bf16* Qh, bf16* Kh, bf16* Vt, int lane, const float* KPEP) {
    const int ws = task & 7, tile = (task >> 3) & 63, bh = task >> 9, b = bh >> 3, h = bh & 7;
    const float qg0 = qn[lane], qg1 = qn[64 + lane], qg2 = qn[128 + lane], kg0 = kn[lane], kg1 = kn[64 + lane], kg2 = kn[128 + lane];
    unsigned short qx[8][3], kx[8][2], vx[8][2]; float kpe[8]; f32x2 cs8[8];
#pragma unroll
    for (int i = 0; i < 8; ++i) { const int t = b * SEQ + tile * 64 + ws * 8 + i;
        const bf16* qr = QRAW + (size_t)t * 1536 + h * QKH; const bf16* kr = KVRAW + (size_t)t * 2048 + h * 256;
        qx[i][0] = qr[lane]; qx[i][1] = qr[64 + lane]; qx[i][2] = qr[128 + lane];
        kx[i][0] = kr[lane]; kx[i][1] = kr[64 + lane];
        kpe[i] = KPEP[(size_t)t * 64 + lane];
        vx[i][0] = kr[128 + lane]; vx[i][1] = kr[192 + lane];
        cs8[i] = rope[(tile * 64 + ws * 8 + i) * 32 + (lane & 31)]; }
#pragma unroll
    for (int i = 0; i < 8; ++i) {
        const int kl = ws * 8 + i, s = tile * 64 + kl;
        const f32x2 cs = cs8[i];
        const float sgn = (lane < 32) ? -1.0f : 1.0f;
        {   float x0 = bf2f(qx[i][0]), x1 = bf2f(qx[i][1]), x2 = bf2f(qx[i][2]);
            const float rstd = __builtin_amdgcn_rsqf(wave_sum_dpp(x0 * x0 + x1 * x1 + x2 * x2) * (1.f / QKH) + EPS);
            x0 *= rstd * qg0; x1 *= rstd * qg1; x2 *= rstd * qg2;
            const float pr = __shfl_xor(x2, 32);
            x2 = x2 * cs.x + sgn * pr * cs.y;
            bf16* qo = Qh + ((size_t)bh * SEQ + s) * QKH;
            qo[lane] = (bf16)f2bf(x0 * QSCALE); qo[64 + lane] = (bf16)f2bf(x1 * QSCALE); qo[128 + lane] = (bf16)f2bf(x2 * QSCALE); }
        {   float x0 = bf2f(kx[i][0]), x1 = bf2f(kx[i][1]), x2 = kpe[i];
            const float rstd = __builtin_amdgcn_rsqf(wave_sum_dpp(x0 * x0 + x1 * x1 + x2 * x2) * (1.f / QKH) + EPS);
            x0 *= rstd * kg0; x1 *= rstd * kg1; x2 *= rstd * kg2;
            const float pr = __shfl_xor(x2, 32);
            x2 = x2 * cs.x + sgn * pr * cs.y;
            bf16* ko = Kh + ((size_t)bh * SEQ + s) * QKH;
            ko[lane] = (bf16)f2bf(x0); ko[64 + lane] = (bf16)f2bf(x1); ko[128 + lane] = (bf16)f2bf(x2); }
    }
    {   bf16* vt = Vt + ((size_t)bh * 64 + tile) * 8192 + 16 * (ws >> 1) + 4 * (ws & 1);
        v2u a0, a1, c0, c1;
        a0.x = (unsigned)vx[0][0] | ((unsigned)vx[1][0] << 16); a0.y = (unsigned)vx[2][0] | ((unsigned)vx[3][0] << 16);
        a1.x = (unsigned)vx[4][0] | ((unsigned)vx[5][0] << 16); a1.y = (unsigned)vx[6][0] | ((unsigned)vx[7][0] << 16);
        c0.x = (unsigned)vx[0][1] | ((unsigned)vx[1][1] << 16); c0.y = (unsigned)vx[2][1] | ((unsigned)vx[3][1] << 16);
        c1.x = (unsigned)vx[4][1] | ((unsigned)vx[5][1] << 16); c1.y = (unsigned)vx[6][1] | ((unsigned)vx[7][1] << 16);
        *(GAS v2u*)(vt + lane * 64) = a0; *(GAS v2u*)(vt + lane * 64 + 8) = a1;
        *(GAS v2u*)(vt + (64 + lane) * 64) = c0; *(GAS v2u*)(vt + (64 + lane) * 64 + 8) = c1; }
}

namespace att {
constexpr int ATT_SPLIT_QB = 6, ATT_UNITS = 26 * 16;
__device__ __forceinline__ unsigned att_entry(unsigned e) {
    constexpr unsigned long long t0 = 0x3c2c3d2d3e2e3f2full, t1 = 0x0439293a2a053b2bull, t2 = 0x0236260337273828ull, t3 = 0x0000000000000001ull;
    const unsigned long long t = (e < 8u) ? t0 : (e < 16u) ? t1 : (e < 24u) ? t2 : t3;
    return (unsigned)(t >> (8u * (e & 7u))) & 0xffu;
}
constexpr int OPITCH_B = 272;
constexpr int KROW = 400, VROW = 144, KT = 64 * KROW, VTB = 128 * VROW, BUFB = KT + VTB, WSF_OFF = 2 * BUFB;
static_assert(WSF_OFF + 8 * 32 * 4 <= RING_BYTES, "attention LDS");
static_assert(8 * 32 * OPITCH_B <= WSF_OFF, "attention O staging");
static_assert(RING_OFF + pg8::STAGE_BYTES + 8 * 512 <= LDSCTL_OFF, "GEMM epilogue prefetch slots");
__device__ __forceinline__ int crow(int r, int hi) { return (r & 3) + 8 * (r >> 2) + 4 * hi; }
__device__ __forceinline__ bf16x8 pack8(const f32x16& p, int b0) {
    v4u w; w.x = pg8::cvt_pk_bf16(p[b0], p[b0 + 1]); w.y = pg8::cvt_pk_bf16(p[b0 + 2], p[b0 + 3]); w.z = pg8::cvt_pk_bf16(p[b0 + 4], p[b0 + 5]); w.w = pg8::cvt_pk_bf16(p[b0 + 6], p[b0 + 7]);
    return __builtin_bit_cast(bf16x8, w);
}
__device__ __forceinline__ void attn_unit(int bh, int qb, int part, int np, const bf16* Qh, const bf16* Kh, const bf16* Vt, bf16* Odst, int opitch, f32x2* ST, LAS unsigned char* lds) {
    const int tid = threadIdx.x, lane = tid & 63, wid = __builtin_amdgcn_readfirstlane(tid >> 6), r32 = lane & 31, hi = lane >> 5;
    const int b = bh >> 3, h = bh & 7, NTP = (np == 2) ? 2 * (qb + 1) : 4 * (qb + 1);
    const char* Kg = (const char*)(Kh + (size_t)bh * SEQ * QKH);
    const char* Vg = (const char*)(Vt + (size_t)bh * 64 * 8192);
    const int q0 = qb * 256 + wid * 32;
    bf16x8 qf[12];
    {   const bf16* qp = Qh + ((size_t)bh * SEQ + q0 + r32) * QKH + hi * 8;
#pragma unroll
        for (int ks = 0; ks < 12; ++ks) qf[ks] = *(const GAS bf16x8*)(qp + ks * 16); }
    v4u kst[3], vst[2];
    int kdst[3], vdst[2];
#pragma unroll
    for (int i = 0; i < 3; ++i) { const int c = tid + 512 * i; kdst[i] = (c / 24) * KROW + (c % 24) * 16; }
#pragma unroll
    for (int i = 0; i < 2; ++i) { const int c = tid + 512 * i; vdst[i] = KT + (c >> 3) * VROW + (c & 7) * 16; }
#define ATT_LOAD(j) do { const char* kg = Kg + (size_t)(j) * (64 * QKH * 2); const char* vg = Vg + (size_t)(j) * 16384; \
        _Pragma("unroll") for (int i_ = 0; i_ < 3; ++i_) kst[i_] = *(const GAS v4u*)(kg + (tid + 512 * i_) * 16); \
        _Pragma("unroll") for (int i_ = 0; i_ < 2; ++i_) vst[i_] = *(const GAS v4u*)(vg + (tid + 512 * i_) * 16); } while (0)
#define ATT_STORE(buf) do { LAS unsigned char* bs = lds + (buf) * BUFB; \
        _Pragma("unroll") for (int i_ = 0; i_ < 3; ++i_) *(LAS v4u*)(bs + kdst[i_]) = kst[i_]; \
        _Pragma("unroll") for (int i_ = 0; i_ < 2; ++i_) *(LAS v4u*)(bs + vdst[i_]) = vst[i_]; } while (0)
    ATT_LOAD(part); ATT_STORE(0);
#pragma unroll
    for (int ks = 0; ks < 12; ++ks) asm volatile("" : "+v"(qf[ks]));
    __syncthreads();
    float m = -1e30f, l = 0.f;
    f32x16 o[4];
#pragma unroll
    for (int d = 0; d < 4; ++d)
#pragma unroll
        for (int r = 0; r < 16; ++r) o[d][r] = 0.f;
    LAS float* wsf = (LAS float*)(lds + WSF_OFF) + wid * 32;
    for (int it = 0; it < NTP; ++it) {
        const int j = np * it + part;
        if (it + 1 < NTP) ATT_LOAD(j + np);
        const int k0 = j * 64;
        if (k0 <= q0) {
            const LAS unsigned char* kb = lds + (it & 1) * BUFB; const LAS unsigned char* vb = kb + KT;
            f32x16 p0, p1;
#pragma unroll
            for (int r = 0; r < 16; ++r) { p0[r] = 0.f; p1[r] = 0.f; }
            __builtin_amdgcn_s_setprio(1);
#pragma unroll
            for (int ks = 0; ks < 12; ++ks) {
                const bf16x8 a0 = *(const LAS bf16x8*)(kb + r32 * KROW + ks * 32 + hi * 16);
                const bf16x8 a1 = *(const LAS bf16x8*)(kb + (32 + r32) * KROW + ks * 32 + hi * 16);
                p0 = __builtin_amdgcn_mfma_f32_32x32x16_bf16(a0, qf[ks], p0, 0, 0, 0);
                p1 = __builtin_amdgcn_mfma_f32_32x32x16_bf16(a1, qf[ks], p1, 0, 0, 0);
            }
            __builtin_amdgcn_s_setprio(0);
            if (k0 + 63 > q0) {
                const int q = q0 + r32;
#pragma unroll
                for (int r = 0; r < 16; ++r) { const int key = k0 + crow(r, hi); if (key > q) p0[r] = -1e30f; if (key + 32 > q) p1[r] = -1e30f; }
            }
            float mx = fmaxf(p0[0], p1[0]);
#pragma unroll
            for (int r = 1; r < 16; ++r) mx = fmaxf(mx, fmaxf(p0[r], p1[r]));
            mx = fmaxf(mx, __shfl_xor(mx, 32));
            const float mn = fmaxf(m, mx);
            if (__any(mn > m)) {
                const float al = __builtin_amdgcn_exp2f(m - mn); l *= al; m = mn;
                if (hi == 0) wsf[r32] = al;
                LDS_WAIT();
#pragma unroll
                for (int g = 0; g < 4; ++g) { const f32x4 a4 = *(const LAS f32x4*)(wsf + 8 * g + 4 * hi);
#pragma unroll
                    for (int d = 0; d < 4; ++d)
#pragma unroll
                        for (int e = 0; e < 4; ++e) o[d][4 * g + e] *= a4[e]; }
            }
            float ps = 0.f;
#pragma unroll
            for (int r = 0; r < 16; ++r) { p0[r] = __builtin_amdgcn_exp2f(p0[r] - m); p1[r] = __builtin_amdgcn_exp2f(p1[r] - m); ps += p0[r] + p1[r]; }
            l += ps;
            bf16x8 pa[4]; pa[0] = pack8(p0, 0); pa[1] = pack8(p0, 8); pa[2] = pack8(p1, 0); pa[3] = pack8(p1, 8);
            __builtin_amdgcn_s_setprio(1);
#pragma unroll
            for (int d = 0; d < 4; ++d)
#pragma unroll
                for (int ks = 0; ks < 4; ++ks) {
                    const bf16x8 bv = *(const LAS bf16x8*)(vb + (32 * d + r32) * VROW + ks * 32 + hi * 16);
                    o[d] = __builtin_amdgcn_mfma_f32_32x32x16_bf16(pa[ks], bv, o[d], 0, 0, 0);
                }
            __builtin_amdgcn_s_setprio(0);
        }
        if (it + 1 < NTP) ATT_STORE((it + 1) & 1);
        __syncthreads();
    }
#undef ATT_LOAD
#undef ATT_STORE
    l += __shfl_xor(l, 32);
    const float inv = (l > 0.f) ? 1.0f / l : 0.f;
    if (hi == 0) { wsf[r32] = inv; ST[((size_t)(b * SEQ) + q0 + r32) * MLA_H + h] = (f32x2){m, l}; }
    LDS_WAIT();
    LAS unsigned char* og = lds + wid * (32 * OPITCH_B);
#pragma unroll
    for (int g = 0; g < 4; ++g) { const f32x4 a4 = *(const LAS f32x4*)(wsf + 8 * g + 4 * hi);
#pragma unroll
        for (int e = 0; e < 4; ++e) { const int row = crow(4 * g + e, hi);
#pragma unroll
            for (int d = 0; d < 4; ++d) *(LAS unsigned short*)(og + row * OPITCH_B + (32 * d + r32) * 2) = f2bf(o[d][4 * g + e] * a4[e]); } }
    LDS_WAIT();
    bf16* ob = Odst + ((size_t)(b * SEQ) + q0) * opitch + h * VH;
#pragma unroll
    for (int i = 0; i < 8; ++i) { const int c = lane + 64 * i, row = c >> 4, cc = c & 15;
        const v4u v = *(const LAS v4u*)(og + row * OPITCH_B + cc * 16);
        *(GAS v4u*)(ob + (size_t)row * opitch + cc * 8) = v; }
    LDS_WAIT();
}
__device__ __forceinline__ void attn_merge_item(int item, bf16* Omix, const bf16* OTMP, const f32x2* ST, int lane) {
    const int t = item >> 1, h = (item & 1) * 4 + (lane >> 4), dd = (lane & 15) * 8;
    const f32x2 s0 = ST[(size_t)t * MLA_H + h], s1 = ST[(size_t)(T + t) * MLA_H + h];
    const float M = fmaxf(s0.x, s1.x);
    float w0 = s0.y * __builtin_amdgcn_exp2f(s0.x - M), w1 = s1.y * __builtin_amdgcn_exp2f(s1.x - M);
    const float inv = __builtin_amdgcn_rcpf(w0 + w1); w0 *= inv; w1 *= inv;
    bf16* op = Omix + (size_t)t * 2048 + h * VH + dd;
    const v4u a = *(const GAS v4u*)op, bq = *(const GAS v4u*)(OTMP + (size_t)t * 1024 + h * VH + dd);
    v4u o; o.x = pk2(w0 * bflo(a.x) + w1 * bflo(bq.x), w0 * bfhi(a.x) + w1 * bfhi(bq.x)); o.y = pk2(w0 * bflo(a.y) + w1 * bflo(bq.y), w0 * bfhi(a.y) + w1 * bfhi(bq.y));
    o.z = pk2(w0 * bflo(a.z) + w1 * bflo(bq.z), w0 * bfhi(a.z) + w1 * bfhi(bq.z)); o.w = pk2(w0 * bflo(a.w) + w1 * bflo(bq.w), w0 * bfhi(a.w) + w1 * bfhi(bq.w));
    *(GAS v4u*)op = o;
}
__device__ __forceinline__ void attn_merge4(int base, int stride, int nvalid, bf16* Omix, const bf16* OTMP, const f32x2* ST, int lane) {
    f32x2 s0[4], s1[4]; v4u a[4], bq[4];
#pragma unroll
    for (int i = 0; i < 4; ++i) { const int item = (i < nvalid) ? base + i * stride : base; const int t = item >> 1, h = (item & 1) * 4 + (lane >> 4), dd = (lane & 15) * 8;
        s0[i] = ST[(size_t)t * MLA_H + h]; s1[i] = ST[(size_t)(T + t) * MLA_H + h];
        a[i] = *(const GAS v4u*)(Omix + (size_t)t * 2048 + h * VH + dd); bq[i] = *(const GAS v4u*)(OTMP + (size_t)t * 1024 + h * VH + dd); }
#pragma unroll
    for (int i = 0; i < 4; ++i) if (i < nvalid && (((base + i * stride) >> 1) % SEQ) >= ATT_SPLIT_QB * 256) { const int item = base + i * stride; const int t = item >> 1, h = (item & 1) * 4 + (lane >> 4), dd = (lane & 15) * 8;
        const float M = fmaxf(s0[i].x, s1[i].x);
        float w0 = s0[i].y * __builtin_amdgcn_exp2f(s0[i].x - M), w1 = s1[i].y * __builtin_amdgcn_exp2f(s1[i].x - M);
        const float inv = __builtin_amdgcn_rcpf(w0 + w1); w0 *= inv; w1 *= inv;
        v4u o; o.x = pk2(w0 * bflo(a[i].x) + w1 * bflo(bq[i].x), w0 * bfhi(a[i].x) + w1 * bfhi(bq[i].x)); o.y = pk2(w0 * bflo(a[i].y) + w1 * bflo(bq[i].y), w0 * bfhi(a[i].y) + w1 * bfhi(bq[i].y));
        o.z = pk2(w0 * bflo(a[i].z) + w1 * bflo(bq[i].z), w0 * bfhi(a[i].z) + w1 * bfhi(bq[i].z)); o.w = pk2(w0 * bflo(a[i].w) + w1 * bflo(bq[i].w), w0 * bfhi(a[i].w) + w1 * bfhi(bq[i].w));
        *(GAS v4u*)(Omix + (size_t)t * 2048 + h * VH + dd) = o; }
}
}

namespace ck {
constexpr int CH = 32, NCH = SEQ / CH;
constexpr int PCK = 72, PKC = 32, PCC = 32;
constexpr int O_AT = 0, O_BT = 4608, O_KT = 9216, O_RT = 13824;
constexpr int O_P0 = 0, O_PT0 = 2048, O_P1 = 4096, O_PT1 = 6144, O_TT0 = 8192, O_TT1 = 10240, O_MAK = 12288, O_MBRT = 14336, O_G1 = 16384;
constexpr int O_AT2 = 0, O_VKT = 4096;
constexpr int O_ATT = 18432, O_RTT = 22528, O_BBT = 26624, O_KBT = 30720, O_VC = 34816, O_GC = 38912;
constexpr int UNIT_LDS = 39424, UNITS_PER_WG = 4;
static_assert(O_GC + 256 <= UNIT_LDS && UNITS_PER_WG * UNIT_LDS <= LDSCTL_OFF, "chunk_pre LDS");
typedef float ck_f32x2 __attribute__((ext_vector_type(2))); typedef __bf16 ck_bf16x2 __attribute__((ext_vector_type(2)));
__device__ __forceinline__ unsigned cvt2(float lo, float hi) { ck_f32x2 v = {lo, hi}; ck_bf16x2 b = __builtin_convertvector(v, ck_bf16x2); return __builtin_bit_cast(unsigned, b); }
__device__ __forceinline__ int crow(int r, int hi) { return (r & 3) + 8 * (r >> 2) + 4 * hi; }
__device__ __forceinline__ void zero16(f32x16& a) {
#pragma unroll
    for (int r = 0; r < 16; ++r) a[r] = 0.f; }
template <int KD> __device__ __forceinline__ void mm(f32x16& acc, const LAS unsigned char* X, int px, int xr0, const LAS unsigned char* YT, int py, int yr0, int r32, int hi) {
#pragma unroll
    for (int ks = 0; ks < KD / 16; ++ks) {
        const bf16x8 a = *(const LAS bf16x8*)(X + ((xr0 + r32) * px + ks * 16 + 8 * hi) * 2);
        const bf16x8 b = *(const LAS bf16x8*)(YT + ((yr0 + r32) * py + ks * 16 + 8 * hi) * 2);
        acc = __builtin_amdgcn_mfma_f32_32x32x16_bf16(a, b, acc, 0, 0, 0);
    }
}
__device__ __forceinline__ void storeT(const f32x16& acc, LAS unsigned char* dst, int pd, int r0, int c0, int r32, int hi) {
#pragma unroll
    for (int g = 0; g < 4; ++g) { v2u w; w.x = cvt2(acc[4 * g], acc[4 * g + 1]); w.y = cvt2(acc[4 * g + 2], acc[4 * g + 3]);
        *(LAS v2u*)(dst + ((r0 + r32) * pd + c0 + 8 * g + 4 * hi) * 2) = w; }
}
__device__ __forceinline__ void storeTg(const f32x16& acc, bf16* dst, int pd, int r0, int c0, int r32, int hi) {
#pragma unroll
    for (int g = 0; g < 4; ++g) { v2u w; w.x = cvt2(acc[4 * g], acc[4 * g + 1]); w.y = cvt2(acc[4 * g + 2], acc[4 * g + 3]);
        *(GAS v2u*)(dst + (size_t)(r0 + r32) * pd + c0 + 8 * g + 4 * hi) = w; }
}
__device__ __forceinline__ bf16x8 idfrag(int ks, int r32, int hi) {
    bf16x8 f;
#pragma unroll
    for (int j = 0; j < 8; ++j) f[j] = (ks * 16 + 8 * hi + j == r32) ? (short)0x3F80 : (short)0;
    return f;
}

struct Bat { unsigned short zr[8], zk[8], zv[8], lw[8], la[8]; };
#define CKA_LOAD(B, zp_, lp_, tb) do { _Pragma("unroll") for (int i = 0; i < 8; ++i) { const bf16* z1 = (zp_) + (size_t)((tb) + i) * ZW; B.zr[i] = z1[Z_R]; B.zk[i] = z1[Z_K]; B.zv[i] = z1[Z_V]; \
            B.lw[i] = (lp_)[(size_t)((tb) + i) * LW]; B.la[i] = (lp_)[(size_t)((tb) + i) * LW + 1024]; } } while (0)
__device__ __forceinline__ void preload(int unit, const bf16* Z, const bf16* L, Bat& B0, Bat& B1, unsigned short& qr, unsigned short& qk, unsigned short& qv, int lane) {
    const int chain = unit >> 7, c = unit & 127, b = chain >> 4, h = chain & 15, ch = h * 64 + lane, t0 = b * SEQ + c * CH;
    const bf16* zp = Z + (size_t)t0 * ZW + ch; const bf16* lp = L + (size_t)t0 * LW + ch;
    qr = 0; qk = 0; qv = 0;
    if (c > 0) { qr = zp[Z_R - ZW]; qk = zp[Z_K - ZW]; qv = zp[Z_V - ZW]; }
    CKA_LOAD(B0, zp, lp, 0); CKA_LOAD(B1, zp, lp, 8);
}
__device__ __forceinline__ void chunk_pre(int unit, const bf16* Z, const bf16* L, const float* mu, const float* w0, const float* a0, const float* k_k, const float* k_a, const float* r_k,
                                          float* BONUS, bf16* TRT, unsigned* SLOT, bf16* RRT, bf16* G2T, bf16* VCG, LAS unsigned char* lds, int lane,
                                          Bat& B0, Bat& B1, unsigned short& qr, unsigned short& qk, unsigned short& qv, int nxt) {
    const int chain = unit >> 7, c = unit & 127, b = chain >> 4, h = chain & 15, ch = h * 64 + lane, r32 = lane & 31, hi = lane >> 5;
    const int t0 = b * SEQ + c * CH;
    LAS bf16* At = (LAS bf16*)(lds + O_AT); LAS bf16* Bt = (LAS bf16*)(lds + O_BT); LAS bf16* Kt = (LAS bf16*)(lds + O_KT); LAS bf16* Rt = (LAS bf16*)(lds + O_RT);
    LAS bf16* AtT = (LAS bf16*)(lds + O_ATT); LAS bf16* RtT = (LAS bf16*)(lds + O_RTT); LAS bf16* BbT = (LAS bf16*)(lds + O_BBT); LAS bf16* KbT = (LAS bf16*)(lds + O_KBT);
    LAS bf16* Vc = (LAS bf16*)(lds + O_VC);
    {
        const float mu_r = mu[ch], mu_k = mu[1024 + ch], mu_v = mu[2048 + ch], w0c = w0[ch], a0c = a0[ch], kkc = k_k[ch], kac = k_a[ch], rkc = r_k[ch];
        const bf16* zp = Z + (size_t)t0 * ZW + ch; const bf16* lp = L + (size_t)t0 * LW + ch;
        float pr = bf2f(qr), pk = bf2f(qk), pv = bf2f(qv);
        float gam = 1.0f, mybon = 0.f;
        unsigned aRow = (unsigned)(size_t)(At + lane), aCol = (unsigned)(size_t)(AtT + lane * PKC);
        asm volatile("" : "+v"(aRow), "+v"(aCol));
#define CK_W16(base, off, v) (*(LAS bf16*)(size_t)((base) + (unsigned)(off)) = (v))
#define CKA_PROC(B, tb) do { unsigned short at8[8], rt8[8], vv8[8]; \
        _Pragma("unroll") for (int hf = 0; hf < 2; ++hf) { float r4[4], dec4[4], a4[4], kk4[4], kp4[4], n24[4], bo4[4]; \
        _Pragma("unroll") for (int j = 0; j < 4; ++j) { const int i = 4 * hf + j; \
            const float rc = bf2f(B.zr[i]), kc = bf2f(B.zk[i]), vc = bf2f(B.zv[i]); \
            r4[j] = rc + (pr - rc) * mu_r; const float k_ = kc + (pk - kc) * mu_k; vv8[i] = (unsigned short)(cvt2(vc + (pv - vc) * mu_v, 0.f) & 0xffffu); \
            pr = rc; pk = kc; pv = vc; \
            dec4[j] = __builtin_amdgcn_exp2f(-0.8750612633917001f * sigmoidf_(w0c + bf2f(B.lw[i]))); \
            a4[j] = sigmoidf_(a0c + bf2f(B.la[i])); \
            kk4[j] = k_ * kkc; n24[j] = kk4[j] * kk4[j]; \
            kp4[j] = k_ * (1.0f + (a4[j] - 1.0f) * kac); bo4[j] = r4[j] * kp4[j] * rkc; } \
        _Pragma("unroll") for (int j = 0; j < 4; ++j) { n24[j] = wave_sum_dpp(n24[j]); bo4[j] = wave_sum_dpp(bo4[j]); }     \
        _Pragma("unroll") for (int j = 0; j < 4; ++j) { const int i = 4 * hf + j, t = (tb) + i; \
            const float kk = kk4[j] * __builtin_amdgcn_rsqf(fmaxf(n24[j], 1e-24f)); \
            mybon = (lane == t) ? bo4[j] : mybon; \
            const float gprev = gam; gam *= dec4[j]; const float ig = __builtin_amdgcn_rcpf(gam); \
            const unsigned ar = cvt2(-gprev * kk, gam * r4[j]), bk = cvt2(kk * a4[j] * ig, kp4[j] * ig); \
            at8[i] = (unsigned short)(ar & 0xffffu); rt8[i] = (unsigned short)(ar >> 16); \
            CK_W16(aRow, t * PCK * 2, at8[i]); \
            CK_W16(aRow, (O_BT - O_AT) + t * PCK * 2, (bf16)(bk & 0xffffu)); CK_W16(aRow, (O_KT - O_AT) + t * PCK * 2, (bf16)(bk >> 16)); \
            CK_W16(aRow, (O_RT - O_AT) + t * PCK * 2, rt8[i]); } } \
          \
        { v4u q_; q_.x = at8[0] | ((unsigned)at8[1] << 16); q_.y = at8[2] | ((unsigned)at8[3] << 16); q_.z = at8[4] | ((unsigned)at8[5] << 16); q_.w = at8[6] | ((unsigned)at8[7] << 16); \
          *(LAS v4u*)(size_t)(aCol + (unsigned)((tb) * 2)) = q_; \
          q_.x = rt8[0] | ((unsigned)rt8[1] << 16); q_.y = rt8[2] | ((unsigned)rt8[3] << 16); q_.z = rt8[4] | ((unsigned)rt8[5] << 16); q_.w = rt8[6] | ((unsigned)rt8[7] << 16); \
          *(LAS v4u*)(size_t)(aCol + (unsigned)((O_RTT - O_ATT) + (tb) * 2)) = q_; \
          q_.x = vv8[0] | ((unsigned)vv8[1] << 16); q_.y = vv8[2] | ((unsigned)vv8[3] << 16); q_.z = vv8[4] | ((unsigned)vv8[5] << 16); q_.w = vv8[6] | ((unsigned)vv8[7] << 16); \
          *(LAS v4u*)(size_t)(aCol + (unsigned)((O_VC - O_ATT) + (tb) * 2)) = q_; } } while (0)
        CKA_PROC(B0, 0); asm volatile("" ::: "memory"); CKA_LOAD(B0, zp, lp, 16); asm volatile("" ::: "memory");
        CKA_PROC(B1, 8); asm volatile("" ::: "memory"); CKA_LOAD(B1, zp, lp, 24); asm volatile("" ::: "memory");
        CKA_PROC(B0, 16); asm volatile("" ::: "memory"); CKA_PROC(B1, 24); asm volatile("" ::: "memory");
#undef CKA_PROC
#undef CK_W16
        if (lane < CH) BONUS[(size_t)(t0 + lane) * RH + h] = mybon;
        const float gcr = bf2f((bf16)(cvt2(gam, 0.f) & 0xffffu));
        ((LAS float*)(lds + O_GC))[lane] = gcr;
#pragma unroll
        for (int t = 0; t < CH; t += 8) { v4u qb, qk;
            qb.x = cvt2(bf2f(Bt[t * PCK + lane]) * gam, bf2f(Bt[(t + 1) * PCK + lane]) * gam); qb.y = cvt2(bf2f(Bt[(t + 2) * PCK + lane]) * gam, bf2f(Bt[(t + 3) * PCK + lane]) * gam);
            qb.z = cvt2(bf2f(Bt[(t + 4) * PCK + lane]) * gam, bf2f(Bt[(t + 5) * PCK + lane]) * gam); qb.w = cvt2(bf2f(Bt[(t + 6) * PCK + lane]) * gam, bf2f(Bt[(t + 7) * PCK + lane]) * gam);
            qk.x = cvt2(bf2f(Kt[t * PCK + lane]) * gam, bf2f(Kt[(t + 1) * PCK + lane]) * gam); qk.y = cvt2(bf2f(Kt[(t + 2) * PCK + lane]) * gam, bf2f(Kt[(t + 3) * PCK + lane]) * gam);
            qk.z = cvt2(bf2f(Kt[(t + 4) * PCK + lane]) * gam, bf2f(Kt[(t + 5) * PCK + lane]) * gam); qk.w = cvt2(bf2f(Kt[(t + 6) * PCK + lane]) * gam, bf2f(Kt[(t + 7) * PCK + lane]) * gam);
            *(LAS v4u*)(BbT + lane * PKC + t) = qb; *(LAS v4u*)(KbT + lane * PKC + t) = qk; }
    }
    f32x16 accM, accMT, accG2, accT, accMakT, accMbr;
    zero16(accM); zero16(accMT); zero16(accMakT); zero16(accMbr); zero16(accG2);
    mm<64>(accM, lds + O_BT, PCK, 0, lds + O_AT, PCK, 0, r32, hi);
    mm<64>(accMT, lds + O_AT, PCK, 0, lds + O_BT, PCK, 0, r32, hi);
    mm<64>(accMakT, lds + O_AT, PCK, 0, lds + O_KT, PCK, 0, r32, hi);
    mm<64>(accMbr, lds + O_BT, PCK, 0, lds + O_RT, PCK, 0, r32, hi);
    mm<64>(accG2, lds + O_KT, PCK, 0, lds + O_RT, PCK, 0, r32, hi);
#pragma unroll
    for (int r = 0; r < 16; ++r) { const int row = crow(r, hi);
        accM[r] = (row < r32) ? accM[r] : 0.f; accMT[r] = (r32 < row) ? accMT[r] : 0.f; accMakT[r] = (r32 < row) ? accMakT[r] : 0.f;
        accMbr[r] = (row <= r32) ? accMbr[r] : 0.f; accG2[r] = (row <= r32) ? accG2[r] : 0.f; }
    asm volatile("" : "+v"(accM), "+v"(accMT), "+v"(accMakT), "+v"(accMbr), "+v"(accG2));
    storeT(accMT, lds + O_P0, PCC, 0, 0, r32, hi);
    storeT(accM, lds + O_PT0, PCC, 0, 0, r32, hi);
    storeT(accMakT, lds + O_MAK, PCC, 0, 0, r32, hi);
    storeT(accMbr, lds + O_MBRT, PCC, 0, 0, r32, hi);
    accT = accM;
#pragma unroll
    for (int r = 0; r < 16; ++r) if (crow(r, hi) == r32) accT[r] += 1.0f;
    storeT(accT, lds + O_TT0, PCC, 0, 0, r32, hi);
    if (nxt >= 0) preload(nxt, Z, L, B0, B1, qr, qk, qv, lane);
    {   f32x16 aP, aPT;
        zero16(aP); zero16(aPT);
        mm<32>(aP, lds + O_P0, PCC, 0, lds + O_PT0, PCC, 0, r32, hi); mm<32>(aPT, lds + O_PT0, PCC, 0, lds + O_P0, PCC, 0, r32, hi);
        storeT(aPT, lds + O_P1, PCC, 0, 0, r32, hi); storeT(aP, lds + O_PT1, PCC, 0, 0, r32, hi);
        mm<32>(accT, lds + O_P1, PCC, 0, lds + O_TT0, PCC, 0, r32, hi); storeT(accT, lds + O_TT1, PCC, 0, 0, r32, hi);
        zero16(aP); zero16(aPT);
        mm<32>(aP, lds + O_P1, PCC, 0, lds + O_PT1, PCC, 0, r32, hi); mm<32>(aPT, lds + O_PT1, PCC, 0, lds + O_P1, PCC, 0, r32, hi);
        storeT(aPT, lds + O_P0, PCC, 0, 0, r32, hi); storeT(aP, lds + O_PT0, PCC, 0, 0, r32, hi);
        mm<32>(accT, lds + O_P0, PCC, 0, lds + O_TT1, PCC, 0, r32, hi); storeT(accT, lds + O_TT0, PCC, 0, 0, r32, hi);
        zero16(aP); zero16(aPT);
        mm<32>(aP, lds + O_P0, PCC, 0, lds + O_PT0, PCC, 0, r32, hi); mm<32>(aPT, lds + O_PT0, PCC, 0, lds + O_P0, PCC, 0, r32, hi);
        storeT(aPT, lds + O_P1, PCC, 0, 0, r32, hi); storeT(aP, lds + O_PT1, PCC, 0, 0, r32, hi);
        mm<32>(accT, lds + O_P1, PCC, 0, lds + O_TT0, PCC, 0, r32, hi); storeT(accT, lds + O_TT1, PCC, 0, 0, r32, hi);
        zero16(aPT);
        mm<32>(aPT, lds + O_PT1, PCC, 0, lds + O_P1, PCC, 0, r32, hi);
        storeT(aPT, lds + O_P0, PCC, 0, 0, r32, hi);
        mm<32>(accT, lds + O_P0, PCC, 0, lds + O_TT1, PCC, 0, r32, hi); storeT(accT, lds + O_TT0, PCC, 0, 0, r32, hi);
    }
    {   f32x16 acc; zero16(acc);
        mm<32>(acc, lds + O_TT0, PCC, 0, lds + O_MAK, PCC, 0, r32, hi);
        storeT(acc, lds + O_G1, PCC, 0, 0, r32, hi);
#pragma unroll
        for (int kb = 0; kb < 2; ++kb) { zero16(acc);
            mm<32>(acc, lds + O_TT0, PCC, 0, lds + O_ATT, PKC, 32 * kb, r32, hi);
            storeT(acc, lds + O_AT2, PKC, 32 * kb, 0, r32, hi); }
        mm<32>(accG2, lds + O_G1, PCC, 0, lds + O_MBRT, PCC, 0, r32, hi);
        storeTg(accG2, G2T + (size_t)unit * 1024, 32, 0, 0, r32, hi);
        const bf16x8 id0 = idfrag(0, r32, hi), id1 = idfrag(1, r32, hi);
#pragma unroll
        for (int kb = 0; kb < 2; ++kb) { zero16(acc);
            mm<32>(acc, lds + O_AT2, PKC, 32 * kb, lds + O_MBRT, PCC, 0, r32, hi);
            acc = __builtin_amdgcn_mfma_f32_32x32x16_bf16(*(const LAS bf16x8*)(lds + O_RTT + ((32 * kb + r32) * PKC + 8 * hi) * 2), id0, acc, 0, 0, 0);
            acc = __builtin_amdgcn_mfma_f32_32x32x16_bf16(*(const LAS bf16x8*)(lds + O_RTT + ((32 * kb + r32) * PKC + 16 + 8 * hi) * 2), id1, acc, 0, 0, 0);
            storeTg(acc, RRT + (size_t)unit * 2048, 64, 0, 32 * kb, r32, hi); }
        const float gcv0 = ((const LAS float*)(lds + O_GC))[r32], gcv1 = ((const LAS float*)(lds + O_GC))[32 + r32];
#pragma unroll
        for (int rb = 0; rb < 2; ++rb)
#pragma unroll
            for (int cb = 0; cb < 2; ++cb) { zero16(acc);
                mm<32>(acc, lds + O_AT2, PKC, 32 * rb, lds + O_BBT, PKC, 32 * cb, r32, hi);
                if (rb == cb) { const float gv = cb ? gcv1 : gcv0;
#pragma unroll
                    for (int r = 0; r < 16; ++r) if (crow(r, hi) == r32) acc[r] += gv; }
                storeTg(acc, TRT + (size_t)unit * 4096, 64, 32 * cb, 32 * rb, r32, hi); }
#pragma unroll
        for (int cb = 0; cb < 2; ++cb) { zero16(acc);
            mm<32>(acc, lds + O_G1, PCC, 0, lds + O_BBT, PKC, 32 * cb, r32, hi);
            acc = __builtin_amdgcn_mfma_f32_32x32x16_bf16(id0, *(const LAS bf16x8*)(lds + O_KBT + ((32 * cb + r32) * PKC + 8 * hi) * 2), acc, 0, 0, 0);
            acc = __builtin_amdgcn_mfma_f32_32x32x16_bf16(id1, *(const LAS bf16x8*)(lds + O_KBT + ((32 * cb + r32) * PKC + 16 + 8 * hi) * 2), acc, 0, 0, 0);
            storeT(acc, lds + O_VKT, PKC, 32 * cb, 0, r32, hi); }
#pragma unroll
        for (int vb = 0; vb < 2; ++vb)
#pragma unroll
            for (int kb = 0; kb < 2; ++kb) { zero16(acc);
                mm<32>(acc, lds + O_VKT, PKC, 32 * kb, lds + O_VC, PKC, 32 * vb, r32, hi);
                v4u q0, q1; q0.x = cvt2(acc[0], acc[1]); q0.y = cvt2(acc[2], acc[3]); q0.z = cvt2(acc[4], acc[5]); q0.w = cvt2(acc[6], acc[7]);
                q1.x = cvt2(acc[8], acc[9]); q1.y = cvt2(acc[10], acc[11]); q1.z = cvt2(acc[12], acc[13]); q1.w = cvt2(acc[14], acc[15]);
                GAS v4u* sl = (GAS v4u*)(SLOT + (size_t)unit * 2048 + ((vb * 2 + kb) * 64 + lane) * 8);
                sl[0] = q0; sl[1] = q1; }
        {   const LAS v4u* vs = (const LAS v4u*)(lds + O_VC + lane * PKC * 2);
            GAS v4u* vd = (GAS v4u*)(VCG + (size_t)unit * 2048 + lane * 32);
            vd[0] = vs[0]; vd[1] = vs[1]; vd[2] = vs[2]; vd[3] = vs[3]; }
    }
}

constexpr int CHN_SLOT = 17408, CHN_S = 2 * CHN_SLOT, CHN_PT = 72;
#define CHN_BAR() do { asm volatile("s_waitcnt lgkmcnt(0)" ::: "memory"); __builtin_amdgcn_s_barrier(); asm volatile("" ::: "memory"); } while (0)
__device__ __forceinline__ void rwkv_chain(int chain, const bf16* TRT, unsigned* SLOT, LAS unsigned char* lds, int tid) {
    const int lane = tid & 63, wv = __builtin_amdgcn_readfirstlane(tid >> 6), r32 = lane & 31, hi = lane >> 5;
    constexpr int NIT = NCH - 1;
    if (wv >= 2 && wv < 6) {
        const int lt = tid - 128;
        const unsigned char* gT = (const unsigned char*)(TRT + (size_t)chain * NCH * 4096);
        const unsigned char* gS = (const unsigned char*)(SLOT + (size_t)chain * NCH * 2048);
        const bool isT = lt < 128;
        const unsigned char* gsrc = isT ? gT + lt * 64 : gS + (lt - 128) * 64;
        const int ldst = isT ? ((lt >> 1) * (CHN_PT * 2) + (lt & 1) * 64) : (64 * CHN_PT * 2 + (lt - 128) * 64);
        struct Set { v4u q[4]; };
        Set R0, R1, R2, R3, R4, R5, R6, R7;
#define CH_RAW(R, c_) do { const int cc_ = ((c_) < NIT) ? (c_) : NIT - 1; const unsigned char* p_ = gsrc + (size_t)cc_ * 8192; \
        _Pragma("unroll") for (int i_ = 0; i_ < 4; ++i_) R.q[i_] = *(const GAS v4u*)(p_ + 16 * i_); } while (0)
#define CH_PUT(R, buf) do { LAS unsigned char* d_ = lds + (buf) * CHN_SLOT + ldst; \
        _Pragma("unroll") for (int i_ = 0; i_ < 4; ++i_) *(LAS v4u*)(d_ + 16 * i_) = R.q[i_]; } while (0)
#define CH_ITER(R, c_) do { CH_PUT(R, ((c_) + 1) & 1); CH_RAW(R, (c_) + 9); CHN_BAR(); } while (0)
        CH_RAW(R0, 0); CH_RAW(R1, 1); CH_RAW(R2, 2); CH_RAW(R3, 3); CH_RAW(R4, 4); CH_RAW(R5, 5); CH_RAW(R6, 6); CH_RAW(R7, 7);
        CH_PUT(R0, 0); CH_RAW(R0, 8);
        CHN_BAR();
        for (int c = 0; c + 7 < NIT; c += 8) { CH_ITER(R1, c); CH_ITER(R2, c + 1); CH_ITER(R3, c + 2); CH_ITER(R4, c + 3); CH_ITER(R5, c + 4); CH_ITER(R6, c + 5); CH_ITER(R7, c + 6); CH_ITER(R0, c + 7); }
        CH_ITER(R1, 120); CH_ITER(R2, 121); CH_ITER(R3, 122); CH_ITER(R4, 123); CH_ITER(R5, 124); CH_ITER(R6, 125); CH_ITER(R7, 126);
#undef CH_RAW
#undef CH_PUT
#undef CH_ITER
    } else if (wv < 2) {
        const int vb = wv;
        LAS unsigned char* sl = lds + CHN_S + vb * (32 * CHN_PT * 2);
        for (int i = lane; i < 32 * CHN_PT / 2; i += 64) ((LAS unsigned*)sl)[i] = 0u;
        CHN_BAR();
        for (int c = 0; c < NIT; ++c) {
            const LAS unsigned char* bs = lds + (c & 1) * CHN_SLOT;
            bf16x8 sfr[4];
#pragma unroll
            for (int ks = 0; ks < 4; ++ks) sfr[ks] = *(const LAS bf16x8*)(sl + (r32 * CHN_PT + 16 * ks + 8 * hi) * 2);
            bf16* sg = (bf16*)(SLOT + ((size_t)chain * NCH + c) * 2048 + vb * 1024);
            f32x16 acc[2]; bf16x8 tr[2][4];
#pragma unroll
            for (int kb = 0; kb < 2; ++kb) {
                const LAS v4u* wp = (const LAS v4u*)(bs + 64 * CHN_PT * 2 + ((vb * 2 + kb) * 64 + lane) * 32);
                const v4u w0 = wp[0], w1 = wp[1];
                acc[kb][0] = bflo(w0.x); acc[kb][1] = bfhi(w0.x); acc[kb][2] = bflo(w0.y); acc[kb][3] = bfhi(w0.y); acc[kb][4] = bflo(w0.z); acc[kb][5] = bfhi(w0.z); acc[kb][6] = bflo(w0.w); acc[kb][7] = bfhi(w0.w);
                acc[kb][8] = bflo(w1.x); acc[kb][9] = bfhi(w1.x); acc[kb][10] = bflo(w1.y); acc[kb][11] = bfhi(w1.y); acc[kb][12] = bflo(w1.z); acc[kb][13] = bfhi(w1.z); acc[kb][14] = bflo(w1.w); acc[kb][15] = bfhi(w1.w);
#pragma unroll
                for (int ks = 0; ks < 4; ++ks) tr[kb][ks] = *(const LAS bf16x8*)(bs + ((32 * kb + r32) * CHN_PT + 16 * ks + 8 * hi) * 2);
            }
#pragma unroll
            for (int ks = 0; ks < 4; ++ks) {
                acc[0] = __builtin_amdgcn_mfma_f32_32x32x16_bf16(tr[0][ks], sfr[ks], acc[0], 0, 0, 0);
                acc[1] = __builtin_amdgcn_mfma_f32_32x32x16_bf16(tr[1][ks], sfr[ks], acc[1], 0, 0, 0); }
#pragma unroll
            for (int kb = 0; kb < 2; ++kb) { storeT(acc[kb], sl, CHN_PT, 0, 32 * kb, r32, hi); storeTg(acc[kb], sg, 64, 0, 32 * kb, r32, hi); }
            CHN_BAR();
        }
    } else {
        for (int c = 0; c < NIT + 1; ++c) CHN_BAR();
    }
}

#undef CHN_BAR
__device__ __forceinline__ void rwkv_out_item(int unit, const unsigned* SLOT, const bf16* RRT, const bf16* G2T, const bf16* VCG, const float* BONUS, const bf16* Z, const bf16* L,
                                              const float* mu, const float* lnw, const float* lnb, bf16* Omix, int lane) {
    const int chain = unit >> 7, c = unit & 127, b = chain >> 4, h = chain & 15, r32 = lane & 31, hi = lane >> 5;
    const int t = b * SEQ + c * CH + r32;
    f32x16 o[2]; zero16(o[0]); zero16(o[1]);
    if (c > 0) {
        bf16x8 rr[4];
#pragma unroll
        for (int ks = 0; ks < 4; ++ks) rr[ks] = *(const GAS bf16x8*)(RRT + (size_t)unit * 2048 + r32 * 64 + 16 * ks + 8 * hi);
#pragma unroll
        for (int vb = 0; vb < 2; ++vb) { const bf16* sg = (const bf16*)(SLOT + (size_t)(unit - 1) * 2048 + vb * 1024);
#pragma unroll
            for (int ks = 0; ks < 4; ++ks) o[vb] = __builtin_amdgcn_mfma_f32_32x32x16_bf16(*(const GAS bf16x8*)(sg + r32 * 64 + 16 * ks + 8 * hi), rr[ks], o[vb], 0, 0, 0); }
    }
    {   bf16x8 g2[2];
#pragma unroll
        for (int ks = 0; ks < 2; ++ks) g2[ks] = *(const GAS bf16x8*)(G2T + (size_t)unit * 1024 + r32 * 32 + 16 * ks + 8 * hi);
#pragma unroll
        for (int vb = 0; vb < 2; ++vb)
#pragma unroll
            for (int ks = 0; ks < 2; ++ks) o[vb] = __builtin_amdgcn_mfma_f32_32x32x16_bf16(*(const GAS bf16x8*)(VCG + (size_t)unit * 2048 + (32 * vb + r32) * 32 + 16 * ks + 8 * hi), g2[ks], o[vb], 0, 0, 0);
    }
    float s = 0.f;
#pragma unroll
    for (int r = 0; r < 16; ++r) s += o[0][r] + o[1][r];
    s += __shfl_xor(s, 32);
    const float mean = s * (1.f / 64.f); float q = 0.f;
#pragma unroll
    for (int r = 0; r < 16; ++r) { o[0][r] -= mean; o[1][r] -= mean; q += o[0][r] * o[0][r] + o[1][r] * o[1][r]; }
    q += __shfl_xor(q, 32);
    const float rstd = __builtin_amdgcn_rsqf(q * (1.f / 64.f) + GN_EPS);
    const float bon = BONUS[(size_t)t * RH + h];
    const bool first = (t % SEQ) == 0;
#pragma unroll
    for (int vb = 0; vb < 2; ++vb) {
        f32x4 lw4[4], lb4[4], mu4[4]; v2u vcw[4], vpw[4], gw[4];
#pragma unroll
        for (int g = 0; g < 4; ++g) { const int c4 = h * 64 + 32 * vb + 8 * g + 4 * hi;
            lw4[g] = *(const GAS f32x4*)(lnw + c4); lb4[g] = *(const GAS f32x4*)(lnb + c4); mu4[g] = *(const GAS f32x4*)(mu + 2048 + c4);
            vcw[g] = *(const GAS v2u*)(Z + (size_t)t * ZW + Z_V + c4);
            vpw[g].x = 0u; vpw[g].y = 0u; if (!first) vpw[g] = *(const GAS v2u*)(Z + (size_t)t * ZW - ZW + Z_V + c4);
            gw[g] = *(const GAS v2u*)(L + (size_t)t * LW + 2048 + c4); }
#pragma unroll
        for (int g = 0; g < 4; ++g) { const int c4 = h * 64 + 32 * vb + 8 * g + 4 * hi;
            const float vc[4] = {bflo(vcw[g].x), bfhi(vcw[g].x), bflo(vcw[g].y), bfhi(vcw[g].y)}, vp[4] = {bflo(vpw[g].x), bfhi(vpw[g].x), bflo(vpw[g].y), bfhi(vpw[g].y)}, gg[4] = {bflo(gw[g].x), bfhi(gw[g].x), bflo(gw[g].y), bfhi(gw[g].y)};
            float y[4];
#pragma unroll
            for (int e = 0; e < 4; ++e) { const float v = vc[e] + (vp[e] - vc[e]) * mu4[g][e]; y[e] = (o[vb][4 * g + e] * rstd * lw4[g][e] + lb4[g][e] + bon * v) * gg[e]; }
            v2u ow; ow.x = pk2(y[0], y[1]); ow.y = pk2(y[2], y[3]);
            *(GAS v2u*)(Omix + (size_t)t * 2048 + 1024 + c4) = ow; }
    }
}
}


#define WIN ((bf16*)(ws + WS_WIN))
#define WKPE ((bf16*)(ws + WS_WKPE))
#define KPEP ((float*)(ws + WS_KPEP))
#define WQB ((bf16*)(ws + WS_WQB))
#define WKVB ((bf16*)(ws + WS_WKVB))
#define WLORA ((bf16*)(ws + WS_WLORA))
#define WOUT ((bf16*)(ws + WS_WOUT))
#define WPG ((bf16*)(ws + WS_WPG))
#define WPP ((bf16*)(ws + WS_WPP))
#define WGU ((bf16*)(ws + WS_WGU))
#define WD ((bf16*)(ws + WS_WD))
#define WD2 ((bf16*)(ws + WS_WD2))
#define H ((bf16*)(ws + WS_H))
#define U ((bf16*)(ws + WS_U))
#define Zb ((bf16*)(ws + WS_Z))
#define AQ ((bf16*)(ws + WS_AQ))
#define AKV ((bf16*)(ws + WS_AKV))
#define AL ((bf16*)(ws + WS_AL))
#define QRAW ((bf16*)(ws + WS_QRAW))
#define KVRAW ((bf16*)(ws + WS_KVRAW))
#define LORA ((bf16*)(ws + WS_LORA))
#define QH ((bf16*)(ws + WS_QH))
#define KH ((bf16*)(ws + WS_KH))
#define VT ((bf16*)(ws + WS_VT))
#define OMIX ((bf16*)(ws + WS_OMIX))
#define TRT ((bf16*)(ws + WS_TRT))
#define OTMP ((bf16*)(ws + WS_OTMP))
#define AST ((f32x2*)(ws + WS_AST))
#define SLOT ((unsigned*)((char*)out + 24 * MiB))
#define RRT ((bf16*)out)
#define G2T ((bf16*)out + (size_t)8 * 1024 * 1024)
#define VCG ((bf16*)(ws + WS_VCG))
#define BONUS ((float*)(ws + WS_BONUS))
#define PB ((bf16*)(ws + WS_PB))
#define PPLE ((float*)(ws + WS_PPLE))
#define ROPE ((f32x2*)(ws + WS_ROPE))
#define SS0 ((float*)(ws + WS_CTL) + CW_SS)
#define SS1 (SS0 + T)
#define SS2 (SS0 + 2 * T)
#define SS3 (SS0 + 3 * T)
__global__ void __launch_bounds__(NTHR, 2) mk_fwd(Args args) {
    extern __shared__ __attribute__((aligned(16))) unsigned char lds_raw[];
    LAS unsigned char* lds = (LAS unsigned char*)lds_raw;
    volatile LAS unsigned* MISC = (volatile LAS unsigned*)(lds + MISC_OFF);
    const int tid = threadIdx.x, lane = tid & 63, wave = __builtin_amdgcn_readfirstlane(tid >> 6);
    const int G = gridDim.x, bx = blockIdx.x, vcu = (G % 8 == 0) ? (bx % 8) * (G / 8) + bx / 8 : bx;
    unsigned char* ws = args.ws;
    gu32* ctl = (gu32*)(ws + WS_CTL);
    for (int u = tid; u < (LDS_BYTES - LDSCTL_OFF) / 4; u += NTHR) ((LAS unsigned*)(lds + LDSCTL_OFF))[u] = 0u;
    __syncthreads();
    XcdBarrier bar; bar.bar = (unsigned*)(ctl + CW_BAR); bar.x = 0; bar.st = nullptr;
    if (N_LAUNCHES == 1) bar = xcd_barrier_post((unsigned*)(ctl + CW_BAR), MISC + 8);
#define GRID_BAR() do { if (N_LAUNCHES == 1) xcd_barrier(bar); } while (0)
    const int lo = args.ph_lo, hi = args.ph_hi;
#define IN(k) (lo <= (k) && (k) < hi)
#define BOTH(k) (IN(k) && IN((k) + 1))
    const int gw = vcu * NWAVES + wave, NGW = G * NWAVES;
    const float* x = args.in[0]; float* out = args.out;
    LAS float* scr = (LAS float*)(lds + RING_OFF + wave * 16384);

    if (IN(0)) {
        int base = 0;
        run_job(mk_job(args.in[3], args.in[4], args.in[2], WGU, DM, FF, 2 * FF, DM, 0, 1), gw, NGW, base, scr, lane);
        run_job(mk_job(args.in[7], nullptr, args.in[6], WIN, DM, ZW, ZW, DM, 0, 0, 4160, 0, 768, 64), gw, NGW, base, scr, lane);
        run_job(mk_job(args.in[7], nullptr, args.in[6], WKPE, DM, 64, 256, DM, 0, 0, 4160, 768), gw, NGW, base, scr, lane);
        run_job(mk_job(args.in[5], nullptr, nullptr, WD, FF, DM, DM, FF, 0, 0), gw, NGW, base, scr, lane);
        for (int e = gw * 64 + lane; e < SEQ * 32; e += NGW * 64) { const int s = e >> 5, i = e & 31;
            const float inv_freq = __builtin_amdgcn_exp2f(-(float)i * (13.287712379549449f / 32.0f));
            float rev = ((float)s * inv_freq) * 0.15915494309189535f; rev -= floorf(rev);
            f32x2 cs; cs.x = __builtin_amdgcn_cosf(rev); cs.y = __builtin_amdgcn_sinf(rev); ROPE[e] = cs; }
        xb_pass(x, H, SS0, gw, NGW, lane);
        if (BOTH(0)) GRID_BAR();
    }
    if (IN(1)) {
        pg8::Gemm g{H, WGU, T, 2 * FF, DM}; pg8::StaticOrder S; S.init(T, 2 * FF, G, bx);
        pg8::EpiSwiGLU E{U, FF, SS0};
        pg8::gemm_phase<pg8::EpiSwiGLU, pg8::StaticOrder, true, true>(lds + RING_OFF, g, S, E);
        if (bx >= (G >> 1)) { int base = 0;
            const int gw2 = (bx - (G >> 1)) * NWAVES + wave, ngw2 = (G - (G >> 1)) * NWAVES;
            run_job(mk_job(args.in[25], nullptr, nullptr, WOUT, DM, DM, DM, DM, 0, 0), gw2, ngw2, base, scr, lane);
            run_job(mk_job(args.in[31], nullptr, args.in[30], WPG, DM, DM, DM, DM, 0, 0), gw2, ngw2, base, scr, lane);
            run_job(mk_job(args.in[9], nullptr, args.in[8], WQB, QL, 1536, 1536, QL, 0, 0), gw2, ngw2, base, scr, lane);
            run_job(mk_job(args.in[11], nullptr, args.in[10], WKVB, KVL, 2048, 2048, KVL, 0, 0), gw2, ngw2, base, scr, lane);
            run_job(mk_job(args.in[16], nullptr, nullptr, WLORA, 64, 1024, 1024, 256, 0, 0), gw2, ngw2, base, scr, lane);
            run_job(mk_job(args.in[18], nullptr, nullptr, WLORA + (size_t)1024 * 256, 64, 1024, 1024, 256, 64, 0), gw2, ngw2, base, scr, lane);
            run_job(mk_job(args.in[19], nullptr, nullptr, WLORA + (size_t)2048 * 256, 128, 1024, 1024, 256, 128, 0), gw2, ngw2, base, scr, lane);
            run_job(mk_job(args.in[32], nullptr, nullptr, WPP, PLE, DM, DM, PLE, 0, 0), gw2, ngw2, base, scr, lane);
            { const float* p = args.in[1];
              for (int e = gw2 * 64 + lane; e < T * PLE / 4; e += ngw2 * 64) { const f32x4 v = *(const GAS f32x4*)(p + (size_t)e * 4); v2u o; o.x = pk2(v.x, v.y); o.y = pk2(v.z, v.w); *(GAS v2u*)(PB + (size_t)e * 4) = o; } }
 }
        if (BOTH(1)) GRID_BAR();
    }
    if (IN(2)) {
        pg8::Gemm g{U, WD, T, DM, FF}; pg8::StaticOrder S; S.init(T, DM, G, bx);
        pg8::EpiRes<false> E{x, DM, 0.5f, H, SS1};
        pg8::gemm_phase<pg8::EpiRes<false>, pg8::StaticOrder, false, true>(lds + RING_OFF, g, S, E);
        if (IN(2) && IN(4)) GRID_BAR();
    }
    if (IN(4)) {
        pg8::Gemm g{H, WIN, T, ZW, DM}; pg8::StaticOrder S; S.init(T, ZW, G, bx);
        pg8::EpiBf16 E{Zb, ZW, SS1};
        pg8::gemm_phase<pg8::EpiBf16, pg8::StaticOrder, true, true>(lds + RING_OFF, g, S, E);
        if (BOTH(4)) GRID_BAR();
    }
    if (IN(5)) {
        { const f32x4 m4 = *(const GAS f32x4*)(args.in[14] + (Z_LORA - Z_R) + lane * 4);
          for (int t = gw; t < T; t += 2 * NGW) { const int t2 = t + NGW; const bool hb = t2 < T; PrepRow ra, rb;
              prep_load(ra, t, Zb, lane); if (hb) prep_load(rb, t2, Zb, lane);
              prep_finish(ra, t, m4, AQ, AKV, AL, lane); if (hb) prep_finish(rb, t2, m4, AQ, AKV, AL, lane); } }
        if (BOTH(5)) GRID_BAR();
    }
    if (IN(6)) {
        {   pg8::Gemm g{AQ, WQB, T, 1536, QL}; pg8::StaticOrder S; S.init(T, 1536, G, bx); pg8::EpiBf16 E{QRAW, 1536, nullptr};
            pg8::gemm_phase<pg8::EpiBf16, pg8::StaticOrder, true, true>(lds + RING_OFF, g, S, E); }
        {   pg8::Gemm g{AKV, WKVB, T, 2048, KVL}; pg8::StaticOrder S; S.init(T, 2048, G, (bx + 192) % G); pg8::EpiBf16 E{KVRAW, 2048, nullptr};
            pg8::gemm_phase<pg8::EpiBf16, pg8::StaticOrder, true, true>(lds + RING_OFF, g, S, E); }
        {   pg8::Gemm g{AL, WLORA, T, LW, 256}; pg8::StaticOrder S; S.init(T, LW, G, (bx + 64) % G); pg8::EpiBf16 E{LORA, LW, nullptr};
            pg8::gemm_phase<pg8::EpiBf16, pg8::StaticOrder, true, true>(lds + RING_OFF, g, S, E); }
        __syncthreads();
        if (G == 256) {
            if (bx >= 192) { kpe_task(2 * (bx - 192), H, WKPE, SS1, KPEP, lds, tid); kpe_task(2 * (bx - 192) + 1, H, WKPE, SS1, KPEP, lds, tid); }
            else if (bx >= 64) kpe_task(128 + (bx - 64), H, WKPE, SS1, KPEP, lds, tid);
        } else for (int task = (vcu + 64) % G; task < T / 32; task += G) kpe_task(task, H, WKPE, SS1, KPEP, lds, tid);
        if (BOTH(6)) GRID_BAR();
    }
    if (IN(7)) {
        if (wave < ck::UNITS_PER_WG) {
            ck::Bat B0, B1; unsigned short qr, qk, qv; const int NU = 32 * ck::NCH, st = ck::UNITS_PER_WG * G; int u = vcu * ck::UNITS_PER_WG + wave;
            if (u < NU) ck::preload(u, Zb, LORA, B0, B1, qr, qk, qv, lane);
            for (; u < NU; u += st)
                ck::chunk_pre(u, Zb, LORA, args.in[14], args.in[15], args.in[17], args.in[20], args.in[21], args.in[22], BONUS, TRT, SLOT, RRT, G2T, VCG, lds + wave * ck::UNIT_LDS, lane,
                              B0, B1, qr, qk, qv, (u + st < NU) ? u + st : -1);
        } else {
            const int nmw = NWAVES - ck::UNITS_PER_WG;
            for (int task = vcu * nmw + (wave - ck::UNITS_PER_WG); task < 16 * 64 * 8; task += G * nmw)
                mla_prep_task(task, QRAW, KVRAW, args.in[12], args.in[13], ROPE, QH, KH, VT, lane, KPEP);
            { int base = 0;
              run_job4(mk_job(args.in[29], nullptr, nullptr, WD2, FF, DM, 1024, FF, 0, 0, 0, 0, 1 << 30, 0, 0), vcu * nmw + (wave - ck::UNITS_PER_WG), G * nmw, base, lane);
              run_job4(mk_job(args.in[27], args.in[28], args.in[26], WGU, DM, FF, 2 * FF - 8192, DM, 0, 1, 0, 0, 1 << 30, 0, 8192), vcu * nmw + (wave - ck::UNITS_PER_WG), G * nmw, base, lane); }
        }
        if (BOTH(7)) GRID_BAR();
    }
    if (IN(8)) {
        for (int rep = 0; rep < REP(8); ++rep) {
        if (vcu < 32) { ck::rwkv_chain(vcu, TRT, SLOT, lds, tid); __syncthreads(); }
        for (;;) {
            if (tid == 0) MISC[16] = __hip_atomic_fetch_add(ctl + CW_QUEUE + 64 * rep, 1u, RLX_AGENT);
            __syncthreads();
            const unsigned idx = MISC[16];
            __syncthreads();
            if (idx >= (unsigned)att::ATT_UNITS) break;
            { const unsigned en = att::att_entry(idx >> 4); const int part = (int)((en >> 4) & 1u), np = (en & 32u) ? 2 : 1;
              att::attn_unit((int)(idx & 15u), (int)(en & 15u), part, np, QH, KH, VT, part ? OTMP : OMIX, part ? 1024 : 2048, AST + (size_t)part * T * MLA_H, lds); }
        }
        }
        if (BOTH(8)) GRID_BAR();
    }
    if (IN(9)) {
        { int base = 0;
          run_job(mk_job(args.in[27], args.in[28], args.in[26], WGU, DM, FF, 8192, DM, 0, 1, 0, 0, 1 << 30, 0, 0), gw, NGW, base, scr, lane); }
        for (int it = gw; it < T * 2; it += 4 * NGW) { const int left = (T * 2 - it + NGW - 1) / NGW; att::attn_merge4(it, NGW, left < 4 ? left : 4, OMIX, OTMP, AST, lane); }
        for (int u = gw; u < 32 * ck::NCH; u += NGW) ck::rwkv_out_item(u, SLOT, RRT, G2T, VCG, BONUS, Zb, LORA, args.in[14], args.in[23], args.in[24], OMIX, lane);
        if (BOTH(9)) GRID_BAR();
    }
    if (IN(10)) {

        pg8::Gemm g{OMIX, WOUT, T, DM, DM}; pg8::StaticOrder S; S.init(T, DM, G, bx);
        pg8::EpiRes<true> E{nullptr, DM, 1.0f, H, SS2};
        pg8::gemm_phase<pg8::EpiRes<true>, pg8::StaticOrder, false, true>(lds + RING_OFF, g, S, E);
        if (IN(10) && IN(12)) GRID_BAR();
    }
    if (IN(12)) {
        pg8::Gemm g{H, WGU, T, 2 * FF, DM}; pg8::StaticOrder S; S.init(T, 2 * FF, G, bx);
        pg8::EpiSwiGLU E{U, FF, SS2};
        pg8::gemm_phase<pg8::EpiSwiGLU, pg8::StaticOrder, true, true>(lds + RING_OFF, g, S, E);
        if (bx >= (G >> 1)) { int base = 0; const int hg = G >> 1;
            run_job(mk_job(args.in[29], nullptr, nullptr, WD2, FF, DM, 1024, FF, 0, 0, 0, 0, 1 << 30, 0, 1024), (bx - hg) * NWAVES + wave, (G - hg) * NWAVES, base, scr, lane);
            __syncthreads();
            pg8::Gemm g2{PB, WPP, T, DM, PLE}; pg8::StaticOrder S2; S2.init(T, DM, G - hg, bx - hg); pg8::EpiBf16 E2{(pg8::bf16_t*)PPLE, DM, nullptr};
            pg8::gemm_phase<pg8::EpiBf16, pg8::StaticOrder, true, true>(lds + RING_OFF, g2, S2, E2); }
        if (BOTH(12)) GRID_BAR();
    }
    if (IN(13)) {
        pg8::Gemm g{U, WD2, T, DM, FF}; pg8::StaticOrder S; S.init(T, DM, G, bx);
        pg8::EpiRes<true> E{nullptr, DM, 0.5f, H, SS3};
        pg8::gemm_phase<pg8::EpiRes<true>, pg8::StaticOrder, false, true>(lds + RING_OFF, g, S, E);
        if (IN(13) && IN(15)) GRID_BAR();
    }
    if (IN(15)) {
        {   pg8::Gemm g{H, WPG, T, DM, DM}; pg8::StaticOrder S; S.init(T, DM, G, bx); pg8::EpiPle E{H, (const pg8::bf16_t*)PPLE, out, DM, SS3};
            pg8::gemm_phase<pg8::EpiPle, pg8::StaticOrder, false, true>(lds + RING_OFF, g, S, E); }
    }
#undef IN
#undef BOTH
#undef GRID_BAR
}

extern "C" void kernel_launch(void* const* d_in, const int* in_sizes, int n_in, void* d_out, int out_size, void* d_ws, size_t ws_size, hipStream_t stream) {
    static int grid = 0;
    if (grid == 0) {
        if (n_in != 33 || out_size != T * DM || ws_size < WS_END) { fprintf(stderr, "kernel_launch: unexpected shapes (n_in %d, out %d, ws %zu, need %zu)\n", n_in, out_size, ws_size, (size_t)WS_END); grid = -1; return; }
        int dev = 0, cus = 0, per_cu = 0;
        if (hipGetDevice(&dev) != hipSuccess || hipDeviceGetAttribute(&cus, hipDeviceAttributeMultiprocessorCount, dev) != hipSuccess) { grid = -1; return; }
        if (hipFuncSetAttribute((const void*)mk_fwd, hipFuncAttributeMaxDynamicSharedMemorySize, LDS_BYTES) != hipSuccess) { fprintf(stderr, "kernel_launch: hipFuncSetAttribute failed\n"); grid = -1; return; }
        if (hipOccupancyMaxActiveBlocksPerMultiprocessor(&per_cu, (const void*)mk_fwd, NTHR, LDS_BYTES) != hipSuccess || per_cu < 1) { fprintf(stderr, "kernel_launch: occupancy query says %d blocks per CU\n", per_cu); (void)hipGetLastError(); grid = -1; return; }
        grid = cus;
        fprintf(stderr, "kernel_launch: grid %d, per_cu %d, ws %zu\n", grid, per_cu, ws_size);
    }
    if (grid < 0) return;
    (void)hipMemsetAsync((char*)d_ws + WS_CTL, 0, CTL_ZERO_BYTES, stream);
    Args a{};
    for (int i = 0; i < 33; ++i) a.in[i] = (const float*)d_in[i];
    a.out = (float*)d_out; a.ws = (unsigned char*)d_ws;
    for (int li = 0; li < N_LAUNCHES; ++li) {
        a.ph_lo = (N_LAUNCHES == 1) ? 0 : li; a.ph_hi = (N_LAUNCHES == 1) ? NPH : li + 1;
        hipLaunchKernelGGL(mk_fwd, dim3(grid), dim3(NTHR), LDS_BYTES, stream, a);
    }
}
```
